# Optimizing an MI355X kernel written in HIP

```python
import math
import jax, jax.numpy as jnp
from jax import lax
import numpy as np


D_MODEL = 1024
BATCH = 2
SEQ = 8192
DEPTH = 2

CTX_LEN = 256
GRID_W = 64
N_HEADS = 8
QK_NOPE = 64
QK_ROPE = 32
QK_DIM = QK_NOPE + QK_ROPE
V_DIM = 64
Q_LORA = 384
KV_LORA = 256
ROPE_BASE = 10000.0
Q_BLOCK = 128
ATTN_W = N_HEADS * V_DIM
ATTN_SCALE = QK_DIM ** -0.5
POOL_WINDOWS = (2, 4, 8, 16)
POOL_GROUPS = 4
POOL_GC = 128
POOL_W = POOL_GROUPS * POOL_GC
FFT_GROUPS = 4
FFT_GC = 128
FFT_W = FFT_GROUPS * FFT_GC
N_BRANCH = 3
OFF_Q = 0
OFF_KV = OFF_Q + Q_LORA
OFF_KR = OFF_KV + KV_LORA
OFF_POOL = OFF_KR + QK_ROPE
OFF_FFT = OFF_POOL + POOL_W
OFF_GATE = OFF_FFT + FFT_W
IN_COLS = OFF_GATE + N_BRANCH * D_MODEL
D_FF = 2816
N_EXPERTS = 8
TOP_K = 2
D_FF_EXPERT = 2816
N_DENSE = (DEPTH + 1) // 2
N_MOE = DEPTH // 2
EPS = 1e-6

kernel_name = "hybrid_mla_pool_fourier_moe_dit"


def rmsnorm(x, g):
    xf = x.astype(jnp.float32)
    y = xf * lax.rsqrt(jnp.mean(xf * xf, axis=-1, keepdims=True) + EPS)
    return (y * g.astype(jnp.float32)).astype(x.dtype)


def modulate(h, shift, scale):
    return h * (1 + scale) + shift


def axial_rope_tables(n_rows, dtype):
    rows = jnp.repeat(jnp.arange(n_rows, dtype=jnp.float32), GRID_W)
    cols = jnp.tile(jnp.arange(GRID_W, dtype=jnp.float32), n_rows)
    half = QK_ROPE // 2
    inv = ROPE_BASE ** (-jnp.arange(0, half, 2, dtype=jnp.float32) / half)
    ang = jnp.stack([rows[:, None] * inv, cols[:, None] * inv], axis=1)
    return jnp.cos(ang).astype(dtype), jnp.sin(ang).astype(dtype)


def apply_axial_rope(x, cos, sin):
    nf = QK_ROPE // 4
    shp = x.shape
    xr = x.reshape(*shp[:-1], 2, 2, nf)
    mid = (1,) * (x.ndim - 3)
    c = cos.reshape(cos.shape[0], *mid, 2, nf)
    s = sin.reshape(sin.shape[0], *mid, 2, nf)
    x1 = xr[..., 0, :]
    x2 = xr[..., 1, :]
    out = jnp.stack([x1 * c - x2 * s, x2 * c + x1 * s], axis=-2)
    return out.reshape(shp)


def mla_queries(pq, g_q, w_uq):
    q = jnp.einsum('blr,rhd->blhd', rmsnorm(pq, g_q), w_uq)
    return q[..., :QK_NOPE], q[..., QK_NOPE:]


def mla_keys_values(pkv, g_kv, w_ukv):
    kv = jnp.einsum('blr,rhd->blhd', rmsnorm(pkv, g_kv), w_ukv)
    return kv[..., :QK_NOPE], kv[..., QK_NOPE:]


def attend(q_nope, q_rope, k_nope, k_rope, v):
    s = (jnp.einsum('bqhd,bkhd->bhqk', q_nope, k_nope)
         + jnp.einsum('bqhr,bkr->bhqk', q_rope, k_rope))
    p = jax.nn.softmax(s.astype(jnp.float32) * ATTN_SCALE, axis=-1).astype(v.dtype)
    return jnp.einsum('bhqk,bkhd->bqhd', p, v)


def blocked_attend(q_nope, q_rope, k_nope, k_rope, v):
    B, L = q_nope.shape[:2]
    nb = L // Q_BLOCK

    def to_blocks(t):
        return t.reshape(B, nb, Q_BLOCK, *t.shape[2:]).swapaxes(0, 1)

    out = lax.map(lambda qs: attend(qs[0], qs[1], k_nope, k_rope, v),
                  (to_blocks(q_nope), to_blocks(q_rope)))
    return out.swapaxes(0, 1).reshape(B, L, N_HEADS, V_DIM)


def multiscale_pool(p, w_pool, s_pool):
    B, L, _ = p.shape
    pg = p.reshape(B, L, POOL_GROUPS, POOL_GC).astype(jnp.float32)
    cs = jnp.cumsum(pg, axis=1)
    cs = jnp.concatenate([jnp.zeros_like(cs[:, :1]), cs], axis=1)
    win = jnp.array(POOL_WINDOWS, dtype=jnp.int32)
    left = win // 2
    right = win - 1 - left
    t = jnp.arange(L, dtype=jnp.int32)[:, None]
    hi = jnp.minimum(t + right + 1, L)
    lo = jnp.maximum(t - left, 0)
    g = jnp.arange(POOL_GROUPS, dtype=jnp.int32)[None, :]
    window_sum = cs[:, hi, g, :] - cs[:, lo, g, :]
    mean = window_sum / (hi - lo).astype(jnp.float32)[None, :, :, None]
    mixed = (mean - pg).astype(p.dtype)
    y = jnp.einsum('blgc,gcd->blgd', mixed, w_pool)
    return y.reshape(B, L, POOL_W) * s_pool


def fourier_mix(f):
    B, L, _ = f.shape
    fg = f.reshape(B, L, FFT_GROUPS, FFT_GC).astype(jnp.float32)
    fr = jnp.fft.fft2(fg, axes=(1, 3), norm='ortho').real
    return fr.reshape(B, L, FFT_W).astype(f.dtype)


def gated_merge(attn_out, pooled, fourier, gate_pre, w_oa, w_ob, w_oc, w_out):
    B, L = attn_out.shape[:2]
    g = jax.nn.sigmoid(gate_pre).reshape(B, L, N_BRANCH, D_MODEL)
    y = (g[:, :, 0] * (attn_out.reshape(B, L, ATTN_W) @ w_oa)
         + g[:, :, 1] * (pooled @ w_ob)
         + g[:, :, 2] * (fourier @ w_oc))
    return y @ w_out


def token_mixer(h_lat, h_ctx, w_in, b_gate, g_q, w_uq, g_kv, w_ukv, w_pool, s_pool,
                w_oa, w_ob, w_oc, w_out, cos, sin, with_ctx_out):
    p_lat = h_lat @ w_in
    q_nope, q_rope = mla_queries(p_lat[..., OFF_Q:OFF_KV], g_q, w_uq)
    q_rope = apply_axial_rope(q_rope, cos, sin)
    k_nope_l, v_l = mla_keys_values(p_lat[..., OFF_KV:OFF_KR], g_kv, w_ukv)
    k_rope_l = apply_axial_rope(p_lat[..., OFF_KR:OFF_POOL], cos, sin)
    p_ctx_kv = h_ctx @ w_in[:, OFF_KV:OFF_POOL]
    k_nope_c, v_c = mla_keys_values(p_ctx_kv[..., :KV_LORA], g_kv, w_ukv)
    k_rope_c = p_ctx_kv[..., KV_LORA:]
    k_nope = jnp.concatenate([k_nope_c, k_nope_l], axis=1)
    k_rope = jnp.concatenate([k_rope_c, k_rope_l], axis=1)
    v = jnp.concatenate([v_c, v_l], axis=1)
    attn_l = blocked_attend(q_nope, q_rope, k_nope, k_rope, v)
    pool_l = multiscale_pool(p_lat[..., OFF_POOL:OFF_FFT], w_pool, s_pool)
    fft_l = fourier_mix(p_lat[..., OFF_FFT:OFF_GATE])
    out_lat = gated_merge(attn_l, pool_l, fft_l, p_lat[..., OFF_GATE:] + b_gate,
                          w_oa, w_ob, w_oc, w_out)
    if not with_ctx_out:
        return out_lat, None
    p_ctx_q = h_ctx @ w_in[:, OFF_Q:OFF_KV]
    p_ctx_rest = h_ctx @ w_in[:, OFF_POOL:]
    qc_nope, qc_rope = mla_queries(p_ctx_q, g_q, w_uq)
    attn_c = attend(qc_nope, qc_rope, k_nope_c, k_rope_c, v_c)
    pool_c = multiscale_pool(p_ctx_rest[..., :POOL_W], w_pool, s_pool)
    fft_c = fourier_mix(p_ctx_rest[..., POOL_W:POOL_W + FFT_W])
    out_ctx = gated_merge(attn_c, pool_c, fft_c, p_ctx_rest[..., POOL_W + FFT_W:] + b_gate,
                          w_oa, w_ob, w_oc, w_out)
    return out_lat, out_ctx


def swiglu(h, w1, w3, w2):
    return (jax.nn.silu(h @ w1) * (h @ w3)) @ w2


def moe_swiglu(h, w_router, b_router, w1, w3, w2):
    logits = (h @ w_router).astype(jnp.float32) + b_router.astype(jnp.float32)
    top_v, top_i = lax.top_k(logits, TOP_K)
    top_w = jax.nn.softmax(top_v, axis=-1)
    combine = jnp.sum(jax.nn.one_hot(top_i, N_EXPERTS, dtype=jnp.float32) * top_w[..., None],
                      axis=-2).astype(h.dtype)
    out = jnp.zeros_like(h)
    for e in range(N_EXPERTS):
        out = out + combine[..., e:e + 1] * swiglu(h, w1[e], w3[e], w2[e])
    return out


def setup_inputs(seed: int = 0) -> dict:
    key = jax.random.key(seed)
    ks = iter(jax.random.split(key, 40))
    D = D_MODEL

    def nrm(shape, scale):
        return jax.random.normal(next(ks), shape, jnp.float32) * scale

    def gain(shape):
        return 1.0 + nrm(shape, 0.02)

    return {
        'x': nrm((BATCH, SEQ, D), 1.0),
        'c': nrm((BATCH, D), 1.0),
        'ctx': nrm((BATCH, CTX_LEN, D), 1.0),
        'c_ctx': nrm((D,), 1.0),
        'w_mod': nrm((DEPTH, D, 6 * D), 0.5 * D ** -0.5),
        'b_mod': nrm((DEPTH, 6 * D), 0.02),
        'g_norm1': gain((DEPTH, D)),
        'w_in': nrm((DEPTH, D, IN_COLS), D ** -0.5),
        'b_gate': nrm((DEPTH, N_BRANCH * D), 0.02),
        'g_q': gain((DEPTH, Q_LORA)),
        'w_uq': nrm((DEPTH, Q_LORA, N_HEADS, QK_DIM), Q_LORA ** -0.5),
        'g_kv': gain((DEPTH, KV_LORA)),
        'w_ukv': nrm((DEPTH, KV_LORA, N_HEADS, QK_NOPE + V_DIM), KV_LORA ** -0.5),
        'w_pool': nrm((DEPTH, POOL_GROUPS, POOL_GC, POOL_GC), POOL_GC ** -0.5),
        's_pool': 1.0 + nrm((DEPTH, POOL_W), 0.1),
        'w_oa': nrm((DEPTH, ATTN_W, D), ATTN_W ** -0.5),
        'w_ob': nrm((DEPTH, POOL_W, D), POOL_W ** -0.5),
        'w_oc': nrm((DEPTH, FFT_W, D), FFT_W ** -0.5),
        'w_out': nrm((DEPTH, D, D), D ** -0.5),
        'g_norm2': gain((DEPTH, D)),
        'ffn_w1': nrm((N_DENSE, D, D_FF), D ** -0.5),
        'ffn_w3': nrm((N_DENSE, D, D_FF), D ** -0.5),
        'ffn_w2': nrm((N_DENSE, D_FF, D), D_FF ** -0.5),
        'moe_router': nrm((N_MOE, D, N_EXPERTS), D ** -0.5),
        'moe_bias': nrm((N_MOE, N_EXPERTS), 0.01),
        'moe_w1': nrm((N_MOE, N_EXPERTS, D, D_FF_EXPERT), D ** -0.5),
        'moe_w3': nrm((N_MOE, N_EXPERTS, D, D_FF_EXPERT), D ** -0.5),
        'moe_w2': nrm((N_MOE, N_EXPERTS, D_FF_EXPERT, D), D_FF_EXPERT ** -0.5),
        'g_final': gain((D,)),
    }


def reference(x, c, ctx, c_ctx, w_mod, b_mod, g_norm1, w_in, b_gate, g_q, w_uq, g_kv, w_ukv,
              w_pool, s_pool, w_oa, w_ob, w_oc, w_out, g_norm2, ffn_w1, ffn_w3, ffn_w2,
              moe_router, moe_bias, moe_w1, moe_w3, moe_w2, g_final):
    B, L, D = x.shape
    n_ctx = ctx.shape[1]
    rows = L // GRID_W
    cos, sin = axial_rope_tables(rows, x.dtype)
    xc = ctx
    cond_lat = jax.nn.silu(c)
    cond_ctx = jax.nn.silu(c_ctx)
    for layer in range(DEPTH):
        last = layer == DEPTH - 1
        mod_l = (cond_lat @ w_mod[layer] + b_mod[layer])[:, None, :]
        sh1, sc1, gt1, sh2, sc2, gt2 = jnp.split(mod_l, 6, axis=-1)
        n_mc = 2 if last else 6
        mod_c = cond_ctx @ w_mod[layer][:, :n_mc * D] + b_mod[layer][:n_mc * D]
        mods_c = jnp.split(mod_c, n_mc)
        h_l = modulate(rmsnorm(x, g_norm1[layer]), sh1, sc1)
        h_c = modulate(rmsnorm(xc, g_norm1[layer]), mods_c[0], mods_c[1])
        out_l, out_c = token_mixer(h_l, h_c, w_in[layer], b_gate[layer], g_q[layer], w_uq[layer],
                                   g_kv[layer], w_ukv[layer], w_pool[layer], s_pool[layer],
                                   w_oa[layer], w_ob[layer], w_oc[layer], w_out[layer],
                                   cos, sin, not last)
        x = x + gt1 * out_l
        if not last:
            xc = xc + mods_c[2] * out_c
        h_l = modulate(rmsnorm(x, g_norm2[layer]), sh2, sc2)
        if last:
            h = h_l
        else:
            h_c = modulate(rmsnorm(xc, g_norm2[layer]), mods_c[3], mods_c[4])
            h = jnp.concatenate([h_c, h_l], axis=1)
        if layer % 2 == 0:
            y = swiglu(h, ffn_w1[layer // 2], ffn_w3[layer // 2], ffn_w2[layer // 2])
        else:
            y = moe_swiglu(h, moe_router[layer // 2], moe_bias[layer // 2],
                           moe_w1[layer // 2], moe_w3[layer // 2], moe_w2[layer // 2])
        if last:
            x = x + gt2 * y
        else:
            x = x + gt2 * y[:, n_ctx:]
            xc = xc + mods_c[5] * y[:, :n_ctx]
    return rmsnorm(x, g_final)
```

```cpp
#include <hip/hip_runtime.h>
#include <cstdio>
#include <cstdint>

#define LAS __attribute__((address_space(3)))
#define GAS __attribute__((address_space(1)))
typedef unsigned short bf16_t;
typedef short bf16x8 __attribute__((ext_vector_type(8)));
typedef short s16x4 __attribute__((ext_vector_type(4)));
typedef float f32x2 __attribute__((ext_vector_type(2)));
typedef float f32x4 __attribute__((ext_vector_type(4)));
typedef float f32x16 __attribute__((ext_vector_type(16)));
typedef unsigned u32x2 __attribute__((ext_vector_type(2)));
typedef unsigned u32x4 __attribute__((ext_vector_type(4)));

constexpr int D = 1024, NB = 2, SEQ = 8192, NCTX = 256;
constexpr int TL = NB * SEQ;
constexpr int TC = NB * NCTX;
constexpr int T = TL + TC;
constexpr int NH = 8, QKD = 96, VD = 64, QL = 384, KVL = 256;
constexpr int NKEY = NCTX + SEQ;
constexpr int OFF_KV = 384, OFF_KR = 640, OFF_POOL = 672, OFF_FFT = 1184, OFF_GATE = 1696, IN_COLS = 4768, NIN = 4864;
constexpr int PP = 1792;
constexpr int DFF = 2816, NE = 8, DFH = 1408;
constexpr int MOE_ROWS = 34816;
constexpr float EPS = 1e-6f;
constexpr float QSCALE = 0.10206207261596577f * 1.4426950408889634f;

constexpr size_t MiB = 1u << 20;
constexpr size_t WS_CTL = 0, CTL_ZERO_BYTES = 64 * 1024;
constexpr size_t WS_MODS = 1 * MiB;
constexpr size_t WS_ROPE = WS_MODS + 2 * 3 * 6144 * 4;
constexpr size_t WS_TW = WS_ROPE + 128 * 8 * 2 * 4;
constexpr size_t WS_DFT128 = WS_TW + 128 * 64 * 2 * 4;
constexpr size_t WS_M64 = WS_DFT128 + 256 * 128 * 2;
constexpr size_t WS_DFT256 = WS_M64 + 128 * 128 * 2;
constexpr size_t WS_ROUTE_E = WS_DFT256 + 512 * 256 * 2;
constexpr size_t WS_ROUTE_W = WS_ROUTE_E + 16384 * 4;
constexpr size_t WS_TOKSLOT = WS_ROUTE_W + 16384 * 8;
constexpr size_t WS_BLKCNT = WS_TOKSLOT + 16384 * 8;
constexpr size_t WS_SSQ = 4 * MiB;
constexpr size_t WS_XW = 8 * MiB;
constexpr size_t WS_PERM = WS_XW + (size_t)T * D * 4;
constexpr size_t LW_IN = 0, LW_UQ = LW_IN + (size_t)NIN * 1024 * 2, LW_UKV = LW_UQ + 768 * 384 * 2, LW_OA = LW_UKV + 1024 * 256 * 2,
                 LW_PB = LW_OA + 1024 * 512 * 2, LW_FC = LW_PB + 1024 * 512 * 2, LW_OUT = LW_FC + 1024 * 1024 * 2, LW_SIZE = LW_OUT + 1024 * 1024 * 2;
constexpr size_t WS_FFN13 = WS_PERM + 2 * LW_SIZE;
constexpr size_t WS_FFN2 = WS_FFN13 + (size_t)5632 * 1024 * 2;
constexpr size_t WS_ARENA = WS_FFN2 + (size_t)1024 * 2816 * 2;
constexpr size_t WS_P = WS_ARENA;
constexpr size_t WS_G = WS_P + (size_t)T * PP * 2;
constexpr size_t WS_A1 = WS_P + (size_t)T * NIN * 2;
constexpr size_t WS_A2 = WS_A1 + (size_t)T * D * 2;
constexpr size_t WS_Q = WS_A2, WS_K = WS_Q + (size_t)T * 768 * 2, WS_VT = WS_K + (size_t)NB * NH * NKEY * QKD * 2;
constexpr size_t WS_A3 = WS_A2 + (size_t)T * D * 4;
constexpr size_t WS_AO = WS_A3, WS_MIX = WS_AO + (size_t)T * 512 * 2, WS_YY = WS_MIX + (size_t)T * 512 * 2;
constexpr size_t WS_MIXER_END = WS_YY + (size_t)T * 1024 * 2;
static_assert(WS_VT + (size_t)NB * NH * VD * NKEY * 2 <= WS_A3, "QKV fits A2");
constexpr size_t WS_U = WS_P;
static_assert((size_t)T * DFF * 2 <= (size_t)T * NIN * 2, "u fits p");
constexpr size_t WS_MW13 = WS_PERM;
constexpr size_t WS_MW2 = WS_MW13 + (size_t)NE * 5632 * 1024 * 2;
constexpr size_t WS_H2G = WS_MW2 + (size_t)NE * 1024 * DFF * 2;
constexpr size_t WS_UF = WS_H2G + (size_t)MOE_ROWS * 1024 * 2;
constexpr size_t WS_YX2 = WS_UF + (size_t)MOE_ROWS * DFF * 2;
constexpr size_t WS_YEXP = WS_H2G;
constexpr size_t WS_MOE_END = WS_YX2 + (size_t)2048 * 1024 * 2;
constexpr size_t WS_NEED = WS_MIXER_END > WS_MOE_END ? WS_MIXER_END : WS_MOE_END;
static_assert(WS_NEED <= 496000000ull, "workspace budget");
constexpr size_t WS_H2M = WS_UF;

constexpr int CW_BAR = 1024;

constexpr int RING_BYTES = 131072;
constexpr int LDSCTL_OFF = RING_BYTES;
constexpr int MISC_OFF = LDSCTL_OFF;
constexpr int TILE_E_OFF = LDSCTL_OFF + 256;
constexpr int SCR_OFF = LDSCTL_OFF + 1024;
constexpr int LDS_BYTES = 147456;

typedef __bf16 bf16x2_t __attribute__((ext_vector_type(2)));
__device__ __forceinline__ unsigned cvt_pk_bf16(float lo, float hi) { const f32x2 v = {lo, hi}; const bf16x2_t b = __builtin_convertvector(v, bf16x2_t); return __builtin_bit_cast(unsigned, b); }
__device__ __forceinline__ float bf2f(unsigned short v) { return __uint_as_float((unsigned)v << 16); }
__device__ __forceinline__ float bflo(unsigned v) { return __uint_as_float(v << 16); }
__device__ __forceinline__ float bfhi(unsigned v) { return __uint_as_float(v & 0xffff0000u); }
__device__ __forceinline__ bf16_t f2bf(float f) { return (bf16_t)(cvt_pk_bf16(f, 0.f) & 0xffffu); }
__device__ __forceinline__ float shx(float v, int o, int lane) { return __int_as_float(__builtin_amdgcn_ds_bpermute((lane ^ o) << 2, __float_as_int(v))); }
__device__ __forceinline__ float wave_sum(float v, int lane) {
#pragma unroll
    for (int o = 1; o < 64; o <<= 1) v += shx(v, o, lane);
    return v;
}
__device__ __forceinline__ float sigmoidf_fast(float x) { return __builtin_amdgcn_rcpf(1.0f + __builtin_amdgcn_exp2f(-1.4426950408889634f * x)); }
__device__ __forceinline__ int crow(int r, int hi) { return (r & 3) + 8 * (r >> 2) + 4 * hi; }
#define LDS_WAIT() asm volatile("s_waitcnt lgkmcnt(0)" ::: "memory")
#define VM_WAIT() asm volatile("s_waitcnt vmcnt(0)" ::: "memory")

#define XB_TMO      128
#define XB_XCNT(j)  (256  + 64 * (j))
#define XB_XSUB(j)  (1280 + 64 * (j))
#define XB_XGEN(j)  (2304 + 64 * (j))
#define XB_TOP      3328
#define XB_TOPGEN   3392
#define XCD_BAR_WORDS 3456
#define XB_SPIN_CAP (1u << 18)
__device__ __forceinline__ unsigned xb_ld(unsigned* p)              { return __hip_atomic_load(p, __ATOMIC_RELAXED, __HIP_MEMORY_SCOPE_AGENT); }
__device__ __forceinline__ unsigned xb_add(unsigned* p, unsigned v) { return __hip_atomic_fetch_add(p, v, __ATOMIC_RELAXED, __HIP_MEMORY_SCOPE_AGENT); }
__device__ __forceinline__ unsigned xb_xcc_id() { return (unsigned)__builtin_amdgcn_s_getreg((3 << 11) | 20) & 0xFu; }
#define XB_SPIN(cond, bar) do { unsigned _sp = 0; while (cond) { __builtin_amdgcn_s_sleep(1); \
    if ((++_sp & 255u) == 0u) { if (xb_ld(&(bar)[XB_TMO])) break; if (_sp > XB_SPIN_CAP) { atomicAdd(&(bar)[XB_TMO], 1u); break; } } } } while (0)
struct XcdBarrier { unsigned* bar; unsigned x; volatile LAS unsigned* st; };
__device__ __forceinline__ XcdBarrier xcd_barrier_post(unsigned* bar, volatile LAS unsigned* st) {
    XcdBarrier b; b.bar = bar; b.x = xb_xcc_id(); b.st = st;
    if (threadIdx.x == 0) (void)xb_add(&bar[XB_XCNT(b.x)], 1u);
    return b;
}
__device__ __forceinline__ void xcd_barrier_complete(unsigned* bar, unsigned x, unsigned& nloc, unsigned& nx) {
    const unsigned G = gridDim.x * gridDim.y * gridDim.z;
    unsigned sum, cnt, mine, sp = 0u;
    for (;;) {
        sum = 0u; cnt = 0u; mine = 0u;
#pragma unroll
        for (unsigned j = 0; j < 16; ++j) { const unsigned c = xb_ld(&bar[XB_XCNT(j)]); sum += c; cnt += (c > 0u) ? 1u : 0u; mine = (j == x) ? c : mine; }
        if (sum == G) break;
        __builtin_amdgcn_s_sleep(1);
        if ((++sp & 255u) == 0u) { if (xb_ld(&bar[XB_TMO])) break; if (sp > XB_SPIN_CAP) { atomicAdd(&bar[XB_TMO], 1u); break; } }
    }
    nloc = mine > 0u ? mine : 1u; nx = cnt > 0u ? cnt : 1u;
}
__device__ __forceinline__ void xcd_barrier(const XcdBarrier& b, int wave_id) {
    asm volatile("s_waitcnt vmcnt(0)" ::: "memory");
    __syncthreads();
    if (wave_id == 0 && __builtin_amdgcn_mbcnt_hi(~0u, __builtin_amdgcn_mbcnt_lo(~0u, 0u)) == 0u) {
        unsigned* bar = b.bar;
        __builtin_amdgcn_s_waitcnt(0);
        unsigned nloc = b.st[0], nx = b.st[1];
        if (nloc == 0u) { xcd_barrier_complete(bar, b.x, nloc, nx); b.st[0] = nloc; b.st[1] = nx; }
        const unsigned old = xb_add(&bar[XB_XSUB(b.x)], 1u);
        const unsigned gen = old / nloc;
        if (old + 1u == (gen + 1u) * nloc) {
            __builtin_amdgcn_fence(__ATOMIC_RELEASE, "agent");
            asm volatile("s_waitcnt vmcnt(0)" ::: "memory");
            const unsigned og = xb_add(&bar[XB_TOP], 1u);
            const unsigned tg = og / nx;
            if (og + 1u == (tg + 1u) * nx) xb_add(&bar[XB_TOPGEN], 1u);
            else XB_SPIN(xb_ld(&bar[XB_TOPGEN]) == tg, bar);
            __builtin_amdgcn_fence(__ATOMIC_ACQUIRE, "agent");
            xb_add(&bar[XB_XGEN(b.x)], 1u);
            asm volatile("s_waitcnt vmcnt(0)" ::: "memory");
        } else {
            XB_SPIN(xb_ld(&bar[XB_XGEN(b.x)]) == gen, bar);
            __builtin_amdgcn_fence(__ATOMIC_ACQUIRE, "agent");
            asm volatile("s_waitcnt vmcnt(0)" ::: "memory");
        }
    }
    __syncthreads();
}

namespace pg8 {
constexpr int BM = 256, BK = 64, HALF = 128, HTB = HALF * BK * 2, NXCD = 8, WGM = 4;
__host__ __device__ __forceinline__ int lds_byte(int r, int c) { const int st = (r >> 4) * 2 + (c >> 5), rr = r & 15, cc = c & 31, ob = rr * 64 + cc * 2; return st * 1024 + (ob ^ (((ob >> 9) & 1) << 5)); }
__host__ __device__ __forceinline__ void stage_rc(int b, int& R, int& C) { const int st = b / 1024, sb = b % 1024, swz = sb ^ (((sb >> 9) & 1) << 5); R = (st >> 1) * 16 + swz / 64; C = (st & 1) * 32 + (swz % 64) / 2; }
__host__ __device__ __forceinline__ int perm32(int rho) { const int n = rho >> 4, i = rho & 15; return 8 * (i >> 2) + 4 * n + (i & 3); }

struct Unit { int pm, pn, e, s = 0; };
struct Gemm { const bf16_t* A; const bf16_t* Bt; int lda, ldb, K; size_t bstride; size_t astride = 0; size_t astride2 = 0, bstride2 = 0; };

struct GridOrder {
    int nM, nN, nwg, G, c, xm0, xn0, xnm, nX; const LAS int* tile_e;
    __device__ __forceinline__ void init(int nM_, int nN_, int G_, int c_) { nM = nM_; nN = nN_; nwg = nM * nN; G = G_; c = c_; xm0 = xn0 = 0; xnm = 1; nX = 0; tile_e = nullptr; }
    __device__ __forceinline__ bool next(int i, Unit& u) const {
        long L = (long)i * G + c;
        if (L < nwg) {
            int wgid = (int)L; { const int q = nwg / NXCD, r = nwg % NXCD, xcd = wgid % NXCD, off = wgid / NXCD; wgid = (xcd < r ? xcd * (q + 1) : r * (q + 1) + (xcd - r) * q) + off; }
            const int nig = WGM * nN, gid = wgid / nig, fm = gid * WGM, gsz = (nM - fm) < WGM ? (nM - fm) : WGM;
            u.pm = fm + ((wgid % nig) % gsz); u.pn = (wgid % nig) / gsz; u.e = tile_e ? tile_e[u.pm] : 0; u.s = 0; return true;
        }
        L -= nwg; if (L >= nX) return false;
        u.pm = xm0 + (int)(L % xnm); u.pn = xn0 + (int)(L / xnm); u.e = 0; u.s = 0; return true;
    }
};

struct CtxSplitOrder {
    int nsl, G, c;
    __device__ __forceinline__ bool next(int i, Unit& u) const { const int L = i * G + c; if (L >= 8 * nsl) return false; u.e = L % nsl; u.s = 0; const int q = L / nsl; u.pn = q & 3; u.pm = 64 + (q >> 2); return true; }
};
struct MoeOvOrder {
    int nov, G, c; const LAS int* tile_e;
    __device__ __forceinline__ bool next(int i, Unit& u) const { const int L = i * G + c; if (L >= nov * 8) return false; u.s = L & 1; const int q = L >> 1; u.pn = q & 3; u.pm = 128 + (q >> 2); u.e = tile_e[u.pm]; return true; }
};
template <class Epi, class Sched, bool ALIGN_EPI>
__device__ __forceinline__ void gemm_phase(LAS unsigned char* lds, const Gemm g, const Sched& S, const Epi& E, int wave_id) {
    int wid_l = wave_id; asm volatile("" : "+s"(wid_l)); int lane_l = (int)__builtin_amdgcn_mbcnt_hi(~0u, __builtin_amdgcn_mbcnt_lo(~0u, 0u)); asm volatile("" : "+v"(lane_l));
    const int wid = wid_l, lane = lane_l, tid = wid * 64 + lane, wr = wid >> 2, wc = wid & 3, fr = lane & 15, fq = lane >> 4;
    const int K = g.K, nt = K / BK;
    unsigned voffA[2], voffB[2];
#pragma unroll
    for (int i = 0; i < 2; ++i) { int R, C; stage_rc(tid * 16 + i * 8192, R, C); const int Rb = Epi::PERM ? ((R & ~31) + perm32(R & 31)) : R;
        voffA[i] = (unsigned)(R * g.lda + C) * 2u; voffB[i] = (unsigned)(Rb * g.ldb + C) * 2u; }
    const size_t kstep = (size_t)(BK * 2);
    const size_t hstepA = (size_t)HALF * g.lda * 2, hstepB = (size_t)HALF * g.ldb * 2;
    const unsigned ldsw = (unsigned)wid * 1024u;
    const int aoff = lds_byte(wr * 64 + fr, fq * 8), boff = lds_byte(wc * 32 + fr, fq * 8);
#define PG8_SA(b, h) (((b) * 2 + (h)) * HTB)
#define PG8_SB(b, h) ((4 + (b) * 2 + (h)) * HTB)
#define PG8_STAGE(bufoff, gbase, voff) do { _Pragma("unroll") for (int _i = 0; _i < 2; ++_i) \
        __builtin_amdgcn_global_load_lds((const unsigned*)((const char*)(gbase) + (voff)[_i]), (LAS unsigned*)(lds + (bufoff) + ldsw + _i * 8192), 16, 0, 0); } while (0)
#define PG8_LDA(dst, b, h) do { _Pragma("unroll") for (int m = 0; m < 4; ++m) _Pragma("unroll") for (int k = 0; k < 2; ++k) dst[m][k] = *(const LAS bf16x8*)(lds + PG8_SA(b, h) + aoff + m * 2048 + k * 1024); } while (0)
#define PG8_LDB(dst, b, h) do { _Pragma("unroll") for (int n = 0; n < 2; ++n) _Pragma("unroll") for (int k = 0; k < 2; ++k) dst[n][k] = *(const LAS bf16x8*)(lds + PG8_SB(b, h) + boff + n * 2048 + k * 1024); } while (0)
#define PG8_MMA(ai, bj, At, Bt) do { __builtin_amdgcn_s_setprio(1); _Pragma("unroll") for (int m = 0; m < 4; ++m) _Pragma("unroll") for (int n = 0; n < 2; ++n) _Pragma("unroll") for (int k = 0; k < 2; ++k) \
        acc[ai][bj][m][n] = __builtin_amdgcn_mfma_f32_16x16x32_bf16(Bt[n][k], At[m][k], acc[ai][bj][m][n], 0, 0, 0); __builtin_amdgcn_s_setprio(0); } while (0)
#define PG8_WAIT_V(n) asm volatile("s_waitcnt vmcnt(" #n ")" ::: "memory")
#define PG8_WAIT_L(n) asm volatile("s_waitcnt lgkmcnt(" #n ")" ::: "memory")
#define PG8_BAR __builtin_amdgcn_s_barrier()
#define PG8_SCHED __builtin_amdgcn_sched_barrier(0)
    Unit cur, nxt; int ui = 0;
    if (!S.next(0, cur)) return;
    f32x4 acc[2][2][4][2];
#pragma unroll
    for (int a = 0; a < 2; ++a)
#pragma unroll
        for (int b = 0; b < 2; ++b)
#pragma unroll
            for (int m = 0; m < 4; ++m)
#pragma unroll
                for (int n = 0; n < 2; ++n) acc[a][b][m][n] = (f32x4){0.f, 0.f, 0.f, 0.f};
    bf16x8 At[4][2], B0[2][2], B1[2][2];
    const char* cA = (const char*)g.A + (size_t)cur.pm * 2 * hstepA + (size_t)cur.e * g.astride + (size_t)cur.s * g.astride2; const char* cB = (const char*)g.Bt + (size_t)cur.e * g.bstride + (size_t)cur.s * g.bstride2 + (size_t)cur.pn * 2 * hstepB;
    PG8_STAGE(PG8_SB(0, 0), cB, voffB); PG8_STAGE(PG8_SB(0, 1), cB + hstepB, voffB); PG8_STAGE(PG8_SA(0, 0), cA, voffA); PG8_STAGE(PG8_SA(0, 1), cA + hstepA, voffA);
    if (wr == 1) PG8_BAR;
    PG8_WAIT_V(2); PG8_BAR;
    PG8_STAGE(PG8_SB(1, 0), cB + kstep, voffB); PG8_STAGE(PG8_SA(1, 0), cA + kstep, voffA); PG8_STAGE(PG8_SB(1, 1), cB + hstepB + kstep, voffB);
    PG8_WAIT_V(6); PG8_BAR;
    for (;;) {
        const bool has_next = S.next(ui + 1, nxt);
        const char* nA = has_next ? (const char*)g.A + (size_t)nxt.pm * 2 * hstepA + (size_t)nxt.e * g.astride + (size_t)nxt.s * g.astride2 : cA;
        const char* nB = has_next ? (const char*)g.Bt + (size_t)nxt.e * g.bstride + (size_t)nxt.s * g.bstride2 + (size_t)nxt.pn * 2 * hstepB : cB;
        for (int t = 0; t < nt; t += 2) {
            const bool last = (t == nt - 2);
            const char* a1 = cA + (size_t)(t + 1) * kstep;
            const char* a2 = last ? nA : cA + (size_t)(t + 2) * kstep; const char* b2 = last ? nB : cB + (size_t)(t + 2) * kstep;
            const char* a3 = a2 + kstep; const char* b3 = b2 + kstep;
            PG8_LDB(B0, 0, 0); PG8_LDB(B1, 0, 1); PG8_SCHED; PG8_LDA(At, 0, 0); PG8_STAGE(PG8_SA(1, 1), a1 + hstepA, voffA);
            PG8_WAIT_V(8); PG8_WAIT_L(0); PG8_BAR; PG8_MMA(0, 0, At, B0); PG8_MMA(0, 1, At, B1); PG8_BAR; PG8_SCHED;
            PG8_LDA(At, 0, 1); PG8_STAGE(PG8_SB(0, 0), b2, voffB); PG8_STAGE(PG8_SB(0, 1), b2 + hstepB, voffB); PG8_STAGE(PG8_SA(0, 0), a2, voffA);
            PG8_WAIT_V(8); PG8_WAIT_L(0); PG8_BAR; PG8_MMA(1, 0, At, B0); PG8_MMA(1, 1, At, B1); PG8_BAR; PG8_SCHED;
            PG8_LDB(B0, 1, 0); PG8_LDB(B1, 1, 1); PG8_SCHED; PG8_LDA(At, 1, 0); PG8_STAGE(PG8_SA(0, 1), a2 + hstepA, voffA);
            PG8_WAIT_V(8); PG8_WAIT_L(0); PG8_BAR; PG8_MMA(0, 0, At, B0); PG8_MMA(0, 1, At, B1); PG8_BAR; PG8_SCHED;
            PG8_LDA(At, 1, 1); PG8_STAGE(PG8_SB(1, 0), b3, voffB); PG8_STAGE(PG8_SB(1, 1), b3 + hstepB, voffB); PG8_STAGE(PG8_SA(1, 0), a3, voffA);
            PG8_WAIT_V(8); PG8_WAIT_L(0); PG8_BAR; PG8_MMA(1, 0, At, B0); PG8_MMA(1, 1, At, B1); PG8_BAR; PG8_SCHED;
        }
        if constexpr (ALIGN_EPI) { if (wr == 0) PG8_BAR; }
        E(acc, cur, wr, wc, fr, fq);
        if (!has_next) break;
#pragma unroll
        for (int a = 0; a < 2; ++a)
#pragma unroll
            for (int b = 0; b < 2; ++b)
#pragma unroll
                for (int m = 0; m < 4; ++m)
#pragma unroll
                    for (int n = 0; n < 2; ++n) acc[a][b][m][n] = (f32x4){0.f, 0.f, 0.f, 0.f};
        cur = nxt; cA = nA; cB = nB; ++ui;
        if constexpr (ALIGN_EPI) { if (wr == 1) PG8_BAR; }
    }
    PG8_WAIT_V(0);
    if constexpr (!ALIGN_EPI) { if (wr == 0) PG8_BAR; }
    PG8_BAR;
#undef PG8_SA
#undef PG8_SB
#undef PG8_STAGE
#undef PG8_LDA
#undef PG8_LDB
#undef PG8_MMA
#undef PG8_WAIT_V
#undef PG8_WAIT_L
#undef PG8_BAR
#undef PG8_SCHED
}
typedef f32x4 Acc[2][2][4][2];

struct EpiWin {
    static constexpr bool PERM = true;
    bf16_t* P; bf16_t* G; const float* bgate; float* ssq;
    __device__ __forceinline__ void operator()(const Acc& acc, const Unit& u, int wr, int wc, int fr, int fq) const {
        asm volatile("" : "+v"(fr), "+v"(fq));
        const int row0 = u.pm * BM + wr * 64 + fr;
        if (u.pn < 7) {
#pragma unroll
            for (int bj = 0; bj < 2; ++bj) {
                const int colb = u.pn * BM + bj * HALF + wc * 32, col0 = colb + 8 * fq;
#pragma unroll
                for (int ai = 0; ai < 2; ++ai)
#pragma unroll
                    for (int m = 0; m < 4; ++m) {
                        const int row = row0 + ai * HALF + m * 16;
                        const f32x4 v0 = acc[ai][bj][m][0], v1 = acc[ai][bj][m][1];
                        if (colb < OFF_KR) {
                            float s = (v0[0] * v0[0] + v0[1] * v0[1]) + (v0[2] * v0[2] + v0[3] * v0[3]) + (v1[0] * v1[0] + v1[1] * v1[1]) + (v1[2] * v1[2] + v1[3] * v1[3]);
                            { const int ln = fr + 16 * fq; s += shx(s, 16, ln); s += shx(s, 32, ln); }
                            if (fq == 0) ssq[(size_t)row * 20 + (colb >> 5)] = s;
                        }
                        u32x4 w; w.x = cvt_pk_bf16(v0[0], v0[1]); w.y = cvt_pk_bf16(v0[2], v0[3]); w.z = cvt_pk_bf16(v1[0], v1[1]); w.w = cvt_pk_bf16(v1[2], v1[3]);
                        *(u32x4*)(P + (size_t)row * PP + col0) = w;
                    }
            }
        } else {
            const int g = u.pn - 7, lane = fr + 16 * fq, wid = wr * 4 + wc;
            bf16_t* gt = G + ((size_t)(u.pm * 12 + g) * 8192 + (size_t)wid * 1024 + lane) * 8;
#pragma unroll
            for (int bj = 0; bj < 2; ++bj) {
                const int bc = g * BM + bj * HALF + wc * 32 + 8 * fq;
                const f32x4 b0 = *(const f32x4*)(bgate + bc), b1 = *(const f32x4*)(bgate + bc + 4);
#pragma unroll
                for (int ai = 0; ai < 2; ++ai)
#pragma unroll
                    for (int m = 0; m < 4; ++m) {
                        f32x4 v0 = acc[ai][bj][m][0] + b0, v1 = acc[ai][bj][m][1] + b1;
#pragma unroll
                        for (int i = 0; i < 4; ++i) { v0[i] = sigmoidf_fast(v0[i]); v1[i] = sigmoidf_fast(v1[i]); }
                        u32x4 w; w.x = cvt_pk_bf16(v0[0], v0[1]); w.y = cvt_pk_bf16(v0[2], v0[3]); w.z = cvt_pk_bf16(v1[0], v1[1]); w.w = cvt_pk_bf16(v1[2], v1[3]);
                        *(u32x4*)(gt + (size_t)(((ai * 4 + m) * 2 + bj) * 64) * 8) = w;
                    }
            }
        }
    }
};
struct EpiPlain {
    static constexpr bool PERM = true;
    bf16_t* O; bf16_t* O2; int ldc;
    __device__ __forceinline__ void operator()(const Acc& acc, const Unit& u, int wr, int wc, int fr, int fq) const {
        asm volatile("" : "+v"(fr), "+v"(fq));
        bf16_t* base = O; int pm = u.pm; if (O2 && pm >= 64) { base = O2; pm -= 64; }
        const int row0 = pm * BM + wr * 64 + fr, col0 = u.pn * BM + wc * 32 + 8 * fq;
#pragma unroll
        for (int ai = 0; ai < 2; ++ai)
#pragma unroll
            for (int m = 0; m < 4; ++m) { bf16_t* rowp = base + (size_t)(row0 + ai * HALF + m * 16) * ldc + col0;
#pragma unroll
                for (int bj = 0; bj < 2; ++bj) { const f32x4 v0 = acc[ai][bj][m][0], v1 = acc[ai][bj][m][1];
                    u32x4 w; w.x = cvt_pk_bf16(v0[0], v0[1]); w.y = cvt_pk_bf16(v0[2], v0[3]); w.z = cvt_pk_bf16(v1[0], v1[1]); w.w = cvt_pk_bf16(v1[2], v1[3]);
                    *(u32x4*)(rowp + bj * HALF) = w; } }
    }
};
template <int PASS> struct EpiMerge {
    static constexpr bool PERM = true;
    const bf16_t* G; bf16_t* ytmp; bf16_t* y;
    __device__ __forceinline__ void operator()(const Acc& acc, const Unit& u, int wr, int wc, int fr, int fq) const {
        asm volatile("" : "+v"(fr), "+v"(fq));
        const int lane = fr + 16 * fq, wid = wr * 4 + wc;
        const bf16_t* gt = G + ((size_t)(u.pm * 12 + PASS * 4 + u.pn) * 8192 + (size_t)wid * 1024 + lane) * 8;
        bf16_t* yt = ytmp + ((size_t)(u.pm * 4 + u.pn) * 8192 + (size_t)wid * 1024 + lane) * 8;
        const int row0 = u.pm * BM + wr * 64 + fr, col0 = u.pn * BM + wc * 32 + 8 * fq;
#pragma unroll
        for (int ai = 0; ai < 2; ++ai)
#pragma unroll
            for (int m = 0; m < 4; ++m)
#pragma unroll
                for (int bj = 0; bj < 2; ++bj) {
                    const size_t eo = (size_t)(((ai * 4 + m) * 2 + bj) * 64) * 8;
                    const u32x4 gw = *(const u32x4*)(gt + eo);
                    f32x4 v0 = acc[ai][bj][m][0] * (f32x4){bflo(gw.x), bfhi(gw.x), bflo(gw.y), bfhi(gw.y)}, v1 = acc[ai][bj][m][1] * (f32x4){bflo(gw.z), bfhi(gw.z), bflo(gw.w), bfhi(gw.w)};
                    if (PASS > 0) { const u32x4 o = *(const u32x4*)(yt + eo); v0 += (f32x4){bflo(o.x), bfhi(o.x), bflo(o.y), bfhi(o.y)}; v1 += (f32x4){bflo(o.z), bfhi(o.z), bflo(o.w), bfhi(o.w)}; }
                    u32x4 w; w.x = cvt_pk_bf16(v0[0], v0[1]); w.y = cvt_pk_bf16(v0[2], v0[3]); w.z = cvt_pk_bf16(v1[0], v1[1]); w.w = cvt_pk_bf16(v1[2], v1[3]);
                    if (PASS < 2) *(u32x4*)(yt + eo) = w;
                    else *(u32x4*)(y + (size_t)(row0 + ai * HALF + m * 16) * D + col0 + bj * HALF) = w;
                }
    }
};
struct EpiResid {
    static constexpr bool PERM = true;
    float* X; const float* gates;
    const float* Xin_lat; const float* Xin_ctx;
    __device__ __forceinline__ void operator()(const Acc& acc, const Unit& u, int wr, int wc, int fr, int fq) const {
        asm volatile("" : "+v"(fr), "+v"(fq));
        const int row0 = u.pm * BM + wr * 64 + fr, col0 = u.pn * BM + wc * 32 + 8 * fq;
        const int set = u.pm < 64 ? (u.pm >> 5) : 2;
        const float* gp = gates + set * 6144;
        const float* xin = u.pm < 64 ? Xin_lat + (size_t)row0 * D + col0 : Xin_ctx + (size_t)(row0 - TL) * D + col0;
        f32x4 gv[2][2];
#pragma unroll
        for (int bj = 0; bj < 2; ++bj)
#pragma unroll
            for (int n = 0; n < 2; ++n) gv[bj][n] = *(const f32x4*)(gp + col0 + bj * HALF + n * 4);
#pragma unroll
        for (int ai = 0; ai < 2; ++ai)
#pragma unroll
            for (int m = 0; m < 4; ++m) {
                const size_t ro = (size_t)(ai * HALF + m * 16) * D;
                float* rowp = X + (size_t)row0 * D + col0 + ro;
#pragma unroll
                for (int bj = 0; bj < 2; ++bj)
#pragma unroll
                    for (int n = 0; n < 2; ++n) { *(f32x4*)(rowp + bj * HALF + n * 4) = *(const f32x4*)(xin + ro + bj * HALF + n * 4) + gv[bj][n] * acc[ai][bj][m][n]; }
            }
    }
};
struct EpiCtxPart {
    static constexpr bool PERM = true;
    float* part; const float* gates;
    __device__ __forceinline__ void operator()(const Acc& acc, const Unit& u, int wr, int wc, int fr, int fq) const {
        asm volatile("" : "+v"(fr), "+v"(fq));
        const int row0 = (u.pm - 64) * BM + wr * 64 + fr, col0 = u.pn * BM + wc * 32 + 8 * fq;
        float* pb = part + (size_t)u.e * TC * D;
#pragma unroll
        for (int ai = 0; ai < 2; ++ai)
#pragma unroll
            for (int m = 0; m < 4; ++m) {
                float* rowp = pb + (size_t)(row0 + ai * HALF + m * 16) * D + col0;
#pragma unroll
                for (int bj = 0; bj < 2; ++bj)
#pragma unroll
                    for (int n = 0; n < 2; ++n) *(f32x4*)(rowp + bj * HALF + n * 4) = *(const f32x4*)(gates + col0 + bj * HALF + n * 4) * acc[ai][bj][m][n];
            }
    }
};
struct EpiSwiglu {
    static constexpr bool PERM = false;
    bf16_t* U; int ldu;
    __device__ __forceinline__ void operator()(const Acc& acc, const Unit& u, int wr, int wc, int fr, int fq) const {
        asm volatile("" : "+v"(fr), "+v"(fq));
        const int row0 = u.pm * BM + wr * 64 + fr;
#pragma unroll
        for (int ai = 0; ai < 2; ++ai)
#pragma unroll
            for (int m = 0; m < 4; ++m) {
                bf16_t* rowp = U + (size_t)(row0 + ai * HALF + m * 16) * ldu;
#pragma unroll
                for (int bj = 0; bj < 2; ++bj) {
                    const int gcol = u.pn * BM + bj * HALF + wc * 32;
                    const f32x4 a = acc[ai][bj][m][0], b = acc[ai][bj][m][1];
                    f32x4 o;
#pragma unroll
                    for (int i = 0; i < 4; ++i) o[i] = a[i] * sigmoidf_fast(a[i]) * b[i];
                    u32x2 w; w.x = cvt_pk_bf16(o[0], o[1]); w.y = cvt_pk_bf16(o[2], o[3]);
                    *(u32x2*)(rowp + (gcol >> 1) + 4 * fq) = w;
                }
            }
    }
};
struct EpiMoeDown {
    static constexpr bool PERM = true;
    bf16_t* Y; bf16_t* Y2;
    __device__ __forceinline__ void operator()(const Acc& acc, const Unit& u, int wr, int wc, int fr, int fq) const {
        asm volatile("" : "+v"(fr), "+v"(fq));
        bf16_t* base = u.s ? Y2 + (size_t)(u.pm - 128) * BM * D : Y + (size_t)u.pm * BM * D;
        const int row0 = wr * 64 + fr, col0 = u.pn * BM + wc * 32 + 8 * fq;
#pragma unroll
        for (int ai = 0; ai < 2; ++ai)
#pragma unroll
            for (int m = 0; m < 4; ++m) {
                bf16_t* rowp = base + (size_t)(row0 + ai * HALF + m * 16) * D + col0;
#pragma unroll
                for (int bj = 0; bj < 2; ++bj) { const f32x4 v0 = acc[ai][bj][m][0], v1 = acc[ai][bj][m][1];
                    u32x4 w; w.x = cvt_pk_bf16(v0[0], v0[1]); w.y = cvt_pk_bf16(v0[2], v0[3]); w.z = cvt_pk_bf16(v1[0], v1[1]); w.w = cvt_pk_bf16(v1[2], v1[3]);
                    *(u32x4*)(rowp + bj * HALF) = w; }
            }
    }
};
}

struct Params { const float* in[29]; float* out; unsigned char* ws; };
enum { I_X = 0, I_C, I_CTX, I_CCTX, I_WMOD, I_BMOD, I_GN1, I_WIN, I_BGATE, I_GQ, I_WUQ, I_GKV, I_WUKV, I_WPOOL, I_SPOOL, I_WOA, I_WOB, I_WOC, I_WOUT, I_GN2,
       I_FW1, I_FW3, I_FW2, I_ROUTER, I_RBIAS, I_MW1, I_MW3, I_MW2, I_GFINAL };

struct Ctx {
    LAS unsigned char* lds; int tid, lane, wave, G, bid, gw, ngw;
};

__device__ __forceinline__ Ctx fresh(const Ctx& C0) {
    Ctx C = C0; int w = C0.wave; asm volatile("" : "+s"(w)); int l = (int)__builtin_amdgcn_mbcnt_hi(~0u, __builtin_amdgcn_mbcnt_lo(~0u, 0u)); asm volatile("" : "+v"(l));
    C.wave = w; C.lane = l; C.tid = w * 64 + l; C.gw = C.bid * 8 + w; return C;
}
template <class RowMap>
__device__ __forceinline__ void tr_item(const float* src, int ldn, int k0, int n0, const float* kscale, bf16_t* dst, int dld, int dk0, RowMap rowmap, LAS float* scr, int lane) {
    float v[32];
#pragma unroll
    for (int i = 0; i < 32; ++i) { const int kk = 2 * i + (lane >> 5); v[i] = src[(size_t)(k0 + kk) * ldn + n0 + (lane & 31)]; }
    if (kscale) {
#pragma unroll
        for (int i = 0; i < 32; ++i) v[i] *= kscale[k0 + 2 * i + (lane >> 5)];
    }
#pragma unroll
    for (int i = 0; i < 32; ++i) scr[(2 * i + (lane >> 5)) * 33 + (lane & 31)] = v[i];
    LDS_WAIT(); asm volatile("" ::: "memory");
    const int c = lane & 7;
#pragma unroll
    for (int j = 0; j < 4; ++j) { const int n = (lane >> 3) + 8 * j; const LAS float* s = scr + (8 * c) * 33 + n;
        u32x4 o; o.x = cvt_pk_bf16(s[0 * 33], s[1 * 33]); o.y = cvt_pk_bf16(s[2 * 33], s[3 * 33]); o.z = cvt_pk_bf16(s[4 * 33], s[5 * 33]); o.w = cvt_pk_bf16(s[6 * 33], s[7 * 33]);
        *(u32x4*)(dst + (size_t)rowmap(n0 + n) * dld + dk0 + 8 * c) = o; }
    LDS_WAIT(); asm volatile("" ::: "memory");
}
struct RowId { __device__ __forceinline__ int operator()(int n) const { return n; } };
struct RowWin { __device__ __forceinline__ int operator()(int n) const { return n < OFF_GATE ? n : n + (PP - OFF_GATE); } };
struct RowQ { __device__ __forceinline__ int operator()(int n) const { const int h = n / QKD, d = n % QKD; if (d < 64) return n; const int j = d - 64, a = j >> 4, rh = (j >> 3) & 1, f = j & 7; return h * QKD + 64 + rh * 16 + a * 8 + f; } };
struct RowGU { int add; __device__ __forceinline__ int operator()(int n) const { return 32 * (n >> 4) + (n & 15) + add; } };

__device__ __forceinline__ void norm_row(const float* xrow, const float* g, const float* sh, const float* sc, bf16_t* drow, int lane, f32x4 (&v)[4]) {
    const f32x4* xr = (const f32x4*)xrow + lane;
    float s = 0.f;
#pragma unroll
    for (int j = 0; j < 4; ++j) { v[j] = xr[64 * j]; s += (v[j][0] * v[j][0] + v[j][1] * v[j][1]) + (v[j][2] * v[j][2] + v[j][3] * v[j][3]); }
    const float rstd = __builtin_amdgcn_rsqf(wave_sum(s, lane) * (1.0f / D) + EPS);
#pragma unroll
    for (int j = 0; j < 4; ++j) {
        const f32x4 gg = *((const f32x4*)g + lane + 64 * j), s1 = *((const f32x4*)sc + lane + 64 * j), s0 = *((const f32x4*)sh + lane + 64 * j);
        v[j] = v[j] * rstd * gg * (s1 + 1.0f) + s0;
        u32x2 w; w.x = cvt_pk_bf16(v[j][0], v[j][1]); w.y = cvt_pk_bf16(v[j][2], v[j][3]);
        *((u32x2*)drow + lane + 64 * j) = w;
    }
}
__device__ __forceinline__ void norm_rows(const float* xrow0, int nr, const float* gn, const float* mp, bf16_t* drow0, int lane) {
    f32x4 gsc[4], shv[4], xn[4];
#pragma unroll
    for (int j = 0; j < 4; ++j) { const f32x4 gg = *((const f32x4*)gn + lane + 64 * j), s1 = *((const f32x4*)(mp + 1024) + lane + 64 * j); gsc[j] = gg * (s1 + 1.0f); shv[j] = *((const f32x4*)mp + lane + 64 * j);
        xn[j] = *((const f32x4*)xrow0 + lane + 64 * j); }
#pragma unroll 1
    for (int rr = 0; rr < nr; ++rr) {
        f32x4 v[4];
#pragma unroll
        for (int j = 0; j < 4; ++j) v[j] = xn[j];
        if (rr + 1 < nr) {
#pragma unroll
            for (int j = 0; j < 4; ++j) xn[j] = *((const f32x4*)(xrow0 + (size_t)(rr + 1) * D) + lane + 64 * j);
        }
        float ssx = 0.f;
#pragma unroll
        for (int j = 0; j < 4; ++j) ssx += (v[j][0] * v[j][0] + v[j][1] * v[j][1]) + (v[j][2] * v[j][2] + v[j][3] * v[j][3]);
        const float rstd = __builtin_amdgcn_rsqf(wave_sum(ssx, lane) * (1.0f / D) + EPS);
#pragma unroll
        for (int j = 0; j < 4; ++j) { const f32x4 o = v[j] * rstd * gsc[j] + shv[j]; u32x2 w; w.x = cvt_pk_bf16(o[0], o[1]); w.y = cvt_pk_bf16(o[2], o[3]); *((u32x2*)(drow0 + (size_t)rr * D) + lane + 64 * j) = w; }
    }
}
__device__ __forceinline__ void norm_ctx_row(const float* xsrc, const float* part, int nsl, float* xdst, const float* gn, const float* mp, bf16_t* drow, int lane) {
    f32x4 v[4];
#pragma unroll
    for (int j = 0; j < 4; ++j) v[j] = *((const f32x4*)xsrc + lane + 64 * j);
    for (int s = 0; s < nsl; ++s) {
#pragma unroll
        for (int j = 0; j < 4; ++j) v[j] += *((const f32x4*)(part + (size_t)s * TC * D) + lane + 64 * j);
    }
    float ssx = 0.f;
#pragma unroll
    for (int j = 0; j < 4; ++j) { if (xdst) *((f32x4*)xdst + lane + 64 * j) = v[j]; ssx += (v[j][0] * v[j][0] + v[j][1] * v[j][1]) + (v[j][2] * v[j][2] + v[j][3] * v[j][3]); }
    const float rstd = __builtin_amdgcn_rsqf(wave_sum(ssx, lane) * (1.0f / D) + EPS);
#pragma unroll
    for (int j = 0; j < 4; ++j) { const f32x4 gg = *((const f32x4*)gn + lane + 64 * j), s1 = *((const f32x4*)(mp + 1024) + lane + 64 * j), s0 = *((const f32x4*)mp + lane + 64 * j);
        const f32x4 o = v[j] * rstd * gg * (s1 + 1.0f) + s0; u32x2 w; w.x = cvt_pk_bf16(o[0], o[1]); w.y = cvt_pk_bf16(o[2], o[3]); *((u32x2*)drow + lane + 64 * j) = w; }
}
__device__ __forceinline__ void norm_phase(const Ctx& C, const float* xlat, const float* xctx, const float* gn, const float* mods_l, int which, bf16_t* dst, int nrows, const float* part = nullptr, int nsl = 0, float* xdst = nullptr) {
    for (int ch = C.gw; ch < TL / 8; ch += C.ngw) { const int row = ch * 8; norm_rows(xlat + (size_t)row * D, 8, gn, mods_l + (row >> 13) * 6144 + which * 3072, dst + (size_t)row * D, C.lane); }
    if (nrows > TL) for (int r = C.gw; r < TC; r += C.ngw) {
        if (nsl > 0) norm_ctx_row(xctx + (size_t)r * D, part + (size_t)r * D, nsl, xdst ? xdst + (size_t)r * D : nullptr, gn, mods_l + 2 * 6144 + which * 3072, dst + (size_t)(TL + r) * D, C.lane);
        else norm_rows(xctx + (size_t)r * D, 1, gn, mods_l + 2 * 6144 + which * 3072, dst + (size_t)(TL + r) * D, C.lane);
    }
}

constexpr int FX_LD = 272;
template <class AL, class BL, class EP>
__device__ __forceinline__ void flex_tile(const Ctx& C, int KC, AL aload, BL bload, EP epi) {
    LAS unsigned char* As = C.lds; LAS unsigned char* Bs = C.lds + 128 * FX_LD;
    const int wm = C.wave >> 1, wn = C.wave & 1, r32 = C.lane & 31, hi = C.lane >> 5;
    f32x16 acc[2];
#pragma unroll
    for (int j = 0; j < 2; ++j)
#pragma unroll
        for (int r = 0; r < 16; ++r) acc[j][r] = 0.f;
    for (int kc = 0; kc < KC; kc += 128) {
        __syncthreads();
#pragma unroll
        for (int i = 0; i < 4; ++i) { const int task = C.tid + 512 * i, m = task & 127, c8 = task >> 7;
            const bf16x8 va = aload(m, kc + c8 * 8); *(LAS bf16x8*)(As + m * FX_LD + c8 * 16) = va;
            const bf16x8 vb = bload(m, kc + c8 * 8); *(LAS bf16x8*)(Bs + m * FX_LD + c8 * 16) = vb; }
        __syncthreads();
#pragma unroll
        for (int s = 0; s < 8; ++s) {
            const bf16x8 a = *(const LAS bf16x8*)(As + (32 * wm + r32) * FX_LD + (2 * s + hi) * 16);
#pragma unroll
            for (int j = 0; j < 2; ++j) { const bf16x8 b = *(const LAS bf16x8*)(Bs + (64 * wn + 32 * j + r32) * FX_LD + (2 * s + hi) * 16);
                acc[j] = __builtin_amdgcn_mfma_f32_32x32x16_bf16(b, a, acc[j], 0, 0, 0); }
        }
    }
    const int m = 32 * wm + r32;
#pragma unroll
    for (int j = 0; j < 2; ++j)
#pragma unroll
        for (int r = 0; r < 16; r += 2) epi(m, 64 * wn + 32 * j + crow(r, hi), acc[j][r], acc[j][r + 1]);
}
__device__ __forceinline__ bf16x8 gather8(const bf16_t* p, size_t ld) {
    bf16x8 v;
#pragma unroll
    for (int t = 0; t < 8; ++t) v[t] = (short)p[(size_t)t * ld];
    return v;
}

struct TT { static constexpr bool value = true; }; struct FF { static constexpr bool value = false; };
constexpr int AT_KT = 128;
constexpr int AT_KLD = 208, AT_VLD = 264, AT_KB = AT_KT * AT_KLD, AT_VB = 64 * AT_VLD, AT_VOFF = 2 * AT_KB;
__device__ __forceinline__ void attn_unit(const Ctx& C, const bf16_t* Q, const bf16_t* Kb, const bf16_t* Vt, bf16_t* O, const float* ssqp, const float* ropep, int b, int h, int qrow0, int NT) {
    const int tid = C.tid, lane = C.lane, wid = C.wave, r32 = lane & 31, hi = lane >> 5;
    LAS unsigned char* L = C.lds;
    const bf16_t* Kh = Kb + (size_t)(b * NH + h) * NKEY * QKD;
    const bf16_t* Vh = Vt + (size_t)(b * NH + h) * VD * NKEY;
    const int qrow = qrow0 + wid * 32 + r32;
    bf16x8 qr[6];
    { const bf16_t* qp = Q + (size_t)qrow * 768 + h * QKD + hi * 8;
      u32x4 raw[6];
#pragma unroll
      for (int s = 0; s < 6; ++s) raw[s] = *(const u32x4*)(qp + 16 * s);
      float rq;
      { const float* sp = ssqp + (size_t)qrow * 20; const f32x4 a = *(const f32x4*)sp, b2 = *(const f32x4*)(sp + 4), c = *(const f32x4*)(sp + 8);
        rq = __builtin_amdgcn_rsqf((((a[0] + a[1]) + (a[2] + a[3])) + ((b2[0] + b2[1]) + (b2[2] + b2[3])) + ((c[0] + c[1]) + (c[2] + c[3]))) * (1.0f / QL) + EPS) * QSCALE; }
#pragma unroll
      for (int s = 0; s < 4; ++s) { u32x4 o; const unsigned wv[4] = {raw[s].x, raw[s].y, raw[s].z, raw[s].w}; unsigned ov[4];
#pragma unroll
          for (int q = 0; q < 4; ++q) ov[q] = cvt_pk_bf16(bflo(wv[q]) * rq, bfhi(wv[q]) * rq);
          o.x = ov[0]; o.y = ov[1]; o.z = ov[2]; o.w = ov[3]; qr[s] = __builtin_bit_cast(bf16x8, o); }
      float cs[8], sn[8];
      if (qrow < TL) { const int l = qrow & (SEQ - 1), pos = hi ? (l & 63) : (l >> 6); const float* rp = ropep + pos * 16;
#pragma unroll
          for (int q = 0; q < 4; ++q) { const f32x4 t = *(const f32x4*)(rp + 4 * q); cs[2 * q] = t[0]; sn[2 * q] = t[1]; cs[2 * q + 1] = t[2]; sn[2 * q + 1] = t[3]; } }
      else {
#pragma unroll
          for (int j = 0; j < 8; ++j) { cs[j] = 1.f; sn[j] = 0.f; } }
      const unsigned w1[4] = {raw[4].x, raw[4].y, raw[4].z, raw[4].w}, w2[4] = {raw[5].x, raw[5].y, raw[5].z, raw[5].w}; unsigned o1[4], o2[4];
#pragma unroll
      for (int q = 0; q < 4; ++q) { const float a0 = bflo(w1[q]), a1 = bfhi(w1[q]), b0 = bflo(w2[q]), b1 = bfhi(w2[q]);
          o1[q] = cvt_pk_bf16((a0 * cs[2 * q] - b0 * sn[2 * q]) * rq, (a1 * cs[2 * q + 1] - b1 * sn[2 * q + 1]) * rq);
          o2[q] = cvt_pk_bf16((b0 * cs[2 * q] + a0 * sn[2 * q]) * rq, (b1 * cs[2 * q + 1] + a1 * sn[2 * q + 1]) * rq); }
      qr[4] = __builtin_bit_cast(bf16x8, ((u32x4){o1[0], o1[1], o1[2], o1[3]})); qr[5] = __builtin_bit_cast(bf16x8, ((u32x4){o2[0], o2[1], o2[2], o2[3]})); }
    int kdst[3], vdst[2]; const bf16_t* vsrc[2];
#pragma unroll
    for (int i = 0; i < 3; ++i) { const int id = tid + 512 * i; kdst[i] = (id / 12) * AT_KLD + (id % 12) * 16; }
#pragma unroll
    for (int i = 0; i < 2; ++i) { const int id = tid + 512 * i, d = id >> 4, ch = id & 15; vdst[i] = AT_VOFF + d * AT_VLD + ch * 16; vsrc[i] = Vh + (size_t)d * NKEY + ch * 8; }
    const bf16_t* ksrc = Kh + (size_t)tid * 8;
    u32x4 kr[3], vr[2];
#pragma unroll
    for (int i = 0; i < 3; ++i) kr[i] = *(const u32x4*)(ksrc + 4096 * i);
#pragma unroll
    for (int i = 0; i < 2; ++i) vr[i] = *(const u32x4*)vsrc[i];
    __syncthreads();
#pragma unroll
    for (int i = 0; i < 3; ++i) *(LAS u32x4*)(L + kdst[i]) = kr[i];
#pragma unroll
    for (int i = 0; i < 2; ++i) { *(LAS u32x2*)(L + vdst[i]) = (u32x2){vr[i].x, vr[i].y}; *(LAS u32x2*)(L + vdst[i] + 8) = (u32x2){vr[i].z, vr[i].w}; }
    __syncthreads();
    constexpr float ATHR = 8.0f;
    float mrun = 0.f, lsum = 0.f;
    f32x16 o0, o1, negm;
#pragma unroll
    for (int r = 0; r < 16; ++r) { o0[r] = 0.f; o1[r] = 0.f; negm[r] = 0.f; }
    auto tile = [&](const int t, auto first) {
        constexpr bool FIRST = decltype(first)::value;
        const int buf = t & 1;
        const bool more = (t + 1 < NT);
        if (more) {
#pragma unroll
            for (int i = 0; i < 3; ++i) kr[i] = *(const u32x4*)(ksrc + (size_t)(t + 1) * (AT_KT * QKD) + 4096 * i);
#pragma unroll
            for (int i = 0; i < 2; ++i) vr[i] = *(const u32x4*)(vsrc[i] + (size_t)(t + 1) * AT_KT);
        }
        const LAS unsigned char* Kt = L + buf * AT_KB; const LAS unsigned char* Vtile = L + AT_VOFF + buf * AT_VB;
        f32x16 p[4];
#pragma unroll
        for (int kb = 0; kb < 4; ++kb)
#pragma unroll
            for (int s = 0; s < 6; ++s) {
                const bf16x8 kf = *(const LAS bf16x8*)(Kt + (32 * kb + r32) * AT_KLD + (2 * s + hi) * 16);
                p[kb] = __builtin_amdgcn_mfma_f32_32x32x16_bf16(kf, qr[s], s == 0 ? negm : p[kb], 0, 0, 0);
            }
        float mx = fmaxf(fmaxf(p[0][0], p[0][1]), p[0][2]);
#pragma unroll
        for (int kb = 0; kb < 4; ++kb)
#pragma unroll
            for (int r = (kb == 0 ? 3 : 0); r + 1 < 16 + (kb == 0 ? 1 : 0); r += 2) { if (r + 1 < 16) mx = fmaxf(fmaxf(mx, p[kb][r]), p[kb][r + 1]); else mx = fmaxf(mx, p[kb][r]); }
        if constexpr (FIRST) {
            if (__any(mx < -64.0f)) {
                mx = fmaxf(mx, shx(mx, 32, lane)); const float dl = fminf(mx, 0.f); mrun = dl;
#pragma unroll
                for (int kb = 0; kb < 4; ++kb)
#pragma unroll
                    for (int r = 0; r < 16; ++r) p[kb][r] -= dl;
#pragma unroll
                for (int r = 0; r < 16; ++r) negm[r] = -dl;
                mx -= dl;
            }
        }
        if (__any(mx > ATHR)) {
            mx = fmaxf(mx, shx(mx, 32, lane));
            const float dl = fmaxf(mx, 0.f); mrun += dl;
            const float alpha = __builtin_amdgcn_exp2f(-dl);
            lsum *= alpha;
#pragma unroll
            for (int kb = 0; kb < 4; ++kb)
#pragma unroll
                for (int r = 0; r < 16; ++r) p[kb][r] -= dl;
#pragma unroll
            for (int r = 0; r < 16; ++r) { o0[r] *= alpha; o1[r] *= alpha; negm[r] = -mrun; }
        }
        f32x2 sa = (f32x2){0.f, 0.f};
#pragma unroll
        for (int hf = 0; hf < 2; ++hf) {
            bf16x8 pf[4];
#pragma unroll
            for (int kq = 0; kq < 2; ++kq) { const int kb = 2 * hf + kq;
#pragma unroll
                for (int r = 0; r < 16; ++r) p[kb][r] = __builtin_amdgcn_exp2f(p[kb][r]);
#pragma unroll
                for (int r = 0; r < 16; r += 2) sa += (f32x2){p[kb][r], p[kb][r + 1]};
#pragma unroll
                for (int s2 = 0; s2 < 2; ++s2) { u32x4 w; w.x = cvt_pk_bf16(p[kb][8 * s2 + 0], p[kb][8 * s2 + 1]); w.y = cvt_pk_bf16(p[kb][8 * s2 + 2], p[kb][8 * s2 + 3]); w.z = cvt_pk_bf16(p[kb][8 * s2 + 4], p[kb][8 * s2 + 5]); w.w = cvt_pk_bf16(p[kb][8 * s2 + 6], p[kb][8 * s2 + 7]);
                    pf[2 * kq + s2] = __builtin_bit_cast(bf16x8, w); }
            }
#pragma unroll
            for (int sq = 0; sq < 4; ++sq) {
                const int st = 4 * hf + sq, ko = (16 * st + 4 * hi) * 2;
                { const s16x4 lo = *(const LAS s16x4*)(Vtile + r32 * AT_VLD + ko), h4 = *(const LAS s16x4*)(Vtile + r32 * AT_VLD + ko + 16);
                  const bf16x8 vf = (bf16x8){lo[0], lo[1], lo[2], lo[3], h4[0], h4[1], h4[2], h4[3]};
                  o0 = __builtin_amdgcn_mfma_f32_32x32x16_bf16(vf, pf[sq], o0, 0, 0, 0); }
                { const s16x4 lo = *(const LAS s16x4*)(Vtile + (32 + r32) * AT_VLD + ko), h4 = *(const LAS s16x4*)(Vtile + (32 + r32) * AT_VLD + ko + 16);
                  const bf16x8 vf = (bf16x8){lo[0], lo[1], lo[2], lo[3], h4[0], h4[1], h4[2], h4[3]};
                  o1 = __builtin_amdgcn_mfma_f32_32x32x16_bf16(vf, pf[sq], o1, 0, 0, 0); }
            }
        }
        lsum += sa[0] + sa[1];
        if (more) {
            LAS unsigned char* Ln = L + (buf ^ 1) * AT_KB; LAS unsigned char* Vn = L + (buf ^ 1) * AT_VB;
#pragma unroll
            for (int i = 0; i < 3; ++i) *(LAS u32x4*)(Ln + kdst[i]) = kr[i];
#pragma unroll
            for (int i = 0; i < 2; ++i) { *(LAS u32x2*)(Vn + vdst[i]) = (u32x2){vr[i].x, vr[i].y}; *(LAS u32x2*)(Vn + vdst[i] + 8) = (u32x2){vr[i].z, vr[i].w}; }
        }
        __syncthreads();
    };
    tile(0, TT{});
    for (int t = 1; t < NT; ++t) tile(t, FF{});
    lsum += shx(lsum, 32, lane);
    const float inv = __builtin_amdgcn_rcpf(lsum);
    bf16_t* op = O + (size_t)qrow * 512 + h * VD + 4 * hi;
#pragma unroll
    for (int g = 0; g < 4; ++g) {
        u32x2 w0, w1;
        w0.x = cvt_pk_bf16(o0[4 * g] * inv, o0[4 * g + 1] * inv); w0.y = cvt_pk_bf16(o0[4 * g + 2] * inv, o0[4 * g + 3] * inv);
        w1.x = cvt_pk_bf16(o1[4 * g] * inv, o1[4 * g + 1] * inv); w1.y = cvt_pk_bf16(o1[4 * g + 2] * inv, o1[4 * g + 3] * inv);
        *(u32x2*)(op + 8 * g) = w0; *(u32x2*)(op + 32 + 8 * g) = w1;
    }
}

#ifndef PH
#define PH 0xFFFFFFFFu
#endif
#define PHON(k) ((PH >> (k)) & 1u)
#define PHASE_WS unsigned char* ws = ws0; asm volatile("" : "+s"(ws));
#define PHASE_CTX PHASE_WS const Ctx& Cb_ = C; const Ctx C = fresh(Cb_);

#ifndef DBG
#define DBG 0
#endif
constexpr int CW_DBG = 64;
__device__ __forceinline__ void dbg_scan(const Ctx& C, unsigned char* ws, const void* p, size_t nbytes, bool isf32, int id) {
#if DBG
    const size_t n16 = nbytes / 16; bool bad = false;
    for (size_t i = (size_t)C.bid * 512 + C.tid; i < n16; i += (size_t)C.G * 512) {
        const u32x4 v = ((const u32x4*)p)[i]; const unsigned w[4] = {v.x, v.y, v.z, v.w};
#pragma unroll
        for (int q = 0; q < 4; ++q) { if (isf32) bad |= ((w[q] & 0x7F800000u) >= (145u << 23)); else bad |= ((w[q] & 0x7F80u) >= (145u << 7)) || ((w[q] & 0x7F800000u) >= (145u << 23)); }
    }
    if (bad) atomicMax((unsigned*)(ws + WS_CTL) + CW_DBG, (unsigned)(100 - id));
#endif
}
__device__ __forceinline__ void dbg_max(const Ctx& C, unsigned char* ws, const void* p, size_t nbytes, int slot) {
    const size_t n16 = nbytes / 16; unsigned mx = 0u;
    for (size_t i = (size_t)C.bid * 512 + C.tid; i < n16; i += (size_t)C.G * 512) {
        const u32x4 v = ((const u32x4*)p)[i]; const unsigned w[4] = {v.x, v.y, v.z, v.w};
#pragma unroll
        for (int q = 0; q < 4; ++q) { const unsigned a = (w[q] & 0x7FFFu) << 16, b = w[q] & 0x7FFF0000u; mx = a > mx ? a : mx; mx = b > mx ? b : mx; }
    }
    if (mx > 0x7E000000u) mx = 0x7E000000u;
    atomicMax((unsigned*)(ws + WS_CTL) + CW_DBG + 1 + slot, mx);
}
#define DBGMAX(p, nbytes, slot) do { if (DBG) { PHASE_CTX dbg_max(C, ws, (p), (nbytes), (slot)); } } while (0)
#define DBGSCAN(p, nbytes, isf32, id) do { if (DBG) { PHASE_CTX dbg_scan(C, ws, (p), (nbytes), (isf32), (id)); } } while (0)
#define GRID_BAR() xcd_barrier(bar, C.wave)
#define mods ((float*)(ws + WS_MODS))
#define ropet ((float*)(ws + WS_ROPE))
#define twt ((float*)(ws + WS_TW))
#define dft128 ((bf16_t*)(ws + WS_DFT128))
#define m64 ((bf16_t*)(ws + WS_M64))
#define dft256 ((bf16_t*)(ws + WS_DFT256))
#define ssq ((float*)(ws + WS_SSQ))
#define xw ((float*)(ws + WS_XW))
#define Pb ((bf16_t*)(ws + WS_P))
#define Gt ((bf16_t*)(ws + WS_G))
#define A1 ((bf16_t*)(ws + WS_A1))
#define Qb ((bf16_t*)(ws + WS_Q))
#define Kb ((bf16_t*)(ws + WS_K))
#define Vtb ((bf16_t*)(ws + WS_VT))
#define ytmp ((float*)(ws + WS_A2))
#define AO ((bf16_t*)(ws + WS_AO))
#define MIXb ((bf16_t*)(ws + WS_MIX))
#define YY ((bf16_t*)(ws + WS_YY))
template <int layer>
__device__ __forceinline__ void layer_body(const Ctx& C, const Params& prm, unsigned char* ws0, const XcdBarrier& bar) {
    constexpr bool last = (layer == 1);
        const int nrt = last ? 64 : 66;
#define mods_l (mods + (size_t)layer * 3 * 6144)
#define lw (ws + WS_PERM + (size_t)layer * LW_SIZE)
        if (PHON(2)) { PHASE_WS
            pg8::Gemm g{A1, (const bf16_t*)(lw + LW_IN), 1024, 1024, 1024, 0};
            pg8::GridOrder S; S.init(nrt, NIN / 256, C.G, C.bid);
            if (last) { S.xm0 = 64; S.xn0 = 1; S.xnm = 2; S.nX = 4; }
            pg8::EpiWin E{Pb, Gt, prm.in[I_BGATE] + layer * 3072, ssq};
            pg8::gemm_phase<pg8::EpiWin, pg8::GridOrder, true>(C.lds, g, S, E, C.wave);
        }
        GRID_BAR();
        DBGSCAN(Pb, (size_t)nrt * 256 * NIN * 2, false, 15 * layer + 3); DBGSCAN(ssq, (size_t)nrt * 256 * 20 * 4, true, 15 * layer + 3);
        {
            if (PHON(3)) { PHASE_WS pg8::Gemm g{Pb, (const bf16_t*)(lw + LW_UQ), PP, QL, QL, 0};
              pg8::GridOrder S; S.init(nrt, 3, C.G, C.bid);
              pg8::EpiPlain E{Qb, nullptr, 768};
              pg8::gemm_phase<pg8::EpiPlain, pg8::GridOrder, true>(C.lds, g, S, E, C.wave); }
            if (PHON(4)) { PHASE_CTX
              pg8::Gemm g{Pb + OFF_KV, (const bf16_t*)(lw + LW_UKV), PP, KVL, KVL, 0};
              pg8::GridOrder S; S.init(66, 4, C.G, (C.bid + C.G / 2) % C.G);
              pg8::EpiPlain E{YY, AO, 1024};
              pg8::gemm_phase<pg8::EpiPlain, pg8::GridOrder, true>(C.lds, g, S, E, C.wave);
              VM_WAIT(); __syncthreads();
              pg8::Unit u;
              for (int i = 0; S.next(i, u); ++i) {
                  const bool lat = u.pm < 64;
                  const int bb = lat ? (u.pm >> 5) : (u.pm - 64), key0 = lat ? (NCTX + (u.pm & 31) * 256) : 0;
                  const int row = C.tid >> 1, hh = C.tid & 1, grow = u.pm * 256 + row;
                  const bf16_t* rawrow = (lat ? YY + (size_t)grow * 1024 : AO + (size_t)(grow - TL) * 1024) + u.pn * 256 + hh * 128;
                  float r;
                  { const float* sp = ssq + (size_t)grow * 20 + 12; const f32x4 a = *(const f32x4*)sp, b = *(const f32x4*)(sp + 4);
                    r = __builtin_amdgcn_rsqf((((a[0] + a[1]) + (a[2] + a[3])) + ((b[0] + b[1]) + (b[2] + b[3]))) * (1.0f / KVL) + EPS); }
                  const int h = u.pn * 2 + hh;
                  { bf16_t* kdst = Kb + ((size_t)(bb * NH + h) * NKEY + key0 + row) * QKD;
#pragma unroll
                    for (int c = 0; c < 8; ++c) { const u32x4 v = *(const u32x4*)(rawrow + 8 * c); u32x4 o;
                        o.x = cvt_pk_bf16(bflo(v.x) * r, bfhi(v.x) * r); o.y = cvt_pk_bf16(bflo(v.y) * r, bfhi(v.y) * r); o.z = cvt_pk_bf16(bflo(v.z) * r, bfhi(v.z) * r); o.w = cvt_pk_bf16(bflo(v.w) * r, bfhi(v.w) * r);
                        *(u32x4*)(kdst + 8 * c) = o; } }
                  constexpr int VSLD = 528;
#pragma unroll 1
                  for (int hv = 0; hv < 2; ++hv) {
                      __syncthreads();
                      { const bf16_t* vr = rawrow - hh * 128 + hv * 128 + 64 + hh * 32;
#pragma unroll
                        for (int c = 0; c < 4; ++c) { const u32x4 v = *(const u32x4*)(vr + 8 * c); const unsigned wv[4] = {v.x, v.y, v.z, v.w};
#pragma unroll
                            for (int q = 0; q < 4; ++q) { const unsigned pk = cvt_pk_bf16(bflo(wv[q]) * r, bfhi(wv[q]) * r); const int d = hh * 32 + c * 8 + q * 2;
                                *(LAS bf16_t*)(C.lds + d * VSLD + row * 2) = (bf16_t)(pk & 0xffffu); *(LAS bf16_t*)(C.lds + (d + 1) * VSLD + row * 2) = (bf16_t)(pk >> 16); } } }
                      __syncthreads();
                      { const int d = C.tid >> 3, ch = C.tid & 7; bf16_t* vdst = Vtb + ((size_t)(bb * NH + u.pn * 2 + hv) * VD + d) * NKEY + key0;
#pragma unroll
                        for (int c = 0; c < 4; ++c) { const int k8 = ch * 4 + c; *(u32x4*)(vdst + 8 * k8) = *(const LAS u32x4*)(C.lds + d * VSLD + k8 * 16); } }
                  }
                  __syncthreads();
              } }
            if (PHON(5)) { PHASE_CTX for (int row = C.gw; row < T; row += C.ngw) {
                const bool lat = row < TL;
                const int t = lat ? (row & (SEQ - 1)) : ((row - TL) & 255), Ls = lat ? SEQ : NCTX;
                if (lat || !last) {
                    const int g = C.lane >> 4, w = 2 << g, left = w >> 1, right = w - 1 - left;
                    const int lo = max(t - left, 0), hiE = min(t + right + 1, Ls);
                    float s[8] = {0.f, 0.f, 0.f, 0.f, 0.f, 0.f, 0.f, 0.f};
                    const bf16_t* base = Pb + (size_t)(row - t) * PP + OFF_POOL + C.lane * 8;
                    u32x4 wv[16];
#pragma unroll
                    for (int j = 0; j < 16; ++j) { const int tt = t + j - 8; wv[j] = (tt >= lo && tt < hiE) ? *(const u32x4*)(base + (size_t)tt * PP) : (u32x4){0u, 0u, 0u, 0u}; }
#pragma unroll
                    for (int j = 0; j < 16; ++j) { const u32x4 v = wv[j];
                        s[0] += bflo(v.x); s[1] += bfhi(v.x); s[2] += bflo(v.y); s[3] += bfhi(v.y); s[4] += bflo(v.z); s[5] += bfhi(v.z); s[6] += bflo(v.w); s[7] += bfhi(v.w); }
                    const u32x4 me = wv[8];
                    const float ic = 1.0f / (float)(hiE - lo);
                    u32x4 o; o.x = cvt_pk_bf16(s[0] * ic - bflo(me.x), s[1] * ic - bfhi(me.x)); o.y = cvt_pk_bf16(s[2] * ic - bflo(me.y), s[3] * ic - bfhi(me.y));
                    o.z = cvt_pk_bf16(s[4] * ic - bflo(me.z), s[5] * ic - bfhi(me.z)); o.w = cvt_pk_bf16(s[6] * ic - bflo(me.w), s[7] * ic - bfhi(me.w));
                    *(u32x4*)(MIXb + (size_t)row * 512 + C.lane * 8) = o;
                }
                if (C.lane < 16) {
                    const int a = C.lane >> 3, f = C.lane & 7;
                    const float x1 = bf2f(Pb[(size_t)row * PP + OFF_KR + a * 16 + f]), x2 = bf2f(Pb[(size_t)row * PP + OFF_KR + a * 16 + 8 + f]);
                    float cs = 1.f, sn = 0.f;
                    if (lat) { const int pos = a ? (t & 63) : (t >> 6); cs = ropet[(pos * 8 + f) * 2]; sn = ropet[(pos * 8 + f) * 2 + 1]; }
                    const bf16_t o1 = f2bf(x1 * cs - x2 * sn), o2 = f2bf(x2 * cs + x1 * sn);
                    const int bb = lat ? (row >> 13) : ((row - TL) >> 8), key = lat ? (NCTX + t) : t;
#pragma unroll
                    for (int h = 0; h < NH; ++h) { bf16_t* kp = Kb + ((size_t)(bb * NH + h) * NKEY + key) * QKD + 64 + a * 8 + f; kp[0] = o1; kp[16] = o2; }
                }
            } }
            if (PHON(6)) { PHASE_CTX for (int un = C.bid; un < 1024; un += C.G) {
                const int nch = un & 1, cch = (un >> 1) & 3, l2 = (un >> 3) & 63, b = un >> 9;
                const bf16_t* src = Pb + (size_t)(b * SEQ + l2) * PP + OFF_FFT + cch * 128;
                flex_tile(C, 128,
                    [&](int m, int k) { return gather8(src + (size_t)k * 64 * PP + m, (size_t)64 * PP); },
                    [&](int n, int k) { return *(const bf16x8*)(dft128 + (size_t)(nch * 128 + n) * 128 + k); },
                    [&](int m, int n, float re, float im) {
                        const int k1 = (nch * 128 + n) >> 1; const float tc = twt[(k1 * 64 + l2) * 2], ts = twt[(k1 * 64 + l2) * 2 + 1];
                        bf16_t* dp = A1 + ((size_t)((b * 128 + k1) * 64 + l2) * 2) * 512 + cch * 128 + m;
                        dp[0] = f2bf(re * tc + im * ts); dp[512] = f2bf(im * tc - re * ts); });
            } }
            if (PHON(7) && !last) { PHASE_CTX for (int un = C.bid; un < 32; un += C.G) {
                const int nch = un & 3, cch = (un >> 2) & 3, b = un >> 4;
                const bf16_t* src = Pb + (size_t)(TL + b * NCTX) * PP + OFF_FFT + cch * 128;
                flex_tile(C, 256,
                    [&](int m, int k) { return gather8(src + (size_t)k * PP + m, (size_t)PP); },
                    [&](int n, int k) { return *(const bf16x8*)(dft256 + (size_t)(nch * 128 + n) * 256 + k); },
                    [&](int m, int n, float re, float im) {
                        const int kf = (nch * 128 + n) >> 1;
                        bf16_t* dp = YY + (size_t)(TL + b * NCTX + kf) * 1024 + cch * 256 + m;
                        dp[0] = f2bf(re * 5.656854249f); dp[128] = f2bf(im * 5.656854249f); });
            } }
        }
        GRID_BAR();
        DBGSCAN(Qb, (size_t)nrt * 256 * 768 * 2, false, 15 * layer + 4); DBGSCAN(Kb, (size_t)NB * NH * NKEY * QKD * 2, false, 15 * layer + 4); DBGSCAN(Vtb, (size_t)NB * NH * VD * NKEY * 2, false, 15 * layer + 4);
        DBGSCAN(MIXb, (size_t)nrt * 256 * 512 * 2, false, 15 * layer + 5); DBGSCAN(A1, (size_t)TL * 1024 * 2, false, 15 * layer + 5); if (!last) DBGSCAN(YY + (size_t)TL * 1024, (size_t)TC * 1024 * 2, false, 15 * layer + 5);
        {
            if (PHON(8)) { PHASE_CTX for (int un = C.bid; un < 1024; un += C.G) {
                const int cch = un & 3, k1 = (un >> 2) & 127, b = un >> 9;
                const bf16_t* src = A1 + (size_t)((b * 128 + k1) * 128) * 512 + cch * 128;
                flex_tile(C, 128,
                    [&](int m, int k) { return gather8(src + (size_t)k * 512 + m, (size_t)512); },
                    [&](int n, int k) { return *(const bf16x8*)(m64 + (size_t)n * 128 + k); },
                    [&](int m, int n, float yr, float yi) {
                        const int k2 = n >> 1;
                        bf16_t* dp = YY + (size_t)(b * SEQ + k1 + 128 * k2) * 1024 + cch * 256 + m;
                        dp[0] = f2bf(yr); dp[128] = f2bf(yi); });
            } }
            __syncthreads();
            const int vcu = (C.G % 8 == 0) ? (C.bid % 8) * (C.G / 8) + C.bid / 8 : C.bid;
            if (PHON(9)) { PHASE_CTX for (int un = vcu; un < 512; un += C.G) { const int bh = un >> 5, qb = un & 31; attn_unit(C, Qb, Kb, Vtb, AO, ssq, ropet, bh >> 3, bh & 7, (bh >> 3) * SEQ + qb * 256, NKEY / AT_KT); } }
            if (PHON(9) && !last) { PHASE_CTX for (int un = C.bid; un < 16; un += C.G) { const int b = un >> 3, h = un & 7; attn_unit(C, Qb, Kb, Vtb, AO, ssq, ropet, b, h, TL + b * NCTX, NCTX / AT_KT); } }
            __syncthreads();
        }
        GRID_BAR();
        DBGSCAN(AO, (size_t)nrt * 256 * 512 * 2, false, 15 * layer + 13); DBGSCAN(YY, (size_t)nrt * 256 * 1024 * 2, false, 15 * layer + 6);
        {
            pg8::GridOrder S; S.init(nrt, 4, C.G, C.bid);
            if (PHON(10)) { PHASE_WS pg8::Gemm g{AO, (const bf16_t*)(lw + LW_OA), 512, 512, 512, 0}; pg8::EpiMerge<0> E{Gt, (bf16_t*)ytmp, A1};
              pg8::gemm_phase<pg8::EpiMerge<0>, pg8::GridOrder, true>(C.lds, g, S, E, C.wave); }
            if (PHON(11)) { PHASE_WS pg8::Gemm g{MIXb, (const bf16_t*)(lw + LW_PB), 512, 512, 512, 0}; pg8::EpiMerge<1> E{Gt, (bf16_t*)ytmp, A1};
              pg8::gemm_phase<pg8::EpiMerge<1>, pg8::GridOrder, true>(C.lds, g, S, E, C.wave); }
            if (PHON(12)) { PHASE_WS pg8::Gemm g{YY, (const bf16_t*)(lw + LW_FC), 1024, 1024, 1024, 0}; pg8::EpiMerge<2> E{Gt, (bf16_t*)ytmp, A1};
              pg8::gemm_phase<pg8::EpiMerge<2>, pg8::GridOrder, true>(C.lds, g, S, E, C.wave); }
        }
        GRID_BAR();
        DBGSCAN(A1, (size_t)nrt * 256 * 1024 * 2, false, 15 * layer + 7);
        if (PHON(13)) { PHASE_WS
            { pg8::Gemm g{A1, (const bf16_t*)(lw + LW_OUT), 1024, 1024, 1024, 0};
              pg8::GridOrder S; S.init(64, 4, C.G, C.bid);
              pg8::EpiResid E{xw, mods_l + 2 * 1024, last ? (const float*)xw : prm.in[I_X], xw + (size_t)TL * D};
              pg8::gemm_phase<pg8::EpiResid, pg8::GridOrder, true>(C.lds, g, S, E, C.wave); }
            if (!last) { pg8::Gemm g{A1, (const bf16_t*)(lw + LW_OUT), 1024, 1024, 256, 512, 512};
              pg8::CtxSplitOrder S{4, C.G, (C.bid + 128) % C.G};
              pg8::EpiCtxPart E{ytmp, mods_l + 2 * 6144 + 2 * 1024};
              pg8::gemm_phase<pg8::EpiCtxPart, pg8::CtxSplitOrder, true>(C.lds, g, S, E, C.wave); }
        }
        GRID_BAR();
        DBGSCAN(xw, (size_t)T * 1024 * 4, true, 15 * layer + 8);
        if (!last) {
            if (PHON(14)) { PHASE_CTX norm_phase(C, xw, prm.in[I_CTX], prm.in[I_GN2] + layer * D, mods_l, 1, A1, T, ytmp, 4, xw + (size_t)TL * D); }
            GRID_BAR();
            DBGSCAN(A1, (size_t)T * 1024 * 2, false, 15 * layer + 9);
            if (PHON(15)) { PHASE_WS
                pg8::Gemm g{A1, (const bf16_t*)(ws + WS_FFN13), 1024, 1024, 1024, 0};
                pg8::GridOrder S; S.init(66, 22, C.G, C.bid);
                pg8::EpiSwiglu E{(bf16_t*)(ws + WS_U), DFF};
                pg8::gemm_phase<pg8::EpiSwiglu, pg8::GridOrder, true>(C.lds, g, S, E, C.wave);
            }
            GRID_BAR();
            DBGSCAN(ws + WS_U, (size_t)T * DFF * 2, false, 15 * layer + 10);
            if (PHON(16)) { PHASE_WS
                { pg8::Gemm g{(const bf16_t*)(ws + WS_U), (const bf16_t*)(ws + WS_FFN2), DFF, DFF, DFF, 0};
                  pg8::GridOrder S; S.init(64, 4, C.G, C.bid);
                  pg8::EpiResid E{xw, mods_l + 5 * 1024, xw, xw + (size_t)TL * D};
                  pg8::gemm_phase<pg8::EpiResid, pg8::GridOrder, true>(C.lds, g, S, E, C.wave); }
                { pg8::Gemm g{(const bf16_t*)(ws + WS_U), (const bf16_t*)(ws + WS_FFN2), DFF, DFF, 256, 512, 512};
                  pg8::CtxSplitOrder S{11, C.G, (C.bid + 128) % C.G};
                  pg8::EpiCtxPart E{ytmp, mods_l + 2 * 6144 + 5 * 1024};
                  pg8::gemm_phase<pg8::EpiCtxPart, pg8::CtxSplitOrder, true>(C.lds, g, S, E, C.wave); }
            }
            GRID_BAR();
            DBGSCAN(xw, (size_t)T * 1024 * 4, true, 15 * layer + 11);
            if (PHON(17)) { PHASE_CTX norm_phase(C, xw, xw + (size_t)TL * D, prm.in[I_GN1] + D, mods + (size_t)3 * 6144, 0, A1, T, ytmp, 11, nullptr); }
            GRID_BAR();
        } else {
#define route_e ((int*)(ws + WS_ROUTE_E))
#define route_w ((float*)(ws + WS_ROUTE_W))
#define tokslot ((int*)(ws + WS_TOKSLOT))
#define blkcnt ((int*)(ws + WS_BLKCNT))
#define h2m ((bf16_t*)(ws + WS_H2M))
#define h2g ((bf16_t*)(ws + WS_H2G))
#define uf ((bf16_t*)(ws + WS_UF))
#define yx2 ((bf16_t*)(ws + WS_YX2))
#define yexp ((bf16_t*)(ws + WS_YEXP))
            LAS int* tile_e = (LAS int*)(C.lds + TILE_E_OFF);
            LAS int* sc_i = (LAS int*)(C.lds + SCR_OFF);
            if (PHON(18)) { PHASE_CTX
                LAS float* wscr = (LAS float*)(C.lds + C.wave * 8448);
                const float* wrt = prm.in[I_ROUTER]; const float* rb = prm.in[I_RBIAS];
                for (int blk = C.bid; blk < 256; blk += C.G) {
                    const int rowb = blk * 64 + C.wave * 8, set = rowb >> 13;
                    const float* mp = mods_l + set * 6144 + 3072; const float* gn = prm.in[I_GN2] + D;
                    f32x4 gsc[4], shv[4]; float wreg[4][4][8];
#pragma unroll
                    for (int j = 0; j < 4; ++j) { const f32x4 gg = *((const f32x4*)gn + C.lane + 64 * j), s1 = *((const f32x4*)(mp + 1024) + C.lane + 64 * j); gsc[j] = gg * (s1 + 1.0f); shv[j] = *((const f32x4*)mp + C.lane + 64 * j);
#pragma unroll
                        for (int i = 0; i < 4; ++i) { const float* wp = wrt + (size_t)(4 * (C.lane + 64 * j) + i) * 8; const f32x4 w0 = *(const f32x4*)wp, w1 = *(const f32x4*)(wp + 4);
                            wreg[j][i][0] = w0[0]; wreg[j][i][1] = w0[1]; wreg[j][i][2] = w0[2]; wreg[j][i][3] = w0[3]; wreg[j][i][4] = w1[0]; wreg[j][i][5] = w1[1]; wreg[j][i][6] = w1[2]; wreg[j][i][7] = w1[3]; } }
                    f32x4 xn[4];
#pragma unroll
                    for (int j = 0; j < 4; ++j) xn[j] = *((const f32x4*)(xw + (size_t)rowb * D) + C.lane + 64 * j);
#pragma unroll 1
                    for (int rr = 0; rr < 8; ++rr) {
                        const int row = rowb + rr;
                        f32x4 v[4];
#pragma unroll
                        for (int j = 0; j < 4; ++j) v[j] = xn[j];
                        if (rr < 7) {
#pragma unroll
                            for (int j = 0; j < 4; ++j) xn[j] = *((const f32x4*)(xw + (size_t)(row + 1) * D) + C.lane + 64 * j);
                        }
                        float ssx = 0.f;
#pragma unroll
                        for (int j = 0; j < 4; ++j) ssx += (v[j][0] * v[j][0] + v[j][1] * v[j][1]) + (v[j][2] * v[j][2] + v[j][3] * v[j][3]);
                        const float rstd = __builtin_amdgcn_rsqf(wave_sum(ssx, C.lane) * (1.0f / D) + EPS);
                        float lg[8] = {0.f, 0.f, 0.f, 0.f, 0.f, 0.f, 0.f, 0.f};
#pragma unroll
                        for (int j = 0; j < 4; ++j) {
                            v[j] = v[j] * rstd * gsc[j] + shv[j];
                            u32x2 w; w.x = cvt_pk_bf16(v[j][0], v[j][1]); w.y = cvt_pk_bf16(v[j][2], v[j][3]);
                            *((u32x2*)(h2m + (size_t)row * D) + C.lane + 64 * j) = w;
#pragma unroll
                            for (int i = 0; i < 4; ++i)
#pragma unroll
                                for (int e = 0; e < 8; ++e) lg[e] += v[j][i] * wreg[j][i][e];
                        }
#pragma unroll
                        for (int e = 0; e < 8; ++e) lg[e] = wave_sum(lg[e], C.lane) + rb[e];
                        int ea = 0; float va = lg[0];
#pragma unroll
                        for (int e = 1; e < 8; ++e) if (lg[e] > va) { va = lg[e]; ea = e; }
                        int eb = (ea + 1) & 7; float vb = -3.0e38f;
#pragma unroll
                        for (int e = 0; e < 8; ++e) if (e != ea && lg[e] > vb) { vb = lg[e]; eb = e; }
                        const float wa = 1.0f / (1.0f + expf(vb - va));
                        if (C.lane == 0) { route_e[row] = ea | (eb << 8); route_w[2 * row] = wa; route_w[2 * row + 1] = 1.0f - wa; }
                    }
                    __syncthreads();
                    VM_WAIT(); __syncthreads();
                    if (C.tid < 8) { int c = 0; for (int i = 0; i < 64; ++i) { const int e2 = __hip_atomic_load(route_e + blk * 64 + i, __ATOMIC_RELAXED, __HIP_MEMORY_SCOPE_AGENT); c += ((e2 & 255) == C.tid) + ((e2 >> 8) == C.tid); }
                        blkcnt[blk * 8 + C.tid] = c; }
                    __syncthreads();
                }
                constexpr int IE1 = 16 * 88, IE2 = 44 * 32, IE = 2 * IE1 + IE2;
                for (int it = C.gw; it < NE * IE; it += C.ngw) {
                    const int e = it / IE; int r = it % IE;
                    if (r < 2 * IE1) { const int w3 = r >= IE1; if (w3) r -= IE1; const int kb = r / 88, nb = r % 88;
                        tr_item(prm.in[w3 ? I_MW3 : I_MW1] + (size_t)e * D * DFF, DFF, 64 * kb, 32 * nb, nullptr, (bf16_t*)(ws + WS_MW13) + (size_t)e * 5632 * 1024, 1024, 64 * kb, RowGU{w3 ? 16 : 0}, wscr, C.lane); }
                    else { r -= 2 * IE1; const int kb = r / 32, nb = r % 32;
                        tr_item(prm.in[I_MW2] + (size_t)e * DFF * D, 1024, 64 * kb, 32 * nb, nullptr, (bf16_t*)(ws + WS_MW2) + (size_t)e * 1024 * DFF, DFF, 64 * kb, RowId{}, wscr, C.lane); }
                }
            }
            GRID_BAR();
            DBGSCAN(h2m, (size_t)TL * 1024 * 2, false, 24); DBGSCAN(ws + WS_MW13, (size_t)NE * 5632 * 1024 * 2 + (size_t)NE * 1024 * DFF * 2, false, 25);
            if (PHON(19)) { PHASE_CTX
                __syncthreads();
                if (C.tid < 8) { int tot = 0; for (int b2 = 0; b2 < 256; ++b2) tot += blkcnt[b2 * 8 + C.tid]; sc_i[128 + C.tid] = tot; }
                __syncthreads();
                if (C.tid == 0) { int seg = 0, tl = 0; for (int e = 0; e < 8; ++e) { sc_i[136 + e] = seg; const int ntl = (sc_i[128 + e] + 255) >> 8; for (int q = 0; q < ntl; ++q) tile_e[tl++] = e; seg += ntl * 256; } tile_e[140] = tl; }
                __syncthreads();
                for (int blk = C.bid; blk < 256; blk += C.G) {
                    if (C.tid < 8) { int run = sc_i[136 + C.tid]; for (int b2 = 0; b2 < blk; ++b2) run += blkcnt[b2 * 8 + C.tid];
                        for (int i = 0; i < 64; ++i) { const int e2 = route_e[blk * 64 + i]; if ((e2 & 255) == C.tid) { sc_i[256 + 2 * i] = run; tokslot[2 * (blk * 64 + i)] = run; ++run; } if ((e2 >> 8) == C.tid) { sc_i[256 + 2 * i + 1] = run; tokslot[2 * (blk * 64 + i) + 1] = run; ++run; } } }
                    __syncthreads();
                    for (int rr = 0; rr < 8; ++rr) { const int lr = C.wave * 8 + rr, row = blk * 64 + lr;
                        const u32x4* sp = (const u32x4*)(h2m + (size_t)row * D) + C.lane; const u32x4 v0 = sp[0], v1 = sp[64];
                        u32x4* d0 = (u32x4*)(h2g + (size_t)sc_i[256 + 2 * lr] * D) + C.lane; u32x4* d1 = (u32x4*)(h2g + (size_t)sc_i[256 + 2 * lr + 1] * D) + C.lane;
                        d0[0] = v0; d0[64] = v1; d1[0] = v0; d1[64] = v1; }
                    __syncthreads();
                }
                if (C.bid < 8) { const int e = C.bid, cnt = sc_i[128 + e], s0 = sc_i[136 + e] + cnt, s1 = sc_i[136 + e] + (((cnt + 255) >> 8) << 8);
                    for (int i = C.tid; i < (s1 - s0) * 128; i += 512) *((u32x4*)(h2g + (size_t)s0 * D) + i) = (u32x4){0u, 0u, 0u, 0u}; }
            }
            GRID_BAR();
            const int ntiles = tile_e[140];
            DBGSCAN(h2g, (size_t)ntiles * 256 * 1024 * 2, false, 26);
            {
                if (PHON(20)) { PHASE_WS pg8::Gemm g{h2g, (const bf16_t*)(ws + WS_MW13), 1024, 1024, 1024, (size_t)5632 * 1024 * 2};
                  pg8::GridOrder S; S.init(ntiles, 22, C.G, C.bid); S.tile_e = tile_e;
                  pg8::EpiSwiglu E{uf, DFF};
                  pg8::gemm_phase<pg8::EpiSwiglu, pg8::GridOrder, true>(C.lds, g, S, E, C.wave); }
                GRID_BAR();
                if (PHON(21)) { PHASE_WS
                  { pg8::Gemm g{uf, (const bf16_t*)(ws + WS_MW2), DFF, DFF, DFF, (size_t)1024 * DFF * 2};
                    pg8::GridOrder S; S.init(ntiles < 128 ? ntiles : 128, 4, C.G, C.bid); S.tile_e = tile_e;
                    pg8::EpiMoeDown E{yexp, yx2};
                    pg8::gemm_phase<pg8::EpiMoeDown, pg8::GridOrder, true>(C.lds, g, S, E, C.wave); }
                  if (ntiles > 128) { pg8::Gemm g{uf, (const bf16_t*)(ws + WS_MW2), DFF, DFF, DFH, (size_t)1024 * DFF * 2, 0, (size_t)DFH * 2, (size_t)DFH * 2};
                    pg8::MoeOvOrder S{ntiles - 128, C.G, (C.bid + 128) % C.G, tile_e};
                    pg8::EpiMoeDown E{yexp, yx2};
                    pg8::gemm_phase<pg8::EpiMoeDown, pg8::MoeOvOrder, true>(C.lds, g, S, E, C.wave); }
                }
                GRID_BAR();
            }
            if (PHON(24)) { PHASE_CTX for (int row = C.gw; row < TL; row += C.ngw) {
                const int set = row >> 13; const float* gt = mods_l + set * 6144 + 5 * 1024;
                const float wa = route_w[2 * row], wb = route_w[2 * row + 1]; const int sa = tokslot[2 * row], sb = tokslot[2 * row + 1];
                f32x4 v[4]; float s = 0.f;
#pragma unroll
                for (int j = 0; j < 4; ++j) {
                    const f32x4 x = *((const f32x4*)(xw + (size_t)row * D) + C.lane + 64 * j), gg = *((const f32x4*)gt + C.lane + 64 * j);
                    const u32x2 ya = *((const u32x2*)(yexp + (size_t)sa * D) + C.lane + 64 * j), yb = *((const u32x2*)(yexp + (size_t)sb * D) + C.lane + 64 * j);
                    f32x4 fa = (f32x4){bflo(ya.x), bfhi(ya.x), bflo(ya.y), bfhi(ya.y)}, fb = (f32x4){bflo(yb.x), bfhi(yb.x), bflo(yb.y), bfhi(yb.y)};
                    if (sa >= 32768) { const u32x2 y2 = *((const u32x2*)(yx2 + (size_t)(sa - 32768) * D) + C.lane + 64 * j); fa += (f32x4){bflo(y2.x), bfhi(y2.x), bflo(y2.y), bfhi(y2.y)}; }
                    if (sb >= 32768) { const u32x2 y2 = *((const u32x2*)(yx2 + (size_t)(sb - 32768) * D) + C.lane + 64 * j); fb += (f32x4){bflo(y2.x), bfhi(y2.x), bflo(y2.y), bfhi(y2.y)}; }
                    v[j] = x + gg * (fa * wa + fb * wb);
                    s += (v[j][0] * v[j][0] + v[j][1] * v[j][1]) + (v[j][2] * v[j][2] + v[j][3] * v[j][3]);
                }
                const float rstd = __builtin_amdgcn_rsqf(wave_sum(s, C.lane) * (1.0f / D) + EPS);
#pragma unroll
                for (int j = 0; j < 4; ++j) { const f32x4 gf = *((const f32x4*)prm.in[I_GFINAL] + C.lane + 64 * j); f32x4 o = v[j] * rstd * gf;
#if DBG
                    { const unsigned fl = *((volatile unsigned*)(ws + WS_CTL) + CW_DBG); if (fl) { const float big = exp2f(2.0f * (float)(100 - (int)fl)); o = (f32x4){big, big, big, big}; }
                      else {
#pragma unroll
                          for (int i = 0; i < 4; ++i) if (!(fabsf(o[i]) < 1e30f)) o[i] = 0.f; } }
#endif
                    *((f32x4*)(prm.out + (size_t)row * D) + C.lane + 64 * j) = o; }
            } }
        }

}
__global__ void __launch_bounds__(512, 2) mega_fwd(Params prm) {
    extern __shared__ __attribute__((aligned(16))) unsigned char lds_raw[];
    Ctx C;
    C.lds = (LAS unsigned char*)lds_raw;
    C.tid = threadIdx.x; C.lane = C.tid & 63; C.wave = __builtin_amdgcn_readfirstlane(C.tid >> 6);
    C.G = gridDim.x; C.bid = blockIdx.x; C.gw = C.bid * 8 + C.wave; C.ngw = C.G * 8;
    unsigned char* ws0 = prm.ws;
    for (int u = C.tid; u < (LDS_BYTES - LDSCTL_OFF) / 4; u += 512) ((LAS unsigned*)(C.lds + LDSCTL_OFF))[u] = 0u;
    __syncthreads();
    XcdBarrier bar = xcd_barrier_post((unsigned*)(ws0 + WS_CTL) + CW_BAR, (volatile LAS unsigned*)(C.lds + MISC_OFF) + 8);
    if (PHON(0)) { PHASE_CTX
        const int gtid = C.bid * 512 + C.tid, gthreads = C.G * 512;
        LAS float* wscr = (LAS float*)(C.lds + C.wave * 8448);
        for (int item = C.bid; item < 192; item += C.G) {
            const int layer = item / 96, c0 = (item % 96) * 64;
            const float* wm = prm.in[I_WMOD] + (size_t)layer * D * 6144 + c0 + C.lane;
            float a0 = 0.f, a1 = 0.f, a2 = 0.f;
#pragma unroll 1
            for (int kh = 0; kh < 2; ++kh) {
                const int k0 = C.wave * 128 + kh * 64;
                float s0 = prm.in[I_C][k0 + C.lane], s1 = prm.in[I_C][D + k0 + C.lane], s2 = prm.in[I_CCTX][k0 + C.lane];
                s0 = s0 * sigmoidf_fast(s0); s1 = s1 * sigmoidf_fast(s1); s2 = s2 * sigmoidf_fast(s2);
                float wv[64];
#pragma unroll
                for (int j = 0; j < 64; ++j) wv[j] = wm[(size_t)(k0 + j) * 6144];
#pragma unroll
                for (int j = 0; j < 64; ++j) {
                    a0 += __int_as_float(__builtin_amdgcn_readlane(__float_as_int(s0), j)) * wv[j];
                    a1 += __int_as_float(__builtin_amdgcn_readlane(__float_as_int(s1), j)) * wv[j];
                    a2 += __int_as_float(__builtin_amdgcn_readlane(__float_as_int(s2), j)) * wv[j];
                }
            }
            LAS float* red = (LAS float*)(C.lds + 80000);
            __syncthreads();
            red[(C.wave * 3 + 0) * 64 + C.lane] = a0; red[(C.wave * 3 + 1) * 64 + C.lane] = a1; red[(C.wave * 3 + 2) * 64 + C.lane] = a2;
            __syncthreads();
            if (C.tid < 192) { const int set = C.tid >> 6, l = C.tid & 63; float s = 0.f;
#pragma unroll
                for (int w = 0; w < 8; ++w) s += red[(w * 3 + set) * 64 + l];
                mods[(size_t)(layer * 3 + set) * 6144 + c0 + l] = s + prm.in[I_BMOD][layer * 6144 + c0 + l]; }
            __syncthreads();
        }
        for (int i = gtid; i < 128 * 8; i += gthreads) { const int pos = i >> 3, f = i & 7; const float inv = exp2f(-(float)f * (13.287712379549449f / 8.0f)); const float a = (float)pos * inv;
            ropet[2 * i] = cosf(a); ropet[2 * i + 1] = sinf(a); }
        for (int i = gtid; i < 128 * 64; i += gthreads) { const int k1 = i >> 6, l2 = i & 63; const float x = (float)((k1 * l2) & 8191) * (2.0f / 8192.0f); twt[2 * i] = cospif(x); twt[2 * i + 1] = sinpif(x); }
        for (int i = gtid; i < 256 * 128; i += gthreads) { const int n = i >> 7, l1 = i & 127, k1 = n >> 1; const float x = (float)((k1 * l1) & 127) * (2.0f / 128.0f); dft128[i] = f2bf((n & 1) ? -sinpif(x) : cospif(x)); }
        for (int i = gtid; i < 128 * 128; i += gthreads) { const int n = i >> 7, kk = i & 127, k2 = n >> 1, ro = n & 1, l2 = kk >> 1, ri = kk & 1; const float x = (float)((k2 * l2) & 63) * (2.0f / 64.0f);
            const float c = cospif(x), s = sinpif(x); m64[i] = f2bf(ro == ri ? c : (ro == 0 ? s : -s)); }
        for (int i = gtid; i < 512 * 256; i += gthreads) { const int n = i >> 8, l = i & 255, k = n >> 1; const float x = (float)((k * l) & 255) * (2.0f / 256.0f); dft256[i] = f2bf((n & 1) ? -sinpif(x) : cospif(x)); }
        {
            constexpr int IL_IN = 16 * 149, IL_UQ = 6 * 24, IL_UKV = 4 * 32, IL_OA = 8 * 32, IL_OUT = 16 * 32, IL = IL_IN + IL_UQ + IL_UKV + IL_OA + IL_OUT;
            constexpr int IF1 = 16 * 88, IF2 = 44 * 32, NIT = 2 * IL + 2 * IF1 + IF2;
            for (int it = C.gw; it < NIT; it += C.ngw) {
                int r = it;
                if (r < 2 * IL) {
                    const int layer = r / IL; r -= layer * IL;
                    bf16_t* lwp = (bf16_t*)(ws + WS_PERM + (size_t)layer * LW_SIZE);
                    if (r < IL_IN) { tr_item(prm.in[I_WIN] + (size_t)layer * D * IN_COLS, IN_COLS, 64 * (r / 149), 32 * (r % 149), nullptr, (bf16_t*)((char*)lwp + LW_IN), 1024, 64 * (r / 149), RowWin{}, wscr, C.lane); continue; } r -= IL_IN;
                    if (r < IL_UQ) { tr_item(prm.in[I_WUQ] + (size_t)layer * QL * 768, 768, 64 * (r / 24), 32 * (r % 24), prm.in[I_GQ] + layer * QL, (bf16_t*)((char*)lwp + LW_UQ), QL, 64 * (r / 24), RowQ{}, wscr, C.lane); continue; } r -= IL_UQ;
                    if (r < IL_UKV) { tr_item(prm.in[I_WUKV] + (size_t)layer * KVL * 1024, 1024, 64 * (r / 32), 32 * (r % 32), prm.in[I_GKV] + layer * KVL, (bf16_t*)((char*)lwp + LW_UKV), KVL, 64 * (r / 32), RowId{}, wscr, C.lane); continue; } r -= IL_UKV;
                    if (r < IL_OA) { tr_item(prm.in[I_WOA] + (size_t)layer * 512 * 1024, 1024, 64 * (r / 32), 32 * (r % 32), nullptr, (bf16_t*)((char*)lwp + LW_OA), 512, 64 * (r / 32), RowId{}, wscr, C.lane); continue; } r -= IL_OA;
                    tr_item(prm.in[I_WOUT] + (size_t)layer * D * D, 1024, 64 * (r / 32), 32 * (r % 32), nullptr, (bf16_t*)((char*)lwp + LW_OUT), 1024, 64 * (r / 32), RowId{}, wscr, C.lane); continue;
                }
                r -= 2 * IL;
                if (r < IF1) { tr_item(prm.in[I_FW1], DFF, 64 * (r / 88), 32 * (r % 88), nullptr, (bf16_t*)(ws + WS_FFN13), 1024, 64 * (r / 88), RowGU{0}, wscr, C.lane); continue; } r -= IF1;
                if (r < IF1) { tr_item(prm.in[I_FW3], DFF, 64 * (r / 88), 32 * (r % 88), nullptr, (bf16_t*)(ws + WS_FFN13), 1024, 64 * (r / 88), RowGU{16}, wscr, C.lane); continue; } r -= IF1;
                tr_item(prm.in[I_FW2], 1024, 64 * (r / 32), 32 * (r % 32), nullptr, (bf16_t*)(ws + WS_FFN2), DFF, 64 * (r / 32), RowId{}, wscr, C.lane);
            }
            for (int i = gtid; i < 2 * 96 * 128; i += gthreads) { const int layer = i / (96 * 128), r = i % (96 * 128);
                *(u32x4*)(ws + WS_PERM + (size_t)layer * LW_SIZE + LW_IN + (size_t)OFF_GATE * 2048 + (size_t)r * 16) = (u32x4){0u, 0u, 0u, 0u}; }
        }
        {
            LAS float* ctab = (LAS float*)(C.lds + 90000);
            __syncthreads();
            if (C.tid < 128) ctab[C.tid] = cospif((float)C.tid * (2.0f / 128.0f));
            __syncthreads();
            for (int un = C.bid; un < 64 + 128; un += C.G) {
                if (un < 64) {
                    const int layer = un >> 5, g = (un >> 3) & 3, dch = un & 7;
                    const float* wo = prm.in[I_WOB] + ((size_t)layer * 512 + g * 128) * 1024 + dch * 128;
                    const float* wp = prm.in[I_WPOOL] + (size_t)(layer * 4 + g) * 128 * 128; const float* sp = prm.in[I_SPOOL] + layer * 512 + g * 128;
                    bf16_t* dst = (bf16_t*)(ws + WS_PERM + (size_t)layer * LW_SIZE + LW_PB) + (size_t)dch * 128 * 512 + g * 128;
                    flex_tile(C, 128,
                        [&](int m, int k) { u32x4 o; float f[8];
#pragma unroll
                            for (int t = 0; t < 8; ++t) f[t] = wo[(size_t)(k + t) * 1024 + m];
                            o.x = cvt_pk_bf16(f[0], f[1]); o.y = cvt_pk_bf16(f[2], f[3]); o.z = cvt_pk_bf16(f[4], f[5]); o.w = cvt_pk_bf16(f[6], f[7]); return __builtin_bit_cast(bf16x8, o); },
                        [&](int n, int k) { const f32x4 a0 = *(const f32x4*)(wp + (size_t)n * 128 + k), a1 = *(const f32x4*)(wp + (size_t)n * 128 + k + 4), s0 = *(const f32x4*)(sp + k), s1 = *(const f32x4*)(sp + k + 4);
                            u32x4 o; o.x = cvt_pk_bf16(a0[0] * s0[0], a0[1] * s0[1]); o.y = cvt_pk_bf16(a0[2] * s0[2], a0[3] * s0[3]); o.z = cvt_pk_bf16(a1[0] * s1[0], a1[1] * s1[1]); o.w = cvt_pk_bf16(a1[2] * s1[2], a1[3] * s1[3]);
                            return __builtin_bit_cast(bf16x8, o); },
                        [&](int m, int n, float v0, float v1) { *(unsigned*)(dst + (size_t)m * 512 + n) = cvt_pk_bf16(v0, v1); });
                } else {
                    const int u2 = un - 64, layer = u2 >> 6, g = (u2 >> 4) & 3, dch = (u2 >> 1) & 7, nch = u2 & 1, sh = nch ? 96 : 0;
                    const float* wo = prm.in[I_WOC] + ((size_t)layer * 512 + g * 128) * 1024 + dch * 128;
                    bf16_t* dst = (bf16_t*)(ws + WS_PERM + (size_t)layer * LW_SIZE + LW_FC) + (size_t)dch * 128 * 1024 + g * 256 + nch * 128;
                    flex_tile(C, 128,
                        [&](int m, int k) { u32x4 o; float f[8];
#pragma unroll
                            for (int t = 0; t < 8; ++t) f[t] = wo[(size_t)(k + t) * 1024 + m];
                            o.x = cvt_pk_bf16(f[0], f[1]); o.y = cvt_pk_bf16(f[2], f[3]); o.z = cvt_pk_bf16(f[4], f[5]); o.w = cvt_pk_bf16(f[6], f[7]); return __builtin_bit_cast(bf16x8, o); },
                        [&](int n, int k) { float f[8];
#pragma unroll
                            for (int t = 0; t < 8; ++t) f[t] = ctab[((k + t) * n + sh) & 127];
                            u32x4 o; o.x = cvt_pk_bf16(f[0], f[1]); o.y = cvt_pk_bf16(f[2], f[3]); o.z = cvt_pk_bf16(f[4], f[5]); o.w = cvt_pk_bf16(f[6], f[7]); return __builtin_bit_cast(bf16x8, o); },
                        [&](int m, int n, float v0, float v1) { *(unsigned*)(dst + (size_t)m * 1024 + n) = cvt_pk_bf16(v0 * (1.0f / 1024.0f), v1 * (1.0f / 1024.0f)); });
                }
            }
        }
    }
    GRID_BAR();
    DBGSCAN(ws0 + WS_DFT128, WS_ROUTE_E - WS_DFT128, false, 1); DBGSCAN(ws0 + WS_ROPE, WS_DFT128 - WS_ROPE, true, 1); DBGSCAN(ws0 + WS_PERM, WS_ARENA - WS_PERM, false, 1); DBGSCAN(ws0 + WS_MODS, (size_t)2 * 3 * 6144 * 4, true, 1); DBGSCAN(ws0 + WS_XW, (size_t)T * D * 4, true, 1);
    if (PHON(1)) { PHASE_CTX norm_phase(C, prm.in[I_X], prm.in[I_CTX], prm.in[I_GN1], mods, 0, A1, T); }
    GRID_BAR();
    DBGSCAN(ws0 + WS_A1, (size_t)T * D * 2, false, 2);

    layer_body<0>(C, prm, ws0, bar);
    layer_body<1>(C, prm, ws0, bar);
#undef GRID_BAR
}

extern "C" void kernel_launch(void* const* d_in, const int* in_sizes, int n_in, void* d_out, int out_size, void* d_ws, size_t ws_size, hipStream_t stream) {
    static int grid = 0;
    if (grid == 0) {
        if (n_in != 29 || out_size != TL * D || ws_size < WS_NEED) { fprintf(stderr, "kernel_launch: unexpected shapes (n_in %d out %d ws %zu need %zu)\n", n_in, out_size, ws_size, (size_t)WS_NEED); grid = -1; return; }
        int dev = 0, cus = 0, per_cu = 0;
        if (hipGetDevice(&dev) != hipSuccess || hipDeviceGetAttribute(&cus, hipDeviceAttributeMultiprocessorCount, dev) != hipSuccess) { grid = -1; return; }
        if (hipFuncSetAttribute((const void*)mega_fwd, hipFuncAttributeMaxDynamicSharedMemorySize, LDS_BYTES) != hipSuccess) { fprintf(stderr, "kernel_launch: hipFuncSetAttribute failed\n"); grid = -1; return; }
        if (hipOccupancyMaxActiveBlocksPerMultiprocessor(&per_cu, (const void*)mega_fwd, 512, LDS_BYTES) != hipSuccess || per_cu < 1) { fprintf(stderr, "kernel_launch: occupancy query reports %d\n", per_cu); }
        (void)hipGetLastError();
        grid = cus;
        if (grid != 256) { fprintf(stderr, "kernel_launch: built for a 256-CU device (got %d)\n", cus); if (grid > 256) grid = 256; }
    }
    if (grid < 0) return;
    if (hipMemsetAsync((char*)d_ws + WS_CTL, 0, CTL_ZERO_BYTES, stream) != hipSuccess) return;
    Params p{};
    for (int i = 0; i < 29; ++i) p.in[i] = (const float*)d_in[i];
    p.out = (float*)d_out; p.ws = (unsigned char*)d_ws;
    hipLaunchKernelGGL(mega_fwd, dim3(grid), dim3(512), LDS_BYTES, stream, p);
}
```

```cpp
#include <hip/hip_runtime.h>
#include <cstdio>
#include <cstdint>

#define LAS __attribute__((address_space(3)))
#define GAS __attribute__((address_space(1)))
typedef unsigned short bf16_t;
typedef short bf16x8 __attribute__((ext_vector_type(8)));
typedef short s16x4 __attribute__((ext_vector_type(4)));
typedef float f32x2 __attribute__((ext_vector_type(2)));
typedef float f32x4 __attribute__((ext_vector_type(4)));
typedef float f32x16 __attribute__((ext_vector_type(16)));
typedef unsigned u32x2 __attribute__((ext_vector_type(2)));
typedef unsigned u32x4 __attribute__((ext_vector_type(4)));

constexpr int D = 1024, NB = 2, SEQ = 8192, NCTX = 256;
constexpr int TL = NB * SEQ;
constexpr int TC = NB * NCTX;
constexpr int T = TL + TC;
constexpr int NH = 8, QKD = 96, VD = 64, QL = 384, KVL = 256;
constexpr int NKEY = NCTX + SEQ;
constexpr int OFF_KV = 384, OFF_KR = 640, OFF_POOL = 672, OFF_FFT = 1184, OFF_GATE = 1696, IN_COLS = 4768, NIN = 4864;
constexpr int PP = 1792;
constexpr int DFF = 2816, NE = 8, DFH = 1408;
constexpr int MOE_ROWS = 34816;
constexpr float EPS = 1e-6f;
constexpr float QSCALE = 0.10206207261596577f * 1.4426950408889634f;

constexpr size_t MiB = 1u << 20;
constexpr size_t WS_CTL = 0, CTL_ZERO_BYTES = 64 * 1024;
constexpr size_t WS_MODS = 1 * MiB;
constexpr size_t WS_ROPE = WS_MODS + 2 * 3 * 6144 * 4;
constexpr size_t WS_TW = WS_ROPE + 128 * 8 * 2 * 4;
constexpr size_t WS_DFT128 = WS_TW + 128 * 64 * 2 * 4;
constexpr size_t WS_M64 = WS_DFT128 + 256 * 128 * 2;
constexpr size_t WS_DFT256 = WS_M64 + 128 * 128 * 2;
constexpr size_t WS_ROUTE_E = WS_DFT256 + 512 * 256 * 2;
constexpr size_t WS_ROUTE_W = WS_ROUTE_E + 16384 * 4;
constexpr size_t WS_TOKSLOT = WS_ROUTE_W + 16384 * 8;
constexpr size_t WS_BLKCNT = WS_TOKSLOT + 16384 * 8;
constexpr size_t WS_SSQ = 4 * MiB;
constexpr size_t WS_XW = 8 * MiB;
constexpr size_t WS_PERM = WS_XW + (size_t)T * D * 4;
constexpr size_t LW_IN = 0, LW_UQ = LW_IN + (size_t)NIN * 1024 * 2, LW_UKV = LW_UQ + 768 * 384 * 2, LW_OA = LW_UKV + 1024 * 256 * 2,
                 LW_PB = LW_OA + 1024 * 512 * 2, LW_FC = LW_PB + 1024 * 512 * 2, LW_OUT = LW_FC + 1024 * 1024 * 2, LW_SIZE = LW_OUT + 1024 * 1024 * 2;
constexpr size_t WS_FFN13 = WS_PERM + 2 * LW_SIZE;
constexpr size_t WS_FFN2 = WS_FFN13 + (size_t)5632 * 1024 * 2;
constexpr size_t WS_ARENA = WS_FFN2 + (size_t)1024 * 2816 * 2;
constexpr size_t WS_P = WS_ARENA;
constexpr size_t WS_G = WS_P + (size_t)T * PP * 2;
constexpr size_t WS_A1 = WS_P + (size_t)T * NIN * 2;
constexpr size_t WS_A2 = WS_A1 + (size_t)T * D * 2;
constexpr size_t WS_Q = WS_A2, WS_K = WS_Q + (size_t)T * 768 * 2, WS_VT = WS_K + (size_t)NB * NH * NKEY * QKD * 2;
constexpr size_t WS_A3 = WS_A2 + (size_t)T * D * 4;
constexpr size_t WS_AO = WS_A3, WS_MIX = WS_AO + (size_t)T * 512 * 2, WS_YY = WS_MIX + (size_t)T * 512 * 2;
constexpr size_t WS_MIXER_END = WS_YY + (size_t)T * 1024 * 2;
static_assert(WS_VT + (size_t)NB * NH * VD * NKEY * 2 <= WS_A3, "QKV fits A2");
constexpr size_t WS_U = WS_P;
static_assert((size_t)T * DFF * 2 <= (size_t)T * NIN * 2, "u fits p");
constexpr size_t WS_MW13 = WS_PERM;
constexpr size_t WS_MW2 = WS_MW13 + (size_t)NE * 5632 * 1024 * 2;
constexpr size_t WS_H2G = WS_MW2 + (size_t)NE * 1024 * DFF * 2;
constexpr size_t WS_UF = WS_H2G + (size_t)MOE_ROWS * 1024 * 2;
constexpr size_t WS_YX2 = WS_UF + (size_t)MOE_ROWS * DFF * 2;
constexpr size_t WS_YEXP = WS_H2G;
constexpr size_t WS_MOE_END = WS_YX2 + (size_t)2048 * 1024 * 2;
constexpr size_t WS_NEED = WS_MIXER_END > WS_MOE_END ? WS_MIXER_END : WS_MOE_END;
static_assert(WS_NEED <= 496000000ull, "workspace budget");
constexpr size_t WS_H2M = WS_UF;

constexpr int CW_BAR = 1024;

constexpr int RING_BYTES = 131072;
constexpr int LDSCTL_OFF = RING_BYTES;
constexpr int MISC_OFF = LDSCTL_OFF;
constexpr int TILE_E_OFF = LDSCTL_OFF + 256;
constexpr int SCR_OFF = LDSCTL_OFF + 1024;
constexpr int LDS_BYTES = 147456;

typedef __bf16 bf16x2_t __attribute__((ext_vector_type(2)));
__device__ __forceinline__ unsigned cvt_pk_bf16(float lo, float hi) { const f32x2 v = {lo, hi}; const bf16x2_t b = __builtin_convertvector(v, bf16x2_t); return __builtin_bit_cast(unsigned, b); }
__device__ __forceinline__ float bf2f(unsigned short v) { return __uint_as_float((unsigned)v << 16); }
__device__ __forceinline__ float bflo(unsigned v) { return __uint_as_float(v << 16); }
__device__ __forceinline__ float bfhi(unsigned v) { return __uint_as_float(v & 0xffff0000u); }
__device__ __forceinline__ bf16_t f2bf(float f) { return (bf16_t)(cvt_pk_bf16(f, 0.f) & 0xffffu); }
__device__ __forceinline__ float shx(float v, int o, int lane) { return __int_as_float(__builtin_amdgcn_ds_bpermute((lane ^ o) << 2, __float_as_int(v))); }
__device__ __forceinline__ float wave_sum(float v, int lane) {
#pragma unroll
    for (int o = 1; o < 64; o <<= 1) v += shx(v, o, lane);
    return v;
}
__device__ __forceinline__ float sigmoidf_fast(float x) { return __builtin_amdgcn_rcpf(1.0f + __builtin_amdgcn_exp2f(-1.4426950408889634f * x)); }
__device__ __forceinline__ int crow(int r, int hi) { return (r & 3) + 8 * (r >> 2) + 4 * hi; }
#define LDS_WAIT() asm volatile("s_waitcnt lgkmcnt(0)" ::: "memory")
#define VM_WAIT() asm volatile("s_waitcnt vmcnt(0)" ::: "memory")

#define XB_TMO      128
#define XB_XCNT(j)  (256  + 64 * (j))
#define XB_XSUB(j)  (1280 + 64 * (j))
#define XB_XGEN(j)  (2304 + 64 * (j))
#define XB_TOP      3328
#define XB_TOPGEN   3392
#define XCD_BAR_WORDS 3456
#define XB_SPIN_CAP (1u << 18)
__device__ __forceinline__ unsigned xb_ld(unsigned* p)              { return __hip_atomic_load(p, __ATOMIC_RELAXED, __HIP_MEMORY_SCOPE_AGENT); }
__device__ __forceinline__ unsigned xb_add(unsigned* p, unsigned v) { return __hip_atomic_fetch_add(p, v, __ATOMIC_RELAXED, __HIP_MEMORY_SCOPE_AGENT); }
__device__ __forceinline__ unsigned xb_xcc_id() { return (unsigned)__builtin_amdgcn_s_getreg((3 << 11) | 20) & 0xFu; }
#define XB_SPIN(cond, bar) do { unsigned _sp = 0; while (cond) { __builtin_amdgcn_s_sleep(1); \
    if ((++_sp & 255u) == 0u) { if (xb_ld(&(bar)[XB_TMO])) break; if (_sp > XB_SPIN_CAP) { atomicAdd(&(bar)[XB_TMO], 1u); break; } } } } while (0)
struct XcdBarrier { unsigned* bar; unsigned x; volatile LAS unsigned* st; };
__device__ __forceinline__ XcdBarrier xcd_barrier_post(unsigned* bar, volatile LAS unsigned* st) {
    XcdBarrier b; b.bar = bar; b.x = xb_xcc_id(); b.st = st;
    if (threadIdx.x == 0) (void)xb_add(&bar[XB_XCNT(b.x)], 1u);
    return b;
}
__device__ __forceinline__ void xcd_barrier_complete(unsigned* bar, unsigned x, unsigned& nloc, unsigned& nx) {
    const unsigned G = gridDim.x * gridDim.y * gridDim.z;
    unsigned sum, cnt, mine, sp = 0u;
    for (;;) {
        sum = 0u; cnt = 0u; mine = 0u;
#pragma unroll
        for (unsigned j = 0; j < 16; ++j) { const unsigned c = xb_ld(&bar[XB_XCNT(j)]); sum += c; cnt += (c > 0u) ? 1u : 0u; mine = (j == x) ? c : mine; }
        if (sum == G) break;
        __builtin_amdgcn_s_sleep(1);
        if ((++sp & 255u) == 0u) { if (xb_ld(&bar[XB_TMO])) break; if (sp > XB_SPIN_CAP) { atomicAdd(&bar[XB_TMO], 1u); break; } }
    }
    nloc = mine > 0u ? mine : 1u; nx = cnt > 0u ? cnt : 1u;
}
__device__ __forceinline__ void xcd_barrier(const XcdBarrier& b, int wave_id) {
    asm volatile("s_waitcnt vmcnt(0)" ::: "memory");
    __syncthreads();
    if (wave_id == 0 && __builtin_amdgcn_mbcnt_hi(~0u, __builtin_amdgcn_mbcnt_lo(~0u, 0u)) == 0u) {
        unsigned* bar = b.bar;
        __builtin_amdgcn_s_waitcnt(0);
        unsigned nloc = b.st[0], nx = b.st[1];
        if (nloc == 0u) { xcd_barrier_complete(bar, b.x, nloc, nx); b.st[0] = nloc; b.st[1] = nx; }
        const unsigned old = xb_add(&bar[XB_XSUB(b.x)], 1u);
        const unsigned gen = old / nloc;
        if (old + 1u == (gen + 1u) * nloc) {
            __builtin_amdgcn_fence(__ATOMIC_RELEASE, "agent");
            asm volatile("s_waitcnt vmcnt(0)" ::: "memory");
            const unsigned og = xb_add(&bar[XB_TOP], 1u);
            const unsigned tg = og / nx;
            if (og + 1u == (tg + 1u) * nx) xb_add(&bar[XB_TOPGEN], 1u);
            else XB_SPIN(xb_ld(&bar[XB_TOPGEN]) == tg, bar);
            __builtin_amdgcn_fence(__ATOMIC_ACQUIRE, "agent");
            xb_add(&bar[XB_XGEN(b.x)], 1u);
            asm volatile("s_waitcnt vmcnt(0)" ::: "memory");
        } else {
            XB_SPIN(xb_ld(&bar[XB_XGEN(b.x)]) == gen, bar);
            __builtin_amdgcn_fence(__ATOMIC_ACQUIRE, "agent");
            asm volatile("s_waitcnt vmcnt(0)" ::: "memory");
        }
    }
    __syncthreads();
}

namespace pg8 {
constexpr int BM = 256, BK = 64, HALF = 128, HTB = HALF * BK * 2, NXCD = 8, WGM = 4;
__host__ __device__ __forceinline__ int lds_byte(int r, int c) { const int st = (r >> 4) * 2 + (c >> 5), rr = r & 15, cc = c & 31, ob = rr * 64 + cc * 2; return st * 1024 + (ob ^ (((ob >> 9) & 1) << 5)); }
__host__ __device__ __forceinline__ void stage_rc(int b, int& R, int& C) { const int st = b / 1024, sb = b % 1024, swz = sb ^ (((sb >> 9) & 1) << 5); R = (st >> 1) * 16 + swz / 64; C = (st & 1) * 32 + (swz % 64) / 2; }
__host__ __device__ __forceinline__ int perm32(int rho) { const int n = rho >> 4, i = rho & 15; return 8 * (i >> 2) + 4 * n + (i & 3); }

struct Unit { int pm, pn, e, s = 0; };
struct Gemm { const bf16_t* A; const bf16_t* Bt; int lda, ldb, K; size_t bstride; size_t astride = 0; size_t astride2 = 0, bstride2 = 0; };

struct GridOrder {
    int nM, nN, nwg, G, c, xm0, xn0, xnm, nX; const LAS int* tile_e;
    __device__ __forceinline__ void init(int nM_, int nN_, int G_, int c_) { nM = nM_; nN = nN_; nwg = nM * nN; G = G_; c = c_; xm0 = xn0 = 0; xnm = 1; nX = 0; tile_e = nullptr; }
    __device__ __forceinline__ bool next(int i, Unit& u) const {
        long L = (long)i * G + c;
        if (L < nwg) {
            int wgid = (int)L; { const int q = nwg / NXCD, r = nwg % NXCD, xcd = wgid % NXCD, off = wgid / NXCD; wgid = (xcd < r ? xcd * (q + 1) : r * (q + 1) + (xcd - r) * q) + off; }
            const int nig = WGM * nN, gid = wgid / nig, fm = gid * WGM, gsz = (nM - fm) < WGM ? (nM - fm) : WGM;
            u.pm = fm + ((wgid % nig) % gsz); u.pn = (wgid % nig) / gsz; u.e = tile_e ? tile_e[u.pm] : 0; u.s = 0; return true;
        }
        L -= nwg; if (L >= nX) return false;
        u.pm = xm0 + (int)(L % xnm); u.pn = xn0 + (int)(L / xnm); u.e = 0; u.s = 0; return true;
    }
};

struct CtxSplitOrder {
    int nsl, G, c;
    __device__ __forceinline__ bool next(int i, Unit& u) const { const int L = i * G + c; if (L >= 8 * nsl) return false; u.e = L % nsl; u.s = 0; const int q = L / nsl; u.pn = q & 3; u.pm = 64 + (q >> 2); return true; }
};
struct MoeOvOrder {
    int nov, G, c; const LAS int* tile_e;
    __device__ __forceinline__ bool next(int i, Unit& u) const { const int L = i * G + c; if (L >= nov * 8) return false; u.s = L & 1; const int q = L >> 1; u.pn = q & 3; u.pm = 128 + (q >> 2); u.e = tile_e[u.pm]; return true; }
};
template <class Epi, class Sched, bool ALIGN_EPI>
__device__ __forceinline__ void gemm_phase(LAS unsigned char* lds, const Gemm g, const Sched& S, const Epi& E, int wave_id) {
    int wid_l = wave_id; asm volatile("" : "+s"(wid_l)); int lane_l = (int)__builtin_amdgcn_mbcnt_hi(~0u, __builtin_amdgcn_mbcnt_lo(~0u, 0u)); asm volatile("" : "+v"(lane_l));
    const int wid = wid_l, lane = lane_l, tid = wid * 64 + lane, wr = wid >> 2, wc = wid & 3, fr = lane & 15, fq = lane >> 4;
    const int K = g.K, nt = K / BK;
    unsigned voffA[2], voffB[2];
#pragma unroll
    for (int i = 0; i < 2; ++i) { int R, C; stage_rc(tid * 16 + i * 8192, R, C); const int Rb = Epi::PERM ? ((R & ~31) + perm32(R & 31)) : R;
        voffA[i] = (unsigned)(R * g.lda + C) * 2u; voffB[i] = (unsigned)(Rb * g.ldb + C) * 2u; }
    const size_t kstep = (size_t)(BK * 2);
    const size_t hstepA = (size_t)HALF * g.lda * 2, hstepB = (size_t)HALF * g.ldb * 2;
    const unsigned ldsw = (unsigned)wid * 1024u;
    const int aoff = lds_byte(wr * 64 + fr, fq * 8), boff = lds_byte(wc * 32 + fr, fq * 8);
#define PG8_SA(b, h) (((b) * 2 + (h)) * HTB)
#define PG8_SB(b, h) ((4 + (b) * 2 + (h)) * HTB)
#define PG8_STAGE(bufoff, gbase, voff) do { _Pragma("unroll") for (int _i = 0; _i < 2; ++_i) \
        __builtin_amdgcn_global_load_lds((const unsigned*)((const char*)(gbase) + (voff)[_i]), (LAS unsigned*)(lds + (bufoff) + ldsw + _i * 8192), 16, 0, 0); } while (0)
#define PG8_LDA(dst, b, h) do { _Pragma("unroll") for (int m = 0; m < 4; ++m) _Pragma("unroll") for (int k = 0; k < 2; ++k) dst[m][k] = *(const LAS bf16x8*)(lds + PG8_SA(b, h) + aoff + m * 2048 + k * 1024); } while (0)
#define PG8_LDB(dst, b, h) do { _Pragma("unroll") for (int n = 0; n < 2; ++n) _Pragma("unroll") for (int k = 0; k < 2; ++k) dst[n][k] = *(const LAS bf16x8*)(lds + PG8_SB(b, h) + boff + n * 2048 + k * 1024); } while (0)
#define PG8_MMA(ai, bj, At, Bt) do { __builtin_amdgcn_s_setprio(1); _Pragma("unroll") for (int m = 0; m < 4; ++m) _Pragma("unroll") for (int n = 0; n < 2; ++n) _Pragma("unroll") for (int k = 0; k < 2; ++k) \
        acc[ai][bj][m][n] = __builtin_amdgcn_mfma_f32_16x16x32_bf16(Bt[n][k], At[m][k], acc[ai][bj][m][n], 0, 0, 0); __builtin_amdgcn_s_setprio(0); } while (0)
#define PG8_WAIT_V(n) asm volatile("s_waitcnt vmcnt(" #n ")" ::: "memory")
#define PG8_WAIT_L(n) asm volatile("s_waitcnt lgkmcnt(" #n ")" ::: "memory")
#define PG8_BAR __builtin_amdgcn_s_barrier()
#define PG8_SCHED __builtin_amdgcn_sched_barrier(0)
    Unit cur, nxt; int ui = 0;
    if (!S.next(0, cur)) return;
    f32x4 acc[2][2][4][2];
#pragma unroll
    for (int a = 0; a < 2; ++a)
#pragma unroll
        for (int b = 0; b < 2; ++b)
#pragma unroll
            for (int m = 0; m < 4; ++m)
#pragma unroll
                for (int n = 0; n < 2; ++n) acc[a][b][m][n] = (f32x4){0.f, 0.f, 0.f, 0.f};
    bf16x8 At[4][2], B0[2][2], B1[2][2];
    const char* cA = (const char*)g.A + (size_t)cur.pm * 2 * hstepA + (size_t)cur.e * g.astride + (size_t)cur.s * g.astride2; const char* cB = (const char*)g.Bt + (size_t)cur.e * g.bstride + (size_t)cur.s * g.bstride2 + (size_t)cur.pn * 2 * hstepB;
    PG8_STAGE(PG8_SB(0, 0), cB, voffB); PG8_STAGE(PG8_SB(0, 1), cB + hstepB, voffB); PG8_STAGE(PG8_SA(0, 0), cA, voffA); PG8_STAGE(PG8_SA(0, 1), cA + hstepA, voffA);
    if (wr == 1) PG8_BAR;
    PG8_WAIT_V(2); PG8_BAR;
    PG8_STAGE(PG8_SB(1, 0), cB + kstep, voffB); PG8_STAGE(PG8_SA(1, 0), cA + kstep, voffA); PG8_STAGE(PG8_SB(1, 1), cB + hstepB + kstep, voffB);
    PG8_WAIT_V(6); PG8_BAR;
    for (;;) {
        const bool has_next = S.next(ui + 1, nxt);
        const char* nA = has_next ? (const char*)g.A + (size_t)nxt.pm * 2 * hstepA + (size_t)nxt.e * g.astride + (size_t)nxt.s * g.astride2 : cA;
        const char* nB = has_next ? (const char*)g.Bt + (size_t)nxt.e * g.bstride + (size_t)nxt.s * g.bstride2 + (size_t)nxt.pn * 2 * hstepB : cB;
        for (int t = 0; t < nt; t += 2) {
            const bool last = (t == nt - 2);
            const char* a1 = cA + (size_t)(t + 1) * kstep;
            const char* a2 = last ? nA : cA + (size_t)(t + 2) * kstep; const char* b2 = last ? nB : cB + (size_t)(t + 2) * kstep;
            const char* a3 = a2 + kstep; const char* b3 = b2 + kstep;
            PG8_LDB(B0, 0, 0); PG8_LDB(B1, 0, 1); PG8_SCHED; PG8_LDA(At, 0, 0); PG8_STAGE(PG8_SA(1, 1), a1 + hstepA, voffA);
            PG8_WAIT_V(8); PG8_WAIT_L(0); PG8_BAR; PG8_MMA(0, 0, At, B0); PG8_MMA(0, 1, At, B1); PG8_BAR; PG8_SCHED;
            PG8_LDA(At, 0, 1); PG8_STAGE(PG8_SB(0, 0), b2, voffB); PG8_STAGE(PG8_SB(0, 1), b2 + hstepB, voffB); PG8_STAGE(PG8_SA(0, 0), a2, voffA);
            PG8_WAIT_V(8); PG8_WAIT_L(0); PG8_BAR; PG8_MMA(1, 0, At, B0); PG8_MMA(1, 1, At, B1); PG8_BAR; PG8_SCHED;
            PG8_LDB(B0, 1, 0); PG8_LDB(B1, 1, 1); PG8_SCHED; PG8_LDA(At, 1, 0); PG8_STAGE(PG8_SA(0, 1), a2 + hstepA, voffA);
            PG8_WAIT_V(8); PG8_WAIT_L(0); PG8_BAR; PG8_MMA(0, 0, At, B0); PG8_MMA(0, 1, At, B1); PG8_BAR; PG8_SCHED;
            PG8_LDA(At, 1, 1); PG8_STAGE(PG8_SB(1, 0), b3, voffB); PG8_STAGE(PG8_SB(1, 1), b3 + hstepB, voffB); PG8_STAGE(PG8_SA(1, 0), a3, voffA);
            PG8_WAIT_V(8); PG8_WAIT_L(0); PG8_BAR; PG8_MMA(1, 0, At, B0); PG8_MMA(1, 1, At, B1); PG8_BAR; PG8_SCHED;
        }
        if constexpr (ALIGN_EPI) { if (wr == 0) PG8_BAR; }
        E(acc, cur, wr, wc, fr, fq);
        if (!has_next) break;
#pragma unroll
        for (int a = 0; a < 2; ++a)
#pragma unroll
            for (int b = 0; b < 2; ++b)
#pragma unroll
                for (int m = 0; m < 4; ++m)
#pragma unroll
                    for (int n = 0; n < 2; ++n) acc[a][b][m][n] = (f32x4){0.f, 0.f, 0.f, 0.f};
        cur = nxt; cA = nA; cB = nB; ++ui;
        if constexpr (ALIGN_EPI) { if (wr == 1) PG8_BAR; }
    }
    PG8_WAIT_V(0);
    if constexpr (!ALIGN_EPI) { if (wr == 0) PG8_BAR; }
    PG8_BAR;
#undef PG8_SA
#undef PG8_SB
#undef PG8_STAGE
#undef PG8_LDA
#undef PG8_LDB
#undef PG8_MMA
#undef PG8_WAIT_V
#undef PG8_WAIT_L
#undef PG8_BAR
#undef PG8_SCHED
}
typedef f32x4 Acc[2][2][4][2];

struct EpiWin {
    static constexpr bool PERM = true;
    bf16_t* P; bf16_t* G; const float* bgate; float* ssq;
    __device__ __forceinline__ void operator()(const Acc& acc, const Unit& u, int wr, int wc, int fr, int fq) const {
        asm volatile("" : "+v"(fr), "+v"(fq));
        const int row0 = u.pm * BM + wr * 64 + fr;
        if (u.pn < 7) {
#pragma unroll
            for (int bj = 0; bj < 2; ++bj) {
                const int colb = u.pn * BM + bj * HALF + wc * 32, col0 = colb + 8 * fq;
#pragma unroll
                for (int ai = 0; ai < 2; ++ai)
#pragma unroll
                    for (int m = 0; m < 4; ++m) {
                        const int row = row0 + ai * HALF + m * 16;
                        const f32x4 v0 = acc[ai][bj][m][0], v1 = acc[ai][bj][m][1];
                        if (colb < OFF_KR) {
                            float s = (v0[0] * v0[0] + v0[1] * v0[1]) + (v0[2] * v0[2] + v0[3] * v0[3]) + (v1[0] * v1[0] + v1[1] * v1[1]) + (v1[2] * v1[2] + v1[3] * v1[3]);
                            { const int ln = fr + 16 * fq; s += shx(s, 16, ln); s += shx(s, 32, ln); }
                            if (fq == 0) ssq[(size_t)row * 20 + (colb >> 5)] = s;
                        }
                        u32x4 w; w.x = cvt_pk_bf16(v0[0], v0[1]); w.y = cvt_pk_bf16(v0[2], v0[3]); w.z = cvt_pk_bf16(v1[0], v1[1]); w.w = cvt_pk_bf16(v1[2], v1[3]);
                        *(u32x4*)(P + (size_t)row * PP + col0) = w;
                    }
            }
        } else {
            const int g = u.pn - 7, lane = fr + 16 * fq, wid = wr * 4 + wc;
            bf16_t* gt = G + ((size_t)(u.pm * 12 + g) * 8192 + (size_t)wid * 1024 + lane) * 8;
#pragma unroll
            for (int bj = 0; bj < 2; ++bj) {
                const int bc = g * BM + bj * HALF + wc * 32 + 8 * fq;
                const f32x4 b0 = *(const f32x4*)(bgate + bc), b1 = *(const f32x4*)(bgate + bc + 4);
#pragma unroll
                for (int ai = 0; ai < 2; ++ai)
#pragma unroll
                    for (int m = 0; m < 4; ++m) {
                        f32x4 v0 = acc[ai][bj][m][0] + b0, v1 = acc[ai][bj][m][1] + b1;
#pragma unroll
                        for (int i = 0; i < 4; ++i) { v0[i] = sigmoidf_fast(v0[i]); v1[i] = sigmoidf_fast(v1[i]); }
                        u32x4 w; w.x = cvt_pk_bf16(v0[0], v0[1]); w.y = cvt_pk_bf16(v0[2], v0[3]); w.z = cvt_pk_bf16(v1[0], v1[1]); w.w = cvt_pk_bf16(v1[2], v1[3]);
                        *(u32x4*)(gt + (size_t)(((ai * 4 + m) * 2 + bj) * 64) * 8) = w;
                    }
            }
        }
    }
};
struct EpiPlain {
    static constexpr bool PERM = true;
    bf16_t* O; bf16_t* O2; int ldc;
    __device__ __forceinline__ void operator()(const Acc& acc, const Unit& u, int wr, int wc, int fr, int fq) const {
        asm volatile("" : "+v"(fr), "+v"(fq));
        bf16_t* base = O; int pm = u.pm; if (O2 && pm >= 64) { base = O2; pm -= 64; }
        const int row0 = pm * BM + wr * 64 + fr, col0 = u.pn * BM + wc * 32 + 8 * fq;
#pragma unroll
        for (int ai = 0; ai < 2; ++ai)
#pragma unroll
            for (int m = 0; m < 4; ++m) { bf16_t* rowp = base + (size_t)(row0 + ai * HALF + m * 16) * ldc + col0;
#pragma unroll
                for (int bj = 0; bj < 2; ++bj) { const f32x4 v0 = acc[ai][bj][m][0], v1 = acc[ai][bj][m][1];
                    u32x4 w; w.x = cvt_pk_bf16(v0[0], v0[1]); w.y = cvt_pk_bf16(v0[2], v0[3]); w.z = cvt_pk_bf16(v1[0], v1[1]); w.w = cvt_pk_bf16(v1[2], v1[3]);
                    *(u32x4*)(rowp + bj * HALF) = w; } }
    }
};
template <int PASS> struct EpiMerge {
    static constexpr bool PERM = true;
    const bf16_t* G; bf16_t* ytmp; bf16_t* y;
    __device__ __forceinline__ void operator()(const Acc& acc, const Unit& u, int wr, int wc, int fr, int fq) const {
        asm volatile("" : "+v"(fr), "+v"(fq));
        const int lane = fr + 16 * fq, wid = wr * 4 + wc;
        const bf16_t* gt = G + ((size_t)(u.pm * 12 + PASS * 4 + u.pn) * 8192 + (size_t)wid * 1024 + lane) * 8;
        bf16_t* yt = ytmp + ((size_t)(u.pm * 4 + u.pn) * 8192 + (size_t)wid * 1024 + lane) * 8;
        const int row0 = u.pm * BM + wr * 64 + fr, col0 = u.pn * BM + wc * 32 + 8 * fq;
#pragma unroll
        for (int ai = 0; ai < 2; ++ai)
#pragma unroll
            for (int m = 0; m < 4; ++m)
#pragma unroll
                for (int bj = 0; bj < 2; ++bj) {
                    const size_t eo = (size_t)(((ai * 4 + m) * 2 + bj) * 64) * 8;
                    const u32x4 gw = *(const u32x4*)(gt + eo);
                    f32x4 v0 = acc[ai][bj][m][0] * (f32x4){bflo(gw.x), bfhi(gw.x), bflo(gw.y), bfhi(gw.y)}, v1 = acc[ai][bj][m][1] * (f32x4){bflo(gw.z), bfhi(gw.z), bflo(gw.w), bfhi(gw.w)};
                    if (PASS > 0) { const u32x4 o = *(const u32x4*)(yt + eo); v0 += (f32x4){bflo(o.x), bfhi(o.x), bflo(o.y), bfhi(o.y)}; v1 += (f32x4){bflo(o.z), bfhi(o.z), bflo(o.w), bfhi(o.w)}; }
                    u32x4 w; w.x = cvt_pk_bf16(v0[0], v0[1]); w.y = cvt_pk_bf16(v0[2], v0[3]); w.z = cvt_pk_bf16(v1[0], v1[1]); w.w = cvt_pk_bf16(v1[2], v1[3]);
                    if (PASS < 2) *(u32x4*)(yt + eo) = w;
                    else *(u32x4*)(y + (size_t)(row0 + ai * HALF + m * 16) * D + col0 + bj * HALF) = w;
                }
    }
};
struct EpiResid {
    static constexpr bool PERM = true;
    float* X; const float* gates;
    const float* Xin_lat; const float* Xin_ctx;
    __device__ __forceinline__ void operator()(const Acc& acc, const Unit& u, int wr, int wc, int fr, int fq) const {
        asm volatile("" : "+v"(fr), "+v"(fq));
        const int row0 = u.pm * BM + wr * 64 + fr, col0 = u.pn * BM + wc * 32 + 8 * fq;
        const int set = u.pm < 64 ? (u.pm >> 5) : 2;
        const float* gp = gates + set * 6144;
        const float* xin = u.pm < 64 ? Xin_lat + (size_t)row0 * D + col0 : Xin_ctx + (size_t)(row0 - TL) * D + col0;
        f32x4 gv[2][2];
#pragma unroll
        for (int bj = 0; bj < 2; ++bj)
#pragma unroll
            for (int n = 0; n < 2; ++n) gv[bj][n] = *(const f32x4*)(gp + col0 + bj * HALF + n * 4);
#pragma unroll
        for (int ai = 0; ai < 2; ++ai)
#pragma unroll
            for (int m = 0; m < 4; ++m) {
                const size_t ro = (size_t)(ai * HALF + m * 16) * D;
                float* rowp = X + (size_t)row0 * D + col0 + ro;
#pragma unroll
                for (int bj = 0; bj < 2; ++bj)
#pragma unroll
                    for (int n = 0; n < 2; ++n) { *(f32x4*)(rowp + bj * HALF + n * 4) = *(const f32x4*)(xin + ro + bj * HALF + n * 4) + gv[bj][n] * acc[ai][bj][m][n]; }
            }
    }
};
struct EpiCtxPart {
    static constexpr bool PERM = true;
    float* part; const float* gates;
    __device__ __forceinline__ void operator()(const Acc& acc, const Unit& u, int wr, int wc, int fr, int fq) const {
        asm volatile("" : "+v"(fr), "+v"(fq));
        const int row0 = (u.pm - 64) * BM + wr * 64 + fr, col0 = u.pn * BM + wc * 32 + 8 * fq;
        float* pb = part + (size_t)u.e * TC * D;
#pragma unroll
        for (int ai = 0; ai < 2; ++ai)
#pragma unroll
            for (int m = 0; m < 4; ++m) {
                float* rowp = pb + (size_t)(row0 + ai * HALF + m * 16) * D + col0;
#pragma unroll
                for (int bj = 0; bj < 2; ++bj)
#pragma unroll
                    for (int n = 0; n < 2; ++n) *(f32x4*)(rowp + bj * HALF + n * 4) = *(const f32x4*)(gates + col0 + bj * HALF + n * 4) * acc[ai][bj][m][n];
            }
    }
};
struct EpiSwiglu {
    static constexpr bool PERM = false;
    bf16_t* U; int ldu;
    __device__ __forceinline__ void operator()(const Acc& acc, const Unit& u, int wr, int wc, int fr, int fq) const {
        asm volatile("" : "+v"(fr), "+v"(fq));
        const int row0 = u.pm * BM + wr * 64 + fr;
#pragma unroll
        for (int ai = 0; ai < 2; ++ai)
#pragma unroll
            for (int m = 0; m < 4; ++m) {
                bf16_t* rowp = U + (size_t)(row0 + ai * HALF + m * 16) * ldu;
#pragma unroll
                for (int bj = 0; bj < 2; ++bj) {
                    const int gcol = u.pn * BM + bj * HALF + wc * 32;
                    const f32x4 a = acc[ai][bj][m][0], b = acc[ai][bj][m][1];
                    f32x4 o;
#pragma unroll
                    for (int i = 0; i < 4; ++i) o[i] = a[i] * sigmoidf_fast(a[i]) * b[i];
                    u32x2 w; w.x = cvt_pk_bf16(o[0], o[1]); w.y = cvt_pk_bf16(o[2], o[3]);
                    *(u32x2*)(rowp + (gcol >> 1) + 4 * fq) = w;
                }
            }
    }
};
struct EpiMoeDown {
    static constexpr bool PERM = true;
    bf16_t* Y; bf16_t* Y2;
    __device__ __forceinline__ void operator()(const Acc& acc, const Unit& u, int wr, int wc, int fr, int fq) const {
        asm volatile("" : "+v"(fr), "+v"(fq));
        bf16_t* base = u.s ? Y2 + (size_t)(u.pm - 128) * BM * D : Y + (size_t)u.pm * BM * D;
        const int row0 = wr * 64 + fr, col0 = u.pn * BM + wc * 32 + 8 * fq;
#pragma unroll
        for (int ai = 0; ai < 2; ++ai)
#pragma unroll
            for (int m = 0; m < 4; ++m) {
                bf16_t* rowp = base + (size_t)(row0 + ai * HALF + m * 16) * D + col0;
#pragma unroll
                for (int bj = 0; bj < 2; ++bj) { const f32x4 v0 = acc[ai][bj][m][0], v1 = acc[ai][bj][m][1];
                    u32x4 w; w.x = cvt_pk_bf16(v0[0], v0[1]); w.y = cvt_pk_bf16(v0[2], v0[3]); w.z = cvt_pk_bf16(v1[0], v1[1]); w.w = cvt_pk_bf16(v1[2], v1[3]);
                    *(u32x4*)(rowp + bj * HALF) = w; }
            }
    }
};
}

struct Params { const float* in[29]; float* out; unsigned char* ws; };
enum { I_X = 0, I_C, I_CTX, I_CCTX, I_WMOD, I_BMOD, I_GN1, I_WIN, I_BGATE, I_GQ, I_WUQ, I_GKV, I_WUKV, I_WPOOL, I_SPOOL, I_WOA, I_WOB, I_WOC, I_WOUT, I_GN2,
       I_FW1, I_FW3, I_FW2, I_ROUTER, I_RBIAS, I_MW1, I_MW3, I_MW2, I_GFINAL };

struct Ctx {
    LAS unsigned char* lds; int tid, lane, wave, G, bid, gw, ngw;
};

__device__ __forceinline__ Ctx fresh(const Ctx& C0) {
    Ctx C = C0; int w = C0.wave; asm volatile("" : "+s"(w)); int l = (int)__builtin_amdgcn_mbcnt_hi(~0u, __builtin_amdgcn_mbcnt_lo(~0u, 0u)); asm volatile("" : "+v"(l));
    C.wave = w; C.lane = l; C.tid = w * 64 + l; C.gw = C.bid * 8 + w; return C;
}
template <class RowMap>
__device__ __forceinline__ void tr_item(const float* src, int ldn, int k0, int n0, const float* kscale, bf16_t* dst, int dld, int dk0, RowMap rowmap, LAS float* scr, int lane) {
    float v[32];
#pragma unroll
    for (int i = 0; i < 32; ++i) { const int kk = 2 * i + (lane >> 5); v[i] = src[(size_t)(k0 + kk) * ldn + n0 + (lane & 31)]; }
    if (kscale) {
#pragma unroll
        for (int i = 0; i < 32; ++i) v[i] *= kscale[k0 + 2 * i + (lane >> 5)];
    }
#pragma unroll
    for (int i = 0; i < 32; ++i) scr[(2 * i + (lane >> 5)) * 33 + (lane & 31)] = v[i];
    LDS_WAIT(); asm volatile("" ::: "memory");
    const int c = lane & 7;
#pragma unroll
    for (int j = 0; j < 4; ++j) { const int n = (lane >> 3) + 8 * j; const LAS float* s = scr + (8 * c) * 33 + n;
        u32x4 o; o.x = cvt_pk_bf16(s[0 * 33], s[1 * 33]); o.y = cvt_pk_bf16(s[2 * 33], s[3 * 33]); o.z = cvt_pk_bf16(s[4 * 33], s[5 * 33]); o.w = cvt_pk_bf16(s[6 * 33], s[7 * 33]);
        *(u32x4*)(dst + (size_t)rowmap(n0 + n) * dld + dk0 + 8 * c) = o; }
    LDS_WAIT(); asm volatile("" ::: "memory");
}
struct RowId { __device__ __forceinline__ int operator()(int n) const { return n; } };
struct RowWin { __device__ __forceinline__ int operator()(int n) const { return n < OFF_GATE ? n : n + (PP - OFF_GATE); } };
struct RowQ { __device__ __forceinline__ int operator()(int n) const { const int h = n / QKD, d = n % QKD; if (d < 64) return n; const int j = d - 64, a = j >> 4, rh = (j >> 3) & 1, f = j & 7; return h * QKD + 64 + rh * 16 + a * 8 + f; } };
struct RowGU { int add; __device__ __forceinline__ int operator()(int n) const { return 32 * (n >> 4) + (n & 15) + add; } };

__device__ __forceinline__ void norm_row(const float* xrow, const float* g, const float* sh, const float* sc, bf16_t* drow, int lane, f32x4 (&v)[4]) {
    const f32x4* xr = (const f32x4*)xrow + lane;
    float s = 0.f;
#pragma unroll
    for (int j = 0; j < 4; ++j) { v[j] = xr[64 * j]; s += (v[j][0] * v[j][0] + v[j][1] * v[j][1]) + (v[j][2] * v[j][2] + v[j][3] * v[j][3]); }
    const float rstd = __builtin_amdgcn_rsqf(wave_sum(s, lane) * (1.0f / D) + EPS);
#pragma unroll
    for (int j = 0; j < 4; ++j) {
        const f32x4 gg = *((const f32x4*)g + lane + 64 * j), s1 = *((const f32x4*)sc + lane + 64 * j), s0 = *((const f32x4*)sh + lane + 64 * j);
        v[j] = v[j] * rstd * gg * (s1 + 1.0f) + s0;
        u32x2 w; w.x = cvt_pk_bf16(v[j][0], v[j][1]); w.y = cvt_pk_bf16(v[j][2], v[j][3]);
        *((u32x2*)drow + lane + 64 * j) = w;
    }
}
__device__ __forceinline__ void norm_rows(const float* xrow0, int nr, const float* gn, const float* mp, bf16_t* drow0, int lane) {
    f32x4 gsc[4], shv[4], xn[4];
#pragma unroll
    for (int j = 0; j < 4; ++j) { const f32x4 gg = *((const f32x4*)gn + lane + 64 * j), s1 = *((const f32x4*)(mp + 1024) + lane + 64 * j); gsc[j] = gg * (s1 + 1.0f); shv[j] = *((const f32x4*)mp + lane + 64 * j);
        xn[j] = *((const f32x4*)xrow0 + lane + 64 * j); }
#pragma unroll 1
    for (int rr = 0; rr < nr; ++rr) {
        f32x4 v[4];
#pragma unroll
        for (int j = 0; j < 4; ++j) v[j] = xn[j];
        if (rr + 1 < nr) {
#pragma unroll
            for (int j = 0; j < 4; ++j) xn[j] = *((const f32x4*)(xrow0 + (size_t)(rr + 1) * D) + lane + 64 * j);
        }
        float ssx = 0.f;
#pragma unroll
        for (int j = 0; j < 4; ++j) ssx += (v[j][0] * v[j][0] + v[j][1] * v[j][1]) + (v[j][2] * v[j][2] + v[j][3] * v[j][3]);
        const float rstd = __builtin_amdgcn_rsqf(wave_sum(ssx, lane) * (1.0f / D) + EPS);
#pragma unroll
        for (int j = 0; j < 4; ++j) { const f32x4 o = v[j] * rstd * gsc[j] + shv[j]; u32x2 w; w.x = cvt_pk_bf16(o[0], o[1]); w.y = cvt_pk_bf16(o[2], o[3]); *((u32x2*)(drow0 + (size_t)rr * D) + lane + 64 * j) = w; }
    }
}
__device__ __forceinline__ void norm_ctx_row(const float* xsrc, const float* part, int nsl, float* xdst, const float* gn, const float* mp, bf16_t* drow, int lane) {
    f32x4 v[4];
#pragma unroll
    for (int j = 0; j < 4; ++j) v[j] = *((const f32x4*)xsrc + lane + 64 * j);
    for (int s = 0; s < nsl; ++s) {
#pragma unroll
        for (int j = 0; j < 4; ++j) v[j] += *((const f32x4*)(part + (size_t)s * TC * D) + lane + 64 * j);
    }
    float ssx = 0.f;
#pragma unroll
    for (int j = 0; j < 4; ++j) { if (xdst) *((f32x4*)xdst + lane + 64 * j) = v[j]; ssx += (v[j][0] * v[j][0] + v[j][1] * v[j][1]) + (v[j][2] * v[j][2] + v[j][3] * v[j][3]); }
    const float rstd = __builtin_amdgcn_rsqf(wave_sum(ssx, lane) * (1.0f / D) + EPS);
#pragma unroll
    for (int j = 0; j < 4; ++j) { const f32x4 gg = *((const f32x4*)gn + lane + 64 * j), s1 = *((const f32x4*)(mp + 1024) + lane + 64 * j), s0 = *((const f32x4*)mp + lane + 64 * j);
        const f32x4 o = v[j] * rstd * gg * (s1 + 1.0f) + s0; u32x2 w; w.x = cvt_pk_bf16(o[0], o[1]); w.y = cvt_pk_bf16(o[2], o[3]); *((u32x2*)drow + lane + 64 * j) = w; }
}
__device__ __forceinline__ void norm_phase(const Ctx& C, const float* xlat, const float* xctx, const float* gn, const float* mods_l, int which, bf16_t* dst, int nrows, const float* part = nullptr, int nsl = 0, float* xdst = nullptr) {
    for (int ch = C.gw; ch < TL / 8; ch += C.ngw) { const int row = ch * 8; norm_rows(xlat + (size_t)row * D, 8, gn, mods_l + (row >> 13) * 6144 + which * 3072, dst + (size_t)row * D, C.lane); }
    if (nrows > TL) for (int r = C.gw; r < TC; r += C.ngw) {
        if (nsl > 0) norm_ctx_row(xctx + (size_t)r * D, part + (size_t)r * D, nsl, xdst ? xdst + (size_t)r * D : nullptr, gn, mods_l + 2 * 6144 + which * 3072, dst + (size_t)(TL + r) * D, C.lane);
        else norm_rows(xctx + (size_t)r * D, 1, gn, mods_l + 2 * 6144 + which * 3072, dst + (size_t)(TL + r) * D, C.lane);
    }
}

constexpr int FX_LD = 272;
template <class AL, class BL, class EP>
__device__ __forceinline__ void flex_tile(const Ctx& C, int KC, AL aload, BL bload, EP epi) {
    LAS unsigned char* As = C.lds; LAS unsigned char* Bs = C.lds + 128 * FX_LD;
    const int wm = C.wave >> 1, wn = C.wave & 1, r32 = C.lane & 31, hi = C.lane >> 5;
    f32x16 acc[2];
#pragma unroll
    for (int j = 0; j < 2; ++j)
#pragma unroll
        for (int r = 0; r < 16; ++r) acc[j][r] = 0.f;
    for (int kc = 0; kc < KC; kc += 128) {
        __syncthreads();
#pragma unroll
        for (int i = 0; i < 4; ++i) { const int task = C.tid + 512 * i, m = task & 127, c8 = task >> 7;
            const bf16x8 va = aload(m, kc + c8 * 8); *(LAS bf16x8*)(As + m * FX_LD + c8 * 16) = va;
            const bf16x8 vb = bload(m, kc + c8 * 8); *(LAS bf16x8*)(Bs + m * FX_LD + c8 * 16) = vb; }
        __syncthreads();
#pragma unroll
        for (int s = 0; s < 8; ++s) {
            const bf16x8 a = *(const LAS bf16x8*)(As + (32 * wm + r32) * FX_LD + (2 * s + hi) * 16);
#pragma unroll
            for (int j = 0; j < 2; ++j) { const bf16x8 b = *(const LAS bf16x8*)(Bs + (64 * wn + 32 * j + r32) * FX_LD + (2 * s + hi) * 16);
                acc[j] = __builtin_amdgcn_mfma_f32_32x32x16_bf16(b, a, acc[j], 0, 0, 0); }
        }
    }
    const int m = 32 * wm + r32;
#pragma unroll
    for (int j = 0; j < 2; ++j)
#pragma unroll
        for (int r = 0; r < 16; r += 2) epi(m, 64 * wn + 32 * j + crow(r, hi), acc[j][r], acc[j][r + 1]);
}
template <class AL, class BL, class EP>
__device__ __forceinline__ void flex_tile_n256(const Ctx& C, AL aload, BL bload, EP epi) {
    LAS unsigned char* As = C.lds; LAS unsigned char* Bs = C.lds + 128 * FX_LD;
    const int wm = C.wave >> 1, wn = C.wave & 1, r32 = C.lane & 31, hi = C.lane >> 5;
    f32x16 acc[4];
#pragma unroll
    for (int j = 0; j < 4; ++j)
#pragma unroll
        for (int r = 0; r < 16; ++r) acc[j][r] = 0.f;
    __syncthreads();
#pragma unroll
    for (int i = 0; i < 4; ++i) { const int task = C.tid + 512 * i, m = task & 127, c8 = task >> 7;
        const bf16x8 va = aload(m, c8 * 8); *(LAS bf16x8*)(As + m * FX_LD + c8 * 16) = va; }
#pragma unroll
    for (int i = 0; i < 8; ++i) { const int task = C.tid + 512 * i, n = task & 255, c8 = task >> 8;
        const bf16x8 vb = bload(n, c8 * 8); *(LAS bf16x8*)(Bs + n * FX_LD + c8 * 16) = vb; }
    __syncthreads();
#pragma unroll
    for (int s = 0; s < 8; ++s) {
        const bf16x8 a = *(const LAS bf16x8*)(As + (32 * wm + r32) * FX_LD + (2 * s + hi) * 16);
#pragma unroll
        for (int j = 0; j < 4; ++j) { const bf16x8 b = *(const LAS bf16x8*)(Bs + (128 * wn + 32 * j + r32) * FX_LD + (2 * s + hi) * 16);
            acc[j] = __builtin_amdgcn_mfma_f32_32x32x16_bf16(b, a, acc[j], 0, 0, 0); }
    }
    const int m = 32 * wm + r32;
#pragma unroll
    for (int j = 0; j < 4; ++j)
#pragma unroll
        for (int r = 0; r < 16; r += 2) epi(m, 128 * wn + 32 * j + crow(r, hi), acc[j][r], acc[j][r + 1]);
}
__device__ __forceinline__ bf16x8 gather8(const bf16_t* p, size_t ld) {
    bf16x8 v;
#pragma unroll
    for (int t = 0; t < 8; ++t) v[t] = (short)p[(size_t)t * ld];
    return v;
}

struct TT { static constexpr bool value = true; }; struct FF { static constexpr bool value = false; };
constexpr int AT_KT = 128;
constexpr int AT_KLD = 208, AT_VLD = 264, AT_KB = AT_KT * AT_KLD, AT_VB = 64 * AT_VLD, AT_VOFF = 2 * AT_KB;
__device__ __forceinline__ void attn_unit(const Ctx& C, const bf16_t* Q, const bf16_t* Kb, const bf16_t* Vt, bf16_t* O, const float* ssqp, const float* ropep, int b, int h, int qrow0, int NT) {
    const int tid = C.tid, lane = C.lane, wid = C.wave, r32 = lane & 31, hi = lane >> 5;
    LAS unsigned char* L = C.lds;
    const bf16_t* Kh = Kb + (size_t)(b * NH + h) * NKEY * QKD;
    const bf16_t* Vh = Vt + (size_t)(b * NH + h) * VD * NKEY;
    const int qrow = qrow0 + wid * 32 + r32;
    bf16x8 qr[6];
    { const bf16_t* qp = Q + (size_t)qrow * 768 + h * QKD + hi * 8;
      u32x4 raw[6];
#pragma unroll
      for (int s = 0; s < 6; ++s) raw[s] = *(const u32x4*)(qp + 16 * s);
      float rq;
      { const float* sp = ssqp + (size_t)qrow * 20; const f32x4 a = *(const f32x4*)sp, b2 = *(const f32x4*)(sp + 4), c = *(const f32x4*)(sp + 8);
        rq = __builtin_amdgcn_rsqf((((a[0] + a[1]) + (a[2] + a[3])) + ((b2[0] + b2[1]) + (b2[2] + b2[3])) + ((c[0] + c[1]) + (c[2] + c[3]))) * (1.0f / QL) + EPS) * QSCALE; }
#pragma unroll
      for (int s = 0; s < 4; ++s) { u32x4 o; const unsigned wv[4] = {raw[s].x, raw[s].y, raw[s].z, raw[s].w}; unsigned ov[4];
#pragma unroll
          for (int q = 0; q < 4; ++q) ov[q] = cvt_pk_bf16(bflo(wv[q]) * rq, bfhi(wv[q]) * rq);
          o.x = ov[0]; o.y = ov[1]; o.z = ov[2]; o.w = ov[3]; qr[s] = __builtin_bit_cast(bf16x8, o); }
      float cs[8], sn[8];
      if (qrow < TL) { const int l = qrow & (SEQ - 1), pos = hi ? (l & 63) : (l >> 6); const float* rp = ropep + pos * 16;
#pragma unroll
          for (int q = 0; q < 4; ++q) { const f32x4 t = *(const f32x4*)(rp + 4 * q); cs[2 * q] = t[0]; sn[2 * q] = t[1]; cs[2 * q + 1] = t[2]; sn[2 * q + 1] = t[3]; } }
      else {
#pragma unroll
          for (int j = 0; j < 8; ++j) { cs[j] = 1.f; sn[j] = 0.f; } }
      const unsigned w1[4] = {raw[4].x, raw[4].y, raw[4].z, raw[4].w}, w2[4] = {raw[5].x, raw[5].y, raw[5].z, raw[5].w}; unsigned o1[4], o2[4];
#pragma unroll
      for (int q = 0; q < 4; ++q) { const float a0 = bflo(w1[q]), a1 = bfhi(w1[q]), b0 = bflo(w2[q]), b1 = bfhi(w2[q]);
          o1[q] = cvt_pk_bf16((a0 * cs[2 * q] - b0 * sn[2 * q]) * rq, (a1 * cs[2 * q + 1] - b1 * sn[2 * q + 1]) * rq);
          o2[q] = cvt_pk_bf16((b0 * cs[2 * q] + a0 * sn[2 * q]) * rq, (b1 * cs[2 * q + 1] + a1 * sn[2 * q + 1]) * rq); }
      qr[4] = __builtin_bit_cast(bf16x8, ((u32x4){o1[0], o1[1], o1[2], o1[3]})); qr[5] = __builtin_bit_cast(bf16x8, ((u32x4){o2[0], o2[1], o2[2], o2[3]})); }
    int kdst[3], vdst[2]; const bf16_t* vsrc[2];
#pragma unroll
    for (int i = 0; i < 3; ++i) { const int id = tid + 512 * i; kdst[i] = (id / 12) * AT_KLD + (id % 12) * 16; }
#pragma unroll
    for (int i = 0; i < 2; ++i) { const int id = tid + 512 * i, d = id >> 4, ch = id & 15; vdst[i] = AT_VOFF + d * AT_VLD + ch * 16; vsrc[i] = Vh + (size_t)d * NKEY + ch * 8; }
    const bf16_t* ksrc = Kh + (size_t)tid * 8;
    u32x4 kr[3], vr[2];
#pragma unroll
    for (int i = 0; i < 3; ++i) kr[i] = *(const u32x4*)(ksrc + 4096 * i);
#pragma unroll
    for (int i = 0; i < 2; ++i) vr[i] = *(const u32x4*)vsrc[i];
    __syncthreads();
#pragma unroll
    for (int i = 0; i < 3; ++i) *(LAS u32x4*)(L + kdst[i]) = kr[i];
#pragma unroll
    for (int i = 0; i < 2; ++i) { *(LAS u32x2*)(L + vdst[i]) = (u32x2){vr[i].x, vr[i].y}; *(LAS u32x2*)(L + vdst[i] + 8) = (u32x2){vr[i].z, vr[i].w}; }
    __syncthreads();
    constexpr float ATHR = 8.0f;
    float mrun = 0.f, lsum = 0.f;
    f32x16 o0, o1, negm;
#pragma unroll
    for (int r = 0; r < 16; ++r) { o0[r] = 0.f; o1[r] = 0.f; negm[r] = 0.f; }
    auto tile = [&](const int t, auto first) {
        constexpr bool FIRST = decltype(first)::value;
        const int buf = t & 1;
        const bool more = (t + 1 < NT);
        if (more) {
#pragma unroll
            for (int i = 0; i < 3; ++i) kr[i] = *(const u32x4*)(ksrc + (size_t)(t + 1) * (AT_KT * QKD) + 4096 * i);
#pragma unroll
            for (int i = 0; i < 2; ++i) vr[i] = *(const u32x4*)(vsrc[i] + (size_t)(t + 1) * AT_KT);
        }
        const LAS unsigned char* Kt = L + buf * AT_KB; const LAS unsigned char* Vtile = L + AT_VOFF + buf * AT_VB;
        f32x16 p[4];
#pragma unroll
        for (int kb = 0; kb < 4; ++kb)
#pragma unroll
            for (int s = 0; s < 6; ++s) {
                const bf16x8 kf = *(const LAS bf16x8*)(Kt + (32 * kb + r32) * AT_KLD + (2 * s + hi) * 16);
                p[kb] = __builtin_amdgcn_mfma_f32_32x32x16_bf16(kf, qr[s], s == 0 ? negm : p[kb], 0, 0, 0);
            }
        float mx = fmaxf(fmaxf(p[0][0], p[0][1]), p[0][2]);
#pragma unroll
        for (int kb = 0; kb < 4; ++kb)
#pragma unroll
            for (int r = (kb == 0 ? 3 : 0); r + 1 < 16 + (kb == 0 ? 1 : 0); r += 2) { if (r + 1 < 16) mx = fmaxf(fmaxf(mx, p[kb][r]), p[kb][r + 1]); else mx = fmaxf(mx, p[kb][r]); }
        if constexpr (FIRST) {
            if (__any(mx < -64.0f)) {
                mx = fmaxf(mx, shx(mx, 32, lane)); const float dl = fminf(mx, 0.f); mrun = dl;
#pragma unroll
                for (int kb = 0; kb < 4; ++kb)
#pragma unroll
                    for (int r = 0; r < 16; ++r) p[kb][r] -= dl;
#pragma unroll
                for (int r = 0; r < 16; ++r) negm[r] = -dl;
                mx -= dl;
            }
        }
        if (__any(mx > ATHR)) {
            mx = fmaxf(mx, shx(mx, 32, lane));
            const float dl = fmaxf(mx, 0.f); mrun += dl;
            const float alpha = __builtin_amdgcn_exp2f(-dl);
            lsum *= alpha;
#pragma unroll
            for (int kb = 0; kb < 4; ++kb)
#pragma unroll
                for (int r = 0; r < 16; ++r) p[kb][r] -= dl;
#pragma unroll
            for (int r = 0; r < 16; ++r) { o0[r] *= alpha; o1[r] *= alpha; negm[r] = -mrun; }
        }
        bf16x8 pf[8];
        { f32x2 sa = (f32x2){0.f, 0.f};
#pragma unroll
          for (int kb = 0; kb < 4; ++kb) {
#pragma unroll
              for (int r = 0; r < 16; ++r) p[kb][r] = __builtin_amdgcn_exp2f(p[kb][r]);
#pragma unroll
              for (int r = 0; r < 16; r += 2) sa += (f32x2){p[kb][r], p[kb][r + 1]};
#pragma unroll
              for (int s2 = 0; s2 < 2; ++s2) { u32x4 w; w.x = cvt_pk_bf16(p[kb][8 * s2 + 0], p[kb][8 * s2 + 1]); w.y = cvt_pk_bf16(p[kb][8 * s2 + 2], p[kb][8 * s2 + 3]); w.z = cvt_pk_bf16(p[kb][8 * s2 + 4], p[kb][8 * s2 + 5]); w.w = cvt_pk_bf16(p[kb][8 * s2 + 6], p[kb][8 * s2 + 7]);
                  pf[2 * kb + s2] = __builtin_bit_cast(bf16x8, w); }
          }
          lsum += sa[0] + sa[1]; }
#pragma unroll
        for (int st = 0; st < 8; ++st) {
            const int ko = (16 * st + 4 * hi) * 2;
            { const s16x4 lo = *(const LAS s16x4*)(Vtile + r32 * AT_VLD + ko), h4 = *(const LAS s16x4*)(Vtile + r32 * AT_VLD + ko + 16);
              const bf16x8 vf = (bf16x8){lo[0], lo[1], lo[2], lo[3], h4[0], h4[1], h4[2], h4[3]};
              o0 = __builtin_amdgcn_mfma_f32_32x32x16_bf16(vf, pf[st], o0, 0, 0, 0); }
            { const s16x4 lo = *(const LAS s16x4*)(Vtile + (32 + r32) * AT_VLD + ko), h4 = *(const LAS s16x4*)(Vtile + (32 + r32) * AT_VLD + ko + 16);
              const bf16x8 vf = (bf16x8){lo[0], lo[1], lo[2], lo[3], h4[0], h4[1], h4[2], h4[3]};
              o1 = __builtin_amdgcn_mfma_f32_32x32x16_bf16(vf, pf[st], o1, 0, 0, 0); }
        }
        if (more) {
            LAS unsigned char* Ln = L + (buf ^ 1) * AT_KB; LAS unsigned char* Vn = L + (buf ^ 1) * AT_VB;
#pragma unroll
            for (int i = 0; i < 3; ++i) *(LAS u32x4*)(Ln + kdst[i]) = kr[i];
#pragma unroll
            for (int i = 0; i < 2; ++i) { *(LAS u32x2*)(Vn + vdst[i]) = (u32x2){vr[i].x, vr[i].y}; *(LAS u32x2*)(Vn + vdst[i] + 8) = (u32x2){vr[i].z, vr[i].w}; }
        }
        __syncthreads();
    };
    tile(0, TT{});
    for (int t = 1; t < NT; ++t) tile(t, FF{});
    lsum += shx(lsum, 32, lane);
    const float inv = __builtin_amdgcn_rcpf(lsum);
    bf16_t* op = O + (size_t)qrow * 512 + h * VD + 4 * hi;
#pragma unroll
    for (int g = 0; g < 4; ++g) {
        u32x2 w0, w1;
        w0.x = cvt_pk_bf16(o0[4 * g] * inv, o0[4 * g + 1] * inv); w0.y = cvt_pk_bf16(o0[4 * g + 2] * inv, o0[4 * g + 3] * inv);
        w1.x = cvt_pk_bf16(o1[4 * g] * inv, o1[4 * g + 1] * inv); w1.y = cvt_pk_bf16(o1[4 * g + 2] * inv, o1[4 * g + 3] * inv);
        *(u32x2*)(op + 8 * g) = w0; *(u32x2*)(op + 32 + 8 * g) = w1;
    }
}

#ifndef PH
#define PH 0xFFFFFFFFu
#endif
#define PHON(k) ((PH >> (k)) & 1u)
#define PHASE_WS size_t wso_ = 0; asm volatile("" : "+s"(wso_)); unsigned char* ws = ws0 + wso_;
#define PHASE_CTX PHASE_WS const Ctx& Cb_ = C; const Ctx C = fresh(Cb_);

#ifndef DBG
#define DBG 0
#endif
constexpr int CW_DBG = 64;
__device__ __forceinline__ void dbg_scan(const Ctx& C, unsigned char* ws, const void* p, size_t nbytes, bool isf32, int id) {
#if DBG
    const size_t n16 = nbytes / 16; bool bad = false;
    for (size_t i = (size_t)C.bid * 512 + C.tid; i < n16; i += (size_t)C.G * 512) {
        const u32x4 v = ((const u32x4*)p)[i]; const unsigned w[4] = {v.x, v.y, v.z, v.w};
#pragma unroll
        for (int q = 0; q < 4; ++q) { if (isf32) bad |= ((w[q] & 0x7F800000u) >= (145u << 23)); else bad |= ((w[q] & 0x7F80u) >= (145u << 7)) || ((w[q] & 0x7F800000u) >= (145u << 23)); }
    }
    if (bad) atomicMax((unsigned*)(ws + WS_CTL) + CW_DBG, (unsigned)(100 - id));
#endif
}
__device__ __forceinline__ void dbg_max(const Ctx& C, unsigned char* ws, const void* p, size_t nbytes, int slot) {
    const size_t n16 = nbytes / 16; unsigned mx = 0u;
    for (size_t i = (size_t)C.bid * 512 + C.tid; i < n16; i += (size_t)C.G * 512) {
        const u32x4 v = ((const u32x4*)p)[i]; const unsigned w[4] = {v.x, v.y, v.z, v.w};
#pragma unroll
        for (int q = 0; q < 4; ++q) { const unsigned a = (w[q] & 0x7FFFu) << 16, b = w[q] & 0x7FFF0000u; mx = a > mx ? a : mx; mx = b > mx ? b : mx; }
    }
    if (mx > 0x7E000000u) mx = 0x7E000000u;
    atomicMax((unsigned*)(ws + WS_CTL) + CW_DBG + 1 + slot, mx);
}
#define DBGMAX(p, nbytes, slot) do { if (DBG) { PHASE_CTX dbg_max(C, ws, (p), (nbytes), (slot)); } } while (0)
#define DBGSCAN(p, nbytes, isf32, id) do { if (DBG) { PHASE_CTX dbg_scan(C, ws, (p), (nbytes), (isf32), (id)); } } while (0)
#define GRID_BAR() xcd_barrier(bar, C.wave)
#define mods ((float*)(ws + WS_MODS))
#define ropet ((float*)(ws + WS_ROPE))
#define twt ((float*)(ws + WS_TW))
#define dft128 ((bf16_t*)(ws + WS_DFT128))
#define m64 ((bf16_t*)(ws + WS_M64))
#define dft256 ((bf16_t*)(ws + WS_DFT256))
#define ssq ((float*)(ws + WS_SSQ))
#define xw ((float*)(ws + WS_XW))
#define Pb ((bf16_t*)(ws + WS_P))
#define Gt ((bf16_t*)(ws + WS_G))
#define A1 ((bf16_t*)(ws + WS_A1))
#define Qb ((bf16_t*)(ws + WS_Q))
#define Kb ((bf16_t*)(ws + WS_K))
#define Vtb ((bf16_t*)(ws + WS_VT))
#define ytmp ((float*)(ws + WS_A2))
#define AO ((bf16_t*)(ws + WS_AO))
#define MIXb ((bf16_t*)(ws + WS_MIX))
#define YY ((bf16_t*)(ws + WS_YY))
template <int layer>
__device__ __forceinline__ void layer_body(const Ctx& C, const Params& prm, unsigned char* ws0, const XcdBarrier& bar) {
    constexpr bool last = (layer == 1);
        const int nrt = last ? 64 : 66;
#define mods_l (mods + (size_t)layer * 3 * 6144)
#define lw (ws + WS_PERM + (size_t)layer * LW_SIZE)
        if (PHON(2)) { PHASE_WS
            pg8::Gemm g{A1, (const bf16_t*)(lw + LW_IN), 1024, 1024, 1024, 0};
            pg8::GridOrder S; S.init(nrt, NIN / 256, C.G, C.bid);
            if (last) { S.xm0 = 64; S.xn0 = 1; S.xnm = 2; S.nX = 4; }
            pg8::EpiWin E{Pb, Gt, prm.in[I_BGATE] + layer * 3072, ssq};
            pg8::gemm_phase<pg8::EpiWin, pg8::GridOrder, true>(C.lds, g, S, E, C.wave);
        }
        GRID_BAR();
        DBGSCAN(Pb, (size_t)nrt * 256 * NIN * 2, false, 15 * layer + 3); DBGSCAN(ssq, (size_t)nrt * 256 * 20 * 4, true, 15 * layer + 3);
        {
            if (PHON(3)) { PHASE_WS pg8::Gemm g{Pb, (const bf16_t*)(lw + LW_UQ), PP, QL, QL, 0};
              pg8::GridOrder S; S.init(nrt, 3, C.G, C.bid);
              pg8::EpiPlain E{Qb, nullptr, 768};
              pg8::gemm_phase<pg8::EpiPlain, pg8::GridOrder, true>(C.lds, g, S, E, C.wave); }
            if (PHON(4)) { PHASE_CTX
              pg8::Gemm g{Pb + OFF_KV, (const bf16_t*)(lw + LW_UKV), PP, KVL, KVL, 0};
              pg8::GridOrder S; S.init(66, 4, C.G, (C.bid + C.G / 2) % C.G);
              pg8::EpiPlain E{YY, AO, 1024};
              pg8::gemm_phase<pg8::EpiPlain, pg8::GridOrder, true>(C.lds, g, S, E, C.wave);
              VM_WAIT(); __syncthreads();
              pg8::Unit u;
              for (int i = 0; S.next(i, u); ++i) {
                  const bool lat = u.pm < 64;
                  const int bb = lat ? (u.pm >> 5) : (u.pm - 64), key0 = lat ? (NCTX + (u.pm & 31) * 256) : 0;
                  const int row = C.tid >> 1, hh = C.tid & 1, grow = u.pm * 256 + row;
                  const bf16_t* rawrow = (lat ? YY + (size_t)grow * 1024 : AO + (size_t)(grow - TL) * 1024) + u.pn * 256 + hh * 128;
                  float r;
                  { const float* sp = ssq + (size_t)grow * 20 + 12; const f32x4 a = *(const f32x4*)sp, b = *(const f32x4*)(sp + 4);
                    r = __builtin_amdgcn_rsqf((((a[0] + a[1]) + (a[2] + a[3])) + ((b[0] + b[1]) + (b[2] + b[3]))) * (1.0f / KVL) + EPS); }
                  const int h = u.pn * 2 + hh;
                  { bf16_t* kdst = Kb + ((size_t)(bb * NH + h) * NKEY + key0 + row) * QKD;
#pragma unroll
                    for (int c = 0; c < 8; ++c) { const u32x4 v = *(const u32x4*)(rawrow + 8 * c); u32x4 o;
                        o.x = cvt_pk_bf16(bflo(v.x) * r, bfhi(v.x) * r); o.y = cvt_pk_bf16(bflo(v.y) * r, bfhi(v.y) * r); o.z = cvt_pk_bf16(bflo(v.z) * r, bfhi(v.z) * r); o.w = cvt_pk_bf16(bflo(v.w) * r, bfhi(v.w) * r);
                        *(u32x4*)(kdst + 8 * c) = o; } }
                  constexpr int VSLD = 528;
#pragma unroll 1
                  for (int hv = 0; hv < 2; ++hv) {
                      __syncthreads();
                      { const bf16_t* vr = rawrow - hh * 128 + hv * 128 + 64 + hh * 32;
#pragma unroll
                        for (int c = 0; c < 4; ++c) { const u32x4 v = *(const u32x4*)(vr + 8 * c); const unsigned wv[4] = {v.x, v.y, v.z, v.w};
#pragma unroll
                            for (int q = 0; q < 4; ++q) { const unsigned pk = cvt_pk_bf16(bflo(wv[q]) * r, bfhi(wv[q]) * r); const int d = hh * 32 + c * 8 + q * 2;
                                *(LAS bf16_t*)(C.lds + d * VSLD + row * 2) = (bf16_t)(pk & 0xffffu); *(LAS bf16_t*)(C.lds + (d + 1) * VSLD + row * 2) = (bf16_t)(pk >> 16); } } }
                      __syncthreads();
                      { const int d = C.tid >> 3, ch = C.tid & 7; bf16_t* vdst = Vtb + ((size_t)(bb * NH + u.pn * 2 + hv) * VD + d) * NKEY + key0;
#pragma unroll
                        for (int c = 0; c < 4; ++c) { const int k8 = ch * 4 + c; *(u32x4*)(vdst + 8 * k8) = *(const LAS u32x4*)(C.lds + d * VSLD + k8 * 16); } }
                  }
                  __syncthreads();
              } }
            if (PHON(5)) { PHASE_CTX for (int row = C.gw; row < T; row += C.ngw) {
                const bool lat = row < TL;
                const int t = lat ? (row & (SEQ - 1)) : ((row - TL) & 255), Ls = lat ? SEQ : NCTX;
                if (lat || !last) {
                    const int g = C.lane >> 4, w = 2 << g, left = w >> 1, right = w - 1 - left;
                    const int lo = max(t - left, 0), hiE = min(t + right + 1, Ls);
                    float s[8] = {0.f, 0.f, 0.f, 0.f, 0.f, 0.f, 0.f, 0.f};
                    const bf16_t* base = Pb + (size_t)(row - t) * PP + OFF_POOL + C.lane * 8;
                    u32x4 wv[16];
#pragma unroll
                    for (int j = 0; j < 16; ++j) { const int tt = t + j - 8; wv[j] = (tt >= lo && tt < hiE) ? *(const u32x4*)(base + (size_t)tt * PP) : (u32x4){0u, 0u, 0u, 0u}; }
#pragma unroll
                    for (int j = 0; j < 16; ++j) { const u32x4 v = wv[j];
                        s[0] += bflo(v.x); s[1] += bfhi(v.x); s[2] += bflo(v.y); s[3] += bfhi(v.y); s[4] += bflo(v.z); s[5] += bfhi(v.z); s[6] += bflo(v.w); s[7] += bfhi(v.w); }
                    const u32x4 me = wv[8];
                    const float ic = 1.0f / (float)(hiE - lo);
                    u32x4 o; o.x = cvt_pk_bf16(s[0] * ic - bflo(me.x), s[1] * ic - bfhi(me.x)); o.y = cvt_pk_bf16(s[2] * ic - bflo(me.y), s[3] * ic - bfhi(me.y));
                    o.z = cvt_pk_bf16(s[4] * ic - bflo(me.z), s[5] * ic - bfhi(me.z)); o.w = cvt_pk_bf16(s[6] * ic - bflo(me.w), s[7] * ic - bfhi(me.w));
                    *(u32x4*)(MIXb + (size_t)row * 512 + C.lane * 8) = o;
                }
                if (C.lane < 16) {
                    const int a = C.lane >> 3, f = C.lane & 7;
                    const float x1 = bf2f(Pb[(size_t)row * PP + OFF_KR + a * 16 + f]), x2 = bf2f(Pb[(size_t)row * PP + OFF_KR + a * 16 + 8 + f]);
                    float cs = 1.f, sn = 0.f;
                    if (lat) { const int pos = a ? (t & 63) : (t >> 6); cs = ropet[(pos * 8 + f) * 2]; sn = ropet[(pos * 8 + f) * 2 + 1]; }
                    const bf16_t o1 = f2bf(x1 * cs - x2 * sn), o2 = f2bf(x2 * cs + x1 * sn);
                    const int bb = lat ? (row >> 13) : ((row - TL) >> 8), key = lat ? (NCTX + t) : t;
#pragma unroll
                    for (int h = 0; h < NH; ++h) { bf16_t* kp = Kb + ((size_t)(bb * NH + h) * NKEY + key) * QKD + 64 + a * 8 + f; kp[0] = o1; kp[16] = o2; }
                }
            } }
            if (PHON(6)) { PHASE_CTX for (int un = C.bid; un < 512; un += C.G) {
                const int cch = un & 3, l2 = (un >> 2) & 63, b = un >> 8;
                const bf16_t* src = Pb + (size_t)(b * SEQ + l2) * PP + OFF_FFT + cch * 128;
                flex_tile_n256(C,
                    [&](int m, int k) { return gather8(src + (size_t)k * 64 * PP + m, (size_t)64 * PP); },
                    [&](int n, int k) { return *(const bf16x8*)(dft128 + (size_t)n * 128 + k); },
                    [&](int m, int n, float re, float im) {
                        const int k1 = n >> 1; const float tc = twt[(k1 * 64 + l2) * 2], ts = twt[(k1 * 64 + l2) * 2 + 1];
                        bf16_t* dp = A1 + ((size_t)((b * 128 + k1) * 64 + l2) * 2) * 512 + cch * 128 + m;
                        dp[0] = f2bf(re * tc + im * ts); dp[512] = f2bf(im * tc - re * ts); });
            } }
            if (PHON(7) && !last) { PHASE_CTX for (int un = C.bid; un < 32; un += C.G) {
                const int nch = un & 3, cch = (un >> 2) & 3, b = un >> 4;
                const bf16_t* src = Pb + (size_t)(TL + b * NCTX) * PP + OFF_FFT + cch * 128;
                flex_tile(C, 256,
                    [&](int m, int k) { return gather8(src + (size_t)k * PP + m, (size_t)PP); },
                    [&](int n, int k) { return *(const bf16x8*)(dft256 + (size_t)(nch * 128 + n) * 256 + k); },
                    [&](int m, int n, float re, float im) {
                        const int kf = (nch * 128 + n) >> 1;
                        bf16_t* dp = YY + (size_t)(TL + b * NCTX + kf) * 1024 + cch * 256 + m;
                        dp[0] = f2bf(re * 5.656854249f); dp[128] = f2bf(im * 5.656854249f); });
            } }
        }
        GRID_BAR();
        DBGSCAN(Qb, (size_t)nrt * 256 * 768 * 2, false, 15 * layer + 4); DBGSCAN(Kb, (size_t)NB * NH * NKEY * QKD * 2, false, 15 * layer + 4); DBGSCAN(Vtb, (size_t)NB * NH * VD * NKEY * 2, false, 15 * layer + 4);
        DBGSCAN(MIXb, (size_t)nrt * 256 * 512 * 2, false, 15 * layer + 5); DBGSCAN(A1, (size_t)TL * 1024 * 2, false, 15 * layer + 5); if (!last) DBGSCAN(YY + (size_t)TL * 1024, (size_t)TC * 1024 * 2, false, 15 * layer + 5);
        {
            if (PHON(8)) { PHASE_CTX for (int un = C.bid; un < 1024; un += C.G) {
                const int cch = un & 3, k1 = (un >> 2) & 127, b = un >> 9;
                const bf16_t* src = A1 + (size_t)((b * 128 + k1) * 128) * 512 + cch * 128;
                flex_tile(C, 128,
                    [&](int m, int k) { return gather8(src + (size_t)k * 512 + m, (size_t)512); },
                    [&](int n, int k) { return *(const bf16x8*)(m64 + (size_t)n * 128 + k); },
                    [&](int m, int n, float yr, float yi) {
                        const int k2 = n >> 1;
                        bf16_t* dp = YY + (size_t)(b * SEQ + k1 + 128 * k2) * 1024 + cch * 256 + m;
                        dp[0] = f2bf(yr); dp[128] = f2bf(yi); });
            } }
            __syncthreads();
            const int vcu = (C.G % 8 == 0) ? (C.bid % 8) * (C.G / 8) + C.bid / 8 : C.bid;
            if (PHON(9)) { PHASE_CTX for (int un = vcu; un < 512; un += C.G) { const int bh = un >> 5, qb = un & 31; attn_unit(C, Qb, Kb, Vtb, AO, ssq, ropet, bh >> 3, bh & 7, (bh >> 3) * SEQ + qb * 256, NKEY / AT_KT); } }
            if (PHON(9) && !last) { PHASE_CTX for (int un = C.bid; un < 16; un += C.G) { const int b = un >> 3, h = un & 7; attn_unit(C, Qb, Kb, Vtb, AO, ssq, ropet, b, h, TL + b * NCTX, NCTX / AT_KT); } }
            __syncthreads();
        }
        GRID_BAR();
        DBGSCAN(AO, (size_t)nrt * 256 * 512 * 2, false, 15 * layer + 13); DBGSCAN(YY, (size_t)nrt * 256 * 1024 * 2, false, 15 * layer + 6);
        {
            pg8::GridOrder S; S.init(nrt, 4, C.G, C.bid);
            if (PHON(10)) { PHASE_WS pg8::Gemm g{AO, (const bf16_t*)(lw + LW_OA), 512, 512, 512, 0}; pg8::EpiMerge<0> E{Gt, (bf16_t*)ytmp, A1};
              pg8::gemm_phase<pg8::EpiMerge<0>, pg8::GridOrder, true>(C.lds, g, S, E, C.wave); }
            if (PHON(11)) { PHASE_WS pg8::Gemm g{MIXb, (const bf16_t*)(lw + LW_PB), 512, 512, 512, 0}; pg8::EpiMerge<1> E{Gt, (bf16_t*)ytmp, A1};
              pg8::gemm_phase<pg8::EpiMerge<1>, pg8::GridOrder, true>(C.lds, g, S, E, C.wave); }
            if (PHON(12)) { PHASE_WS pg8::Gemm g{YY, (const bf16_t*)(lw + LW_FC), 1024, 1024, 1024, 0}; pg8::EpiMerge<2> E{Gt, (bf16_t*)ytmp, A1};
              pg8::gemm_phase<pg8::EpiMerge<2>, pg8::GridOrder, true>(C.lds, g, S, E, C.wave); }
        }
        GRID_BAR();
        DBGSCAN(A1, (size_t)nrt * 256 * 1024 * 2, false, 15 * layer + 7);
        if (PHON(13)) { PHASE_WS
            { pg8::Gemm g{A1, (const bf16_t*)(lw + LW_OUT), 1024, 1024, 1024, 0};
              pg8::GridOrder S; S.init(64, 4, C.G, C.bid);
              pg8::EpiResid E{xw, mods_l + 2 * 1024, last ? (const float*)xw : prm.in[I_X], xw + (size_t)TL * D};
              pg8::gemm_phase<pg8::EpiResid, pg8::GridOrder, true>(C.lds, g, S, E, C.wave); }
            if (!last) { pg8::Gemm g{A1, (const bf16_t*)(lw + LW_OUT), 1024, 1024, 256, 512, 512};
              pg8::CtxSplitOrder S{4, C.G, (C.bid + 128) % C.G};
              pg8::EpiCtxPart E{ytmp, mods_l + 2 * 6144 + 2 * 1024};
              pg8::gemm_phase<pg8::EpiCtxPart, pg8::CtxSplitOrder, true>(C.lds, g, S, E, C.wave); }
        }
        GRID_BAR();
        DBGSCAN(xw, (size_t)T * 1024 * 4, true, 15 * layer + 8);
        if (!last) {
            if (PHON(14)) { PHASE_CTX norm_phase(C, xw, prm.in[I_CTX], prm.in[I_GN2] + layer * D, mods_l, 1, A1, T, ytmp, 4, xw + (size_t)TL * D); }
            GRID_BAR();
            DBGSCAN(A1, (size_t)T * 1024 * 2, false, 15 * layer + 9);
            if (PHON(15)) { PHASE_WS
                pg8::Gemm g{A1, (const bf16_t*)(ws + WS_FFN13), 1024, 1024, 1024, 0};
                pg8::GridOrder S; S.init(66, 22, C.G, C.bid);
                pg8::EpiSwiglu E{(bf16_t*)(ws + WS_U), DFF};
                pg8::gemm_phase<pg8::EpiSwiglu, pg8::GridOrder, true>(C.lds, g, S, E, C.wave);
            }
            GRID_BAR();
            DBGSCAN(ws + WS_U, (size_t)T * DFF * 2, false, 15 * layer + 10);
            if (PHON(16)) { PHASE_WS
                { pg8::Gemm g{(const bf16_t*)(ws + WS_U), (const bf16_t*)(ws + WS_FFN2), DFF, DFF, DFF, 0};
                  pg8::GridOrder S; S.init(64, 4, C.G, C.bid);
                  pg8::EpiResid E{xw, mods_l + 5 * 1024, xw, xw + (size_t)TL * D};
                  pg8::gemm_phase<pg8::EpiResid, pg8::GridOrder, true>(C.lds, g, S, E, C.wave); }
                { pg8::Gemm g{(const bf16_t*)(ws + WS_U), (const bf16_t*)(ws + WS_FFN2), DFF, DFF, 256, 512, 512};
                  pg8::CtxSplitOrder S{11, C.G, (C.bid + 128) % C.G};
                  pg8::EpiCtxPart E{ytmp, mods_l + 2 * 6144 + 5 * 1024};
                  pg8::gemm_phase<pg8::EpiCtxPart, pg8::CtxSplitOrder, true>(C.lds, g, S, E, C.wave); }
            }
            GRID_BAR();
            DBGSCAN(xw, (size_t)T * 1024 * 4, true, 15 * layer + 11);
            if (PHON(17)) { PHASE_CTX norm_phase(C, xw, xw + (size_t)TL * D, prm.in[I_GN1] + D, mods + (size_t)3 * 6144, 0, A1, T, ytmp, 11, nullptr); }
            GRID_BAR();
        } else {
#define route_e ((int*)(ws + WS_ROUTE_E))
#define route_w ((float*)(ws + WS_ROUTE_W))
#define tokslot ((int*)(ws + WS_TOKSLOT))
#define blkcnt ((int*)(ws + WS_BLKCNT))
#define h2m ((bf16_t*)(ws + WS_H2M))
#define h2g ((bf16_t*)(ws + WS_H2G))
#define uf ((bf16_t*)(ws + WS_UF))
#define yx2 ((bf16_t*)(ws + WS_YX2))
#define yexp ((bf16_t*)(ws + WS_YEXP))
            LAS int* tile_e = (LAS int*)(C.lds + TILE_E_OFF);
            LAS int* sc_i = (LAS int*)(C.lds + SCR_OFF);
            if (PHON(18)) { PHASE_CTX
                LAS float* wscr = (LAS float*)(C.lds + C.wave * 8448);
                const float* wrt = prm.in[I_ROUTER]; const float* rb = prm.in[I_RBIAS];
                for (int blk = C.bid; blk < 256; blk += C.G) {
                    const int rowb = blk * 64 + C.wave * 8, set = rowb >> 13;
                    const float* mp = mods_l + set * 6144 + 3072; const float* gn = prm.in[I_GN2] + D;
                    f32x4 gsc[4], shv[4]; float wreg[4][4][8];
#pragma unroll
                    for (int j = 0; j < 4; ++j) { const f32x4 gg = *((const f32x4*)gn + C.lane + 64 * j), s1 = *((const f32x4*)(mp + 1024) + C.lane + 64 * j); gsc[j] = gg * (s1 + 1.0f); shv[j] = *((const f32x4*)mp + C.lane + 64 * j);
#pragma unroll
                        for (int i = 0; i < 4; ++i) { const float* wp = wrt + (size_t)(4 * (C.lane + 64 * j) + i) * 8; const f32x4 w0 = *(const f32x4*)wp, w1 = *(const f32x4*)(wp + 4);
                            wreg[j][i][0] = w0[0]; wreg[j][i][1] = w0[1]; wreg[j][i][2] = w0[2]; wreg[j][i][3] = w0[3]; wreg[j][i][4] = w1[0]; wreg[j][i][5] = w1[1]; wreg[j][i][6] = w1[2]; wreg[j][i][7] = w1[3]; } }
                    f32x4 xn[4];
#pragma unroll
                    for (int j = 0; j < 4; ++j) xn[j] = *((const f32x4*)(xw + (size_t)rowb * D) + C.lane + 64 * j);
#pragma unroll 1
                    for (int rr = 0; rr < 8; ++rr) {
                        const int row = rowb + rr;
                        f32x4 v[4];
#pragma unroll
                        for (int j = 0; j < 4; ++j) v[j] = xn[j];
                        if (rr < 7) {
#pragma unroll
                            for (int j = 0; j < 4; ++j) xn[j] = *((const f32x4*)(xw + (size_t)(row + 1) * D) + C.lane + 64 * j);
                        }
                        float ssx = 0.f;
#pragma unroll
                        for (int j = 0; j < 4; ++j) ssx += (v[j][0] * v[j][0] + v[j][1] * v[j][1]) + (v[j][2] * v[j][2] + v[j][3] * v[j][3]);
                        const float rstd = __builtin_amdgcn_rsqf(wave_sum(ssx, C.lane) * (1.0f / D) + EPS);
                        float lg[8] = {0.f, 0.f, 0.f, 0.f, 0.f, 0.f, 0.f, 0.f};
#pragma unroll
                        for (int j = 0; j < 4; ++j) {
                            v[j] = v[j] * rstd * gsc[j] + shv[j];
                            u32x2 w; w.x = cvt_pk_bf16(v[j][0], v[j][1]); w.y = cvt_pk_bf16(v[j][2], v[j][3]);
                            *((u32x2*)(h2m + (size_t)row * D) + C.lane + 64 * j) = w;
#pragma unroll
                            for (int i = 0; i < 4; ++i)
#pragma unroll
                                for (int e = 0; e < 8; ++e) lg[e] += v[j][i] * wreg[j][i][e];
                        }
#pragma unroll
                        for (int e = 0; e < 8; ++e) lg[e] = wave_sum(lg[e], C.lane) + rb[e];
                        int ea = 0; float va = lg[0];
#pragma unroll
                        for (int e = 1; e < 8; ++e) if (lg[e] > va) { va = lg[e]; ea = e; }
                        int eb = (ea + 1) & 7; float vb = -3.0e38f;
#pragma unroll
                        for (int e = 0; e < 8; ++e) if (e != ea && lg[e] > vb) { vb = lg[e]; eb = e; }
                        const float wa = 1.0f / (1.0f + expf(vb - va));
                        if (C.lane == 0) { route_e[row] = ea | (eb << 8); route_w[2 * row] = wa; route_w[2 * row + 1] = 1.0f - wa; }
                    }
                    __syncthreads();
                    VM_WAIT(); __syncthreads();
                    if (C.tid < 8) { int c = 0; for (int i = 0; i < 64; ++i) { const int e2 = __hip_atomic_load(route_e + blk * 64 + i, __ATOMIC_RELAXED, __HIP_MEMORY_SCOPE_AGENT); c += ((e2 & 255) == C.tid) + ((e2 >> 8) == C.tid); }
                        blkcnt[blk * 8 + C.tid] = c; }
                    __syncthreads();
                }
                constexpr int IE1 = 16 * 88, IE2 = 44 * 32, IE = 2 * IE1 + IE2;
                for (int it = C.gw; it < NE * IE; it += C.ngw) {
                    const int e = it / IE; int r = it % IE;
                    if (r < 2 * IE1) { const int w3 = r >= IE1; if (w3) r -= IE1; const int kb = r / 88, nb = r % 88;
                        tr_item(prm.in[w3 ? I_MW3 : I_MW1] + (size_t)e * D * DFF, DFF, 64 * kb, 32 * nb, nullptr, (bf16_t*)(ws + WS_MW13) + (size_t)e * 5632 * 1024, 1024, 64 * kb, RowGU{w3 ? 16 : 0}, wscr, C.lane); }
                    else { r -= 2 * IE1; const int kb = r / 32, nb = r % 32;
                        tr_item(prm.in[I_MW2] + (size_t)e * DFF * D, 1024, 64 * kb, 32 * nb, nullptr, (bf16_t*)(ws + WS_MW2) + (size_t)e * 1024 * DFF, DFF, 64 * kb, RowId{}, wscr, C.lane); }
                }
            }
            GRID_BAR();
            DBGSCAN(h2m, (size_t)TL * 1024 * 2, false, 24); DBGSCAN(ws + WS_MW13, (size_t)NE * 5632 * 1024 * 2 + (size_t)NE * 1024 * DFF * 2, false, 25);
            if (PHON(19)) { PHASE_CTX
                __syncthreads();
                if (C.tid < 8) { int tot = 0; for (int b2 = 0; b2 < 256; ++b2) tot += blkcnt[b2 * 8 + C.tid]; sc_i[128 + C.tid] = tot; }
                __syncthreads();
                if (C.tid == 0) { int seg = 0, tl = 0; for (int e = 0; e < 8; ++e) { sc_i[136 + e] = seg; const int ntl = (sc_i[128 + e] + 255) >> 8; for (int q = 0; q < ntl; ++q) tile_e[tl++] = e; seg += ntl * 256; } tile_e[140] = tl; }
                __syncthreads();
                for (int blk = C.bid; blk < 256; blk += C.G) {
                    if (C.tid < 8) { int run = sc_i[136 + C.tid]; for (int b2 = 0; b2 < blk; ++b2) run += blkcnt[b2 * 8 + C.tid];
                        for (int i = 0; i < 64; ++i) { const int e2 = route_e[blk * 64 + i]; if ((e2 & 255) == C.tid) { sc_i[256 + 2 * i] = run; tokslot[2 * (blk * 64 + i)] = run; ++run; } if ((e2 >> 8) == C.tid) { sc_i[256 + 2 * i + 1] = run; tokslot[2 * (blk * 64 + i) + 1] = run; ++run; } } }
                    __syncthreads();
                    for (int rr = 0; rr < 8; ++rr) { const int lr = C.wave * 8 + rr, row = blk * 64 + lr;
                        const u32x4* sp = (const u32x4*)(h2m + (size_t)row * D) + C.lane; const u32x4 v0 = sp[0], v1 = sp[64];
                        u32x4* d0 = (u32x4*)(h2g + (size_t)sc_i[256 + 2 * lr] * D) + C.lane; u32x4* d1 = (u32x4*)(h2g + (size_t)sc_i[256 + 2 * lr + 1] * D) + C.lane;
                        d0[0] = v0; d0[64] = v1; d1[0] = v0; d1[64] = v1; }
                    __syncthreads();
                }
                if (C.bid < 8) { const int e = C.bid, cnt = sc_i[128 + e], s0 = sc_i[136 + e] + cnt, s1 = sc_i[136 + e] + (((cnt + 255) >> 8) << 8);
                    for (int i = C.tid; i < (s1 - s0) * 128; i += 512) *((u32x4*)(h2g + (size_t)s0 * D) + i) = (u32x4){0u, 0u, 0u, 0u}; }
            }
            GRID_BAR();
            const int ntiles = tile_e[140];
            DBGSCAN(h2g, (size_t)ntiles * 256 * 1024 * 2, false, 26);
            {
                if (PHON(20)) { PHASE_WS pg8::Gemm g{h2g, (const bf16_t*)(ws + WS_MW13), 1024, 1024, 1024, (size_t)5632 * 1024 * 2};
                  pg8::GridOrder S; S.init(ntiles, 22, C.G, C.bid); S.tile_e = tile_e;
                  pg8::EpiSwiglu E{uf, DFF};
                  pg8::gemm_phase<pg8::EpiSwiglu, pg8::GridOrder, true>(C.lds, g, S, E, C.wave); }
                GRID_BAR();
                if (PHON(21)) { PHASE_WS
                  { pg8::Gemm g{uf, (const bf16_t*)(ws + WS_MW2), DFF, DFF, DFF, (size_t)1024 * DFF * 2};
                    pg8::GridOrder S; S.init(ntiles < 128 ? ntiles : 128, 4, C.G, C.bid); S.tile_e = tile_e;
                    pg8::EpiMoeDown E{yexp, yx2};
                    pg8::gemm_phase<pg8::EpiMoeDown, pg8::GridOrder, true>(C.lds, g, S, E, C.wave); }
                  if (ntiles > 128) { pg8::Gemm g{uf, (const bf16_t*)(ws + WS_MW2), DFF, DFF, DFH, (size_t)1024 * DFF * 2, 0, (size_t)DFH * 2, (size_t)DFH * 2};
                    pg8::MoeOvOrder S{ntiles - 128, C.G, (C.bid + 128) % C.G, tile_e};
                    pg8::EpiMoeDown E{yexp, yx2};
                    pg8::gemm_phase<pg8::EpiMoeDown, pg8::MoeOvOrder, true>(C.lds, g, S, E, C.wave); }
                }
                GRID_BAR();
            }
            if (PHON(24)) { PHASE_CTX for (int row = C.gw; row < TL; row += C.ngw) {
                const int set = row >> 13; const float* gt = mods_l + set * 6144 + 5 * 1024;
                const float wa = route_w[2 * row], wb = route_w[2 * row + 1]; const int sa = tokslot[2 * row], sb = tokslot[2 * row + 1];
                f32x4 v[4]; float s = 0.f;
#pragma unroll
                for (int j = 0; j < 4; ++j) {
                    const f32x4 x = *((const f32x4*)(xw + (size_t)row * D) + C.lane + 64 * j), gg = *((const f32x4*)gt + C.lane + 64 * j);
                    const u32x2 ya = *((const u32x2*)(yexp + (size_t)sa * D) + C.lane + 64 * j), yb = *((const u32x2*)(yexp + (size_t)sb * D) + C.lane + 64 * j);
                    f32x4 fa = (f32x4){bflo(ya.x), bfhi(ya.x), bflo(ya.y), bfhi(ya.y)}, fb = (f32x4){bflo(yb.x), bfhi(yb.x), bflo(yb.y), bfhi(yb.y)};
                    if (sa >= 32768) { const u32x2 y2 = *((const u32x2*)(yx2 + (size_t)(sa - 32768) * D) + C.lane + 64 * j); fa += (f32x4){bflo(y2.x), bfhi(y2.x), bflo(y2.y), bfhi(y2.y)}; }
                    if (sb >= 32768) { const u32x2 y2 = *((const u32x2*)(yx2 + (size_t)(sb - 32768) * D) + C.lane + 64 * j); fb += (f32x4){bflo(y2.x), bfhi(y2.x), bflo(y2.y), bfhi(y2.y)}; }
                    v[j] = x + gg * (fa * wa + fb * wb);
                    s += (v[j][0] * v[j][0] + v[j][1] * v[j][1]) + (v[j][2] * v[j][2] + v[j][3] * v[j][3]);
                }
                const float rstd = __builtin_amdgcn_rsqf(wave_sum(s, C.lane) * (1.0f / D) + EPS);
#pragma unroll
                for (int j = 0; j < 4; ++j) { const f32x4 gf = *((const f32x4*)prm.in[I_GFINAL] + C.lane + 64 * j); f32x4 o = v[j] * rstd * gf;
#if DBG
                    { const unsigned fl = *((volatile unsigned*)(ws + WS_CTL) + CW_DBG); if (fl) { const float big = exp2f(2.0f * (float)(100 - (int)fl)); o = (f32x4){big, big, big, big}; }
                      else {
#pragma unroll
                          for (int i = 0; i < 4; ++i) if (!(fabsf(o[i]) < 1e30f)) o[i] = 0.f; } }
#endif
                    *((f32x4*)(prm.out + (size_t)row * D) + C.lane + 64 * j) = o; }
            } }
        }

}
__global__ void __launch_bounds__(512, 2) mega_fwd(Params prm) {
    extern __shared__ __attribute__((aligned(16))) unsigned char lds_raw[];
    Ctx C;
    C.lds = (LAS unsigned char*)lds_raw;
    C.tid = threadIdx.x; C.lane = C.tid & 63; C.wave = __builtin_amdgcn_readfirstlane(C.tid >> 6);
    C.G = gridDim.x; C.bid = blockIdx.x; C.gw = C.bid * 8 + C.wave; C.ngw = C.G * 8;
    unsigned char* ws0 = prm.ws;
    for (int u = C.tid; u < (LDS_BYTES - LDSCTL_OFF) / 4; u += 512) ((LAS unsigned*)(C.lds + LDSCTL_OFF))[u] = 0u;
    __syncthreads();
    XcdBarrier bar = xcd_barrier_post((unsigned*)(ws0 + WS_CTL) + CW_BAR, (volatile LAS unsigned*)(C.lds + MISC_OFF) + 8);
    if (PHON(0)) { PHASE_CTX
        const int gtid = C.bid * 512 + C.tid, gthreads = C.G * 512;
        LAS float* wscr = (LAS float*)(C.lds + C.wave * 8448);
        for (int item = C.bid; item < 192; item += C.G) {
            const int layer = item / 96, c0 = (item % 96) * 64;
            const float* wm = prm.in[I_WMOD] + (size_t)layer * D * 6144 + c0 + C.lane;
            float a0 = 0.f, a1 = 0.f, a2 = 0.f;
#pragma unroll 1
            for (int kh = 0; kh < 2; ++kh) {
                const int k0 = C.wave * 128 + kh * 64;
                float s0 = prm.in[I_C][k0 + C.lane], s1 = prm.in[I_C][D + k0 + C.lane], s2 = prm.in[I_CCTX][k0 + C.lane];
                s0 = s0 * sigmoidf_fast(s0); s1 = s1 * sigmoidf_fast(s1); s2 = s2 * sigmoidf_fast(s2);
                float wv[64];
#pragma unroll
                for (int j = 0; j < 64; ++j) wv[j] = wm[(size_t)(k0 + j) * 6144];
#pragma unroll
                for (int j = 0; j < 64; ++j) {
                    a0 += __int_as_float(__builtin_amdgcn_readlane(__float_as_int(s0), j)) * wv[j];
                    a1 += __int_as_float(__builtin_amdgcn_readlane(__float_as_int(s1), j)) * wv[j];
                    a2 += __int_as_float(__builtin_amdgcn_readlane(__float_as_int(s2), j)) * wv[j];
                }
            }
            LAS float* red = (LAS float*)(C.lds + 80000);
            __syncthreads();
            red[(C.wave * 3 + 0) * 64 + C.lane] = a0; red[(C.wave * 3 + 1) * 64 + C.lane] = a1; red[(C.wave * 3 + 2) * 64 + C.lane] = a2;
            __syncthreads();
            if (C.tid < 192) { const int set = C.tid >> 6, l = C.tid & 63; float s = 0.f;
#pragma unroll
                for (int w = 0; w < 8; ++w) s += red[(w * 3 + set) * 64 + l];
                mods[(size_t)(layer * 3 + set) * 6144 + c0 + l] = s + prm.in[I_BMOD][layer * 6144 + c0 + l]; }
            __syncthreads();
        }
        for (int i = gtid; i < 128 * 8; i += gthreads) { const int pos = i >> 3, f = i & 7; const float inv = exp2f(-(float)f * (13.287712379549449f / 8.0f)); const float a = (float)pos * inv;
            ropet[2 * i] = cosf(a); ropet[2 * i + 1] = sinf(a); }
        for (int i = gtid; i < 128 * 64; i += gthreads) { const int k1 = i >> 6, l2 = i & 63; const float x = (float)((k1 * l2) & 8191) * (2.0f / 8192.0f); twt[2 * i] = cospif(x); twt[2 * i + 1] = sinpif(x); }
        for (int i = gtid; i < 256 * 128; i += gthreads) { const int n = i >> 7, l1 = i & 127, k1 = n >> 1; const float x = (float)((k1 * l1) & 127) * (2.0f / 128.0f); dft128[i] = f2bf((n & 1) ? -sinpif(x) : cospif(x)); }
        for (int i = gtid; i < 128 * 128; i += gthreads) { const int n = i >> 7, kk = i & 127, k2 = n >> 1, ro = n & 1, l2 = kk >> 1, ri = kk & 1; const float x = (float)((k2 * l2) & 63) * (2.0f / 64.0f);
            const float c = cospif(x), s = sinpif(x); m64[i] = f2bf(ro == ri ? c : (ro == 0 ? s : -s)); }
        for (int i = gtid; i < 512 * 256; i += gthreads) { const int n = i >> 8, l = i & 255, k = n >> 1; const float x = (float)((k * l) & 255) * (2.0f / 256.0f); dft256[i] = f2bf((n & 1) ? -sinpif(x) : cospif(x)); }
        {
            constexpr int IL_IN = 16 * 149, IL_UQ = 6 * 24, IL_UKV = 4 * 32, IL_OA = 8 * 32, IL_OUT = 16 * 32, IL = IL_IN + IL_UQ + IL_UKV + IL_OA + IL_OUT;
            constexpr int IF1 = 16 * 88, IF2 = 44 * 32, NIT = 2 * IL + 2 * IF1 + IF2;
            for (int it = C.gw; it < NIT; it += C.ngw) {
                int r = it;
                if (r < 2 * IL) {
                    const int layer = r / IL; r -= layer * IL;
                    bf16_t* lwp = (bf16_t*)(ws + WS_PERM + (size_t)layer * LW_SIZE);
                    if (r < IL_IN) { tr_item(prm.in[I_WIN] + (size_t)layer * D * IN_COLS, IN_COLS, 64 * (r / 149), 32 * (r % 149), nullptr, (bf16_t*)((char*)lwp + LW_IN), 1024, 64 * (r / 149), RowWin{}, wscr, C.lane); continue; } r -= IL_IN;
                    if (r < IL_UQ) { tr_item(prm.in[I_WUQ] + (size_t)layer * QL * 768, 768, 64 * (r / 24), 32 * (r % 24), prm.in[I_GQ] + layer * QL, (bf16_t*)((char*)lwp + LW_UQ), QL, 64 * (r / 24), RowQ{}, wscr, C.lane); continue; } r -= IL_UQ;
                    if (r < IL_UKV) { tr_item(prm.in[I_WUKV] + (size_t)layer * KVL * 1024, 1024, 64 * (r / 32), 32 * (r % 32), prm.in[I_GKV] + layer * KVL, (bf16_t*)((char*)lwp + LW_UKV), KVL, 64 * (r / 32), RowId{}, wscr, C.lane); continue; } r -= IL_UKV;
                    if (r < IL_OA) { tr_item(prm.in[I_WOA] + (size_t)layer * 512 * 1024, 1024, 64 * (r / 32), 32 * (r % 32), nullptr, (bf16_t*)((char*)lwp + LW_OA), 512, 64 * (r / 32), RowId{}, wscr, C.lane); continue; } r -= IL_OA;
                    tr_item(prm.in[I_WOUT] + (size_t)layer * D * D, 1024, 64 * (r / 32), 32 * (r % 32), nullptr, (bf16_t*)((char*)lwp + LW_OUT), 1024, 64 * (r / 32), RowId{}, wscr, C.lane); continue;
                }
                r -= 2 * IL;
                if (r < IF1) { tr_item(prm.in[I_FW1], DFF, 64 * (r / 88), 32 * (r % 88), nullptr, (bf16_t*)(ws + WS_FFN13), 1024, 64 * (r / 88), RowGU{0}, wscr, C.lane); continue; } r -= IF1;
                if (r < IF1) { tr_item(prm.in[I_FW3], DFF, 64 * (r / 88), 32 * (r % 88), nullptr, (bf16_t*)(ws + WS_FFN13), 1024, 64 * (r / 88), RowGU{16}, wscr, C.lane); continue; } r -= IF1;
                tr_item(prm.in[I_FW2], 1024, 64 * (r / 32), 32 * (r % 32), nullptr, (bf16_t*)(ws + WS_FFN2), DFF, 64 * (r / 32), RowId{}, wscr, C.lane);
            }
            for (int i = gtid; i < 2 * 96 * 128; i += gthreads) { const int layer = i / (96 * 128), r = i % (96 * 128);
                *(u32x4*)(ws + WS_PERM + (size_t)layer * LW_SIZE + LW_IN + (size_t)OFF_GATE * 2048 + (size_t)r * 16) = (u32x4){0u, 0u, 0u, 0u}; }
        }
        {
            LAS float* ctab = (LAS float*)(C.lds + 90000);
            __syncthreads();
            if (C.tid < 128) ctab[C.tid] = cospif((float)C.tid * (2.0f / 128.0f));
            __syncthreads();
            for (int un = C.bid; un < 64 + 128; un += C.G) {
                if (un < 64) {
                    const int layer = un >> 5, g = (un >> 3) & 3, dch = un & 7;
                    const float* wo = prm.in[I_WOB] + ((size_t)layer * 512 + g * 128) * 1024 + dch * 128;
                    const float* wp = prm.in[I_WPOOL] + (size_t)(layer * 4 + g) * 128 * 128; const float* sp = prm.in[I_SPOOL] + layer * 512 + g * 128;
                    bf16_t* dst = (bf16_t*)(ws + WS_PERM + (size_t)layer * LW_SIZE + LW_PB) + (size_t)dch * 128 * 512 + g * 128;
                    flex_tile(C, 128,
                        [&](int m, int k) { u32x4 o; float f[8];
#pragma unroll
                            for (int t = 0; t < 8; ++t) f[t] = wo[(size_t)(k + t) * 1024 + m];
                            o.x = cvt_pk_bf16(f[0], f[1]); o.y = cvt_pk_bf16(f[2], f[3]); o.z = cvt_pk_bf16(f[4], f[5]); o.w = cvt_pk_bf16(f[6], f[7]); return __builtin_bit_cast(bf16x8, o); },
                        [&](int n, int k) { const f32x4 a0 = *(const f32x4*)(wp + (size_t)n * 128 + k), a1 = *(const f32x4*)(wp + (size_t)n * 128 + k + 4), s0 = *(const f32x4*)(sp + k), s1 = *(const f32x4*)(sp + k + 4);
                            u32x4 o; o.x = cvt_pk_bf16(a0[0] * s0[0], a0[1] * s0[1]); o.y = cvt_pk_bf16(a0[2] * s0[2], a0[3] * s0[3]); o.z = cvt_pk_bf16(a1[0] * s1[0], a1[1] * s1[1]); o.w = cvt_pk_bf16(a1[2] * s1[2], a1[3] * s1[3]);
                            return __builtin_bit_cast(bf16x8, o); },
                        [&](int m, int n, float v0, float v1) { *(unsigned*)(dst + (size_t)m * 512 + n) = cvt_pk_bf16(v0, v1); });
                } else {
                    const int u2 = un - 64, layer = u2 >> 6, g = (u2 >> 4) & 3, dch = (u2 >> 1) & 7, nch = u2 & 1, sh = nch ? 96 : 0;
                    const float* wo = prm.in[I_WOC] + ((size_t)layer * 512 + g * 128) * 1024 + dch * 128;
                    bf16_t* dst = (bf16_t*)(ws + WS_PERM + (size_t)layer * LW_SIZE + LW_FC) + (size_t)dch * 128 * 1024 + g * 256 + nch * 128;
                    flex_tile(C, 128,
                        [&](int m, int k) { u32x4 o; float f[8];
#pragma unroll
                            for (int t = 0; t < 8; ++t) f[t] = wo[(size_t)(k + t) * 1024 + m];
                            o.x = cvt_pk_bf16(f[0], f[1]); o.y = cvt_pk_bf16(f[2], f[3]); o.z = cvt_pk_bf16(f[4], f[5]); o.w = cvt_pk_bf16(f[6], f[7]); return __builtin_bit_cast(bf16x8, o); },
                        [&](int n, int k) { float f[8];
#pragma unroll
                            for (int t = 0; t < 8; ++t) f[t] = ctab[((k + t) * n + sh) & 127];
                            u32x4 o; o.x = cvt_pk_bf16(f[0], f[1]); o.y = cvt_pk_bf16(f[2], f[3]); o.z = cvt_pk_bf16(f[4], f[5]); o.w = cvt_pk_bf16(f[6], f[7]); return __builtin_bit_cast(bf16x8, o); },
                        [&](int m, int n, float v0, float v1) { *(unsigned*)(dst + (size_t)m * 1024 + n) = cvt_pk_bf16(v0 * (1.0f / 1024.0f), v1 * (1.0f / 1024.0f)); });
                }
            }
        }
    }
    GRID_BAR();
    DBGSCAN(ws0 + WS_DFT128, WS_ROUTE_E - WS_DFT128, false, 1); DBGSCAN(ws0 + WS_ROPE, WS_DFT128 - WS_ROPE, true, 1); DBGSCAN(ws0 + WS_PERM, WS_ARENA - WS_PERM, false, 1); DBGSCAN(ws0 + WS_MODS, (size_t)2 * 3 * 6144 * 4, true, 1); DBGSCAN(ws0 + WS_XW, (size_t)T * D * 4, true, 1);
    if (PHON(1)) { PHASE_CTX norm_phase(C, prm.in[I_X], prm.in[I_CTX], prm.in[I_GN1], mods, 0, A1, T); }
    GRID_BAR();
    DBGSCAN(ws0 + WS_A1, (size_t)T * D * 2, false, 2);

    layer_body<0>(C, prm, ws0, bar);
    layer_body<1>(C, prm, ws0, bar);
#undef GRID_BAR
}

extern "C" void kernel_launch(void* const* d_in, const int* in_sizes, int n_in, void* d_out, int out_size, void* d_ws, size_t ws_size, hipStream_t stream) {
    static int grid = 0;
    if (grid == 0) {
        if (n_in != 29 || out_size != TL * D || ws_size < WS_NEED) { fprintf(stderr, "kernel_launch: unexpected shapes (n_in %d out %d ws %zu need %zu)\n", n_in, out_size, ws_size, (size_t)WS_NEED); grid = -1; return; }
        int dev = 0, cus = 0, per_cu = 0;
        if (hipGetDevice(&dev) != hipSuccess || hipDeviceGetAttribute(&cus, hipDeviceAttributeMultiprocessorCount, dev) != hipSuccess) { grid = -1; return; }
        if (hipFuncSetAttribute((const void*)mega_fwd, hipFuncAttributeMaxDynamicSharedMemorySize, LDS_BYTES) != hipSuccess) { fprintf(stderr, "kernel_launch: hipFuncSetAttribute failed\n"); grid = -1; return; }
        if (hipOccupancyMaxActiveBlocksPerMultiprocessor(&per_cu, (const void*)mega_fwd, 512, LDS_BYTES) != hipSuccess || per_cu < 1) { fprintf(stderr, "kernel_launch: occupancy query reports %d\n", per_cu); }
        (void)hipGetLastError();
        grid = cus;
        if (grid != 256) { fprintf(stderr, "kernel_launch: built for a 256-CU device (got %d)\n", cus); if (grid > 256) grid = 256; }
    }
    if (grid < 0) return;
    if (hipMemsetAsync((char*)d_ws + WS_CTL, 0, CTL_ZERO_BYTES, stream) != hipSuccess) return;
    Params p{};
    for (int i = 0; i < 29; ++i) p.in[i] = (const float*)d_in[i];
    p.out = (float*)d_out; p.ws = (unsigned char*)d_ws;
    hipLaunchKernelGGL(mega_fwd, dim3(grid), dim3(512), LDS_BYTES, stream, p);
}
```

```cpp
#include <hip/hip_runtime.h>
#include <cstdio>
#include <cstdint>

#define LAS __attribute__((address_space(3)))
#define GAS __attribute__((address_space(1)))
typedef unsigned short bf16_t;
typedef short bf16x8 __attribute__((ext_vector_type(8)));
typedef short s16x4 __attribute__((ext_vector_type(4)));
typedef float f32x2 __attribute__((ext_vector_type(2)));
typedef float f32x4 __attribute__((ext_vector_type(4)));
typedef float f32x16 __attribute__((ext_vector_type(16)));
typedef unsigned u32x2 __attribute__((ext_vector_type(2)));
typedef unsigned u32x4 __attribute__((ext_vector_type(4)));

constexpr int D = 1024, NB = 2, SEQ = 8192, NCTX = 256;
constexpr int TL = NB * SEQ;
constexpr int TC = NB * NCTX;
constexpr int T = TL + TC;
constexpr int NH = 8, QKD = 96, VD = 64, QL = 384, KVL = 256;
constexpr int NKEY = NCTX + SEQ;
constexpr int OFF_KV = 384, OFF_KR = 640, OFF_POOL = 672, OFF_FFT = 1184, OFF_GATE = 1696, IN_COLS = 4768, NIN = 4864;
constexpr int PP = 1792;
constexpr int DFF = 2816, NE = 8, DFH = 1408;
constexpr int MOE_ROWS = 34816;
constexpr float EPS = 1e-6f;
constexpr float QSCALE = 0.10206207261596577f * 1.4426950408889634f;

constexpr size_t MiB = 1u << 20;
constexpr size_t WS_CTL = 0, CTL_ZERO_BYTES = 64 * 1024;
constexpr size_t WS_MODS = 1 * MiB;
constexpr size_t WS_ROPE = WS_MODS + 2 * 3 * 6144 * 4;
constexpr size_t WS_TW = WS_ROPE + 128 * 8 * 2 * 4;
constexpr size_t WS_DFT128 = WS_TW + 128 * 64 * 2 * 4;
constexpr size_t WS_M64 = WS_DFT128 + 256 * 128 * 2;
constexpr size_t WS_DFT256 = WS_M64 + 128 * 128 * 2;
constexpr size_t WS_ROUTE_E = WS_DFT256 + 512 * 256 * 2;
constexpr size_t WS_ROUTE_W = WS_ROUTE_E + 16384 * 4;
constexpr size_t WS_TOKSLOT = WS_ROUTE_W + 16384 * 8;
constexpr size_t WS_BLKCNT = WS_TOKSLOT + 16384 * 8;
constexpr size_t WS_SSQ = 4 * MiB;
constexpr size_t WS_XW = 8 * MiB;
constexpr size_t WS_PERM = WS_XW + (size_t)T * D * 4;
constexpr size_t LW_IN = 0, LW_UQ = LW_IN + (size_t)NIN * 1024 * 2, LW_UKV = LW_UQ + 768 * 384 * 2, LW_OA = LW_UKV + 1024 * 256 * 2,
                 LW_PB = LW_OA + 1024 * 512 * 2, LW_FC = LW_PB + 1024 * 512 * 2, LW_OUT = LW_FC + 1024 * 1024 * 2, LW_SIZE = LW_OUT + 1024 * 1024 * 2;
constexpr size_t WS_FFN13 = WS_PERM + 2 * LW_SIZE;
constexpr size_t WS_FFN2 = WS_FFN13 + (size_t)5632 * 1024 * 2;
constexpr size_t WS_ARENA = WS_FFN2 + (size_t)1024 * 2816 * 2;
constexpr size_t WS_P = WS_ARENA;
constexpr size_t WS_G = WS_P + (size_t)T * PP * 2;
constexpr size_t WS_A1 = WS_P + (size_t)T * NIN * 2;
constexpr size_t WS_A2 = WS_A1 + (size_t)T * D * 2;
constexpr size_t WS_Q = WS_A2, WS_K = WS_Q + (size_t)T * 768 * 2, WS_VT = WS_K + (size_t)NB * NH * NKEY * QKD * 2;
constexpr size_t WS_A3 = WS_A2 + (size_t)T * D * 4;
constexpr size_t WS_AO = WS_A3, WS_MIX = WS_AO + (size_t)T * 512 * 2, WS_YY = WS_MIX + (size_t)T * 512 * 2;
constexpr size_t WS_MIXER_END = WS_YY + (size_t)T * 1024 * 2;
static_assert(WS_VT + (size_t)NB * NH * VD * NKEY * 2 <= WS_A3, "QKV fits A2");
constexpr size_t WS_U = WS_P;
static_assert((size_t)T * DFF * 2 <= (size_t)T * NIN * 2, "u fits p");
constexpr size_t WS_MW13 = WS_PERM;
constexpr size_t WS_MW2 = WS_MW13 + (size_t)NE * 5632 * 1024 * 2;
constexpr size_t WS_H2G = WS_MW2 + (size_t)NE * 1024 * DFF * 2;
constexpr size_t WS_UF = WS_H2G + (size_t)MOE_ROWS * 1024 * 2;
constexpr size_t WS_YX2 = WS_UF + (size_t)MOE_ROWS * DFF * 2;
constexpr size_t WS_YEXP = WS_H2G;
constexpr size_t WS_MOE_END = WS_YX2 + (size_t)2048 * 1024 * 2;
constexpr size_t WS_NEED = WS_MIXER_END > WS_MOE_END ? WS_MIXER_END : WS_MOE_END;
static_assert(WS_NEED <= 496000000ull, "workspace budget");
constexpr size_t WS_H2M = WS_UF;

constexpr int CW_BAR = 1024;

constexpr int RING_BYTES = 131072;
constexpr int LDSCTL_OFF = RING_BYTES;
constexpr int MISC_OFF = LDSCTL_OFF;
constexpr int TILE_E_OFF = LDSCTL_OFF + 256;
constexpr int SCR_OFF = LDSCTL_OFF + 1024;
constexpr int LDS_BYTES = 147456;

typedef __bf16 bf16x2_t __attribute__((ext_vector_type(2)));
__device__ __forceinline__ unsigned cvt_pk_bf16(float lo, float hi) { const f32x2 v = {lo, hi}; const bf16x2_t b = __builtin_convertvector(v, bf16x2_t); return __builtin_bit_cast(unsigned, b); }
__device__ __forceinline__ float bf2f(unsigned short v) { return __uint_as_float((unsigned)v << 16); }
__device__ __forceinline__ float bflo(unsigned v) { return __uint_as_float(v << 16); }
__device__ __forceinline__ float bfhi(unsigned v) { return __uint_as_float(v & 0xffff0000u); }
__device__ __forceinline__ bf16_t f2bf(float f) { return (bf16_t)(cvt_pk_bf16(f, 0.f) & 0xffffu); }
__device__ __forceinline__ float shx(float v, int o, int lane) { return __int_as_float(__builtin_amdgcn_ds_bpermute((lane ^ o) << 2, __float_as_int(v))); }
__device__ __forceinline__ float wave_sum(float v, int lane) {
#pragma unroll
    for (int o = 1; o < 64; o <<= 1) v += shx(v, o, lane);
    return v;
}
__device__ __forceinline__ float sigmoidf_fast(float x) { return __builtin_amdgcn_rcpf(1.0f + __builtin_amdgcn_exp2f(-1.4426950408889634f * x)); }
__device__ __forceinline__ int crow(int r, int hi) { return (r & 3) + 8 * (r >> 2) + 4 * hi; }
#define LDS_WAIT() asm volatile("s_waitcnt lgkmcnt(0)" ::: "memory")
#define VM_WAIT() asm volatile("s_waitcnt vmcnt(0)" ::: "memory")

#define XB_TMO      128
#define XB_XCNT(j)  (256  + 64 * (j))
#define XB_XSUB(j)  (1280 + 64 * (j))
#define XB_XGEN(j)  (2304 + 64 * (j))
#define XB_TOP      3328
#define XB_TOPGEN   3392
#define XCD_BAR_WORDS 3456
#define XB_SPIN_CAP (1u << 18)
__device__ __forceinline__ unsigned xb_ld(unsigned* p)              { return __hip_atomic_load(p, __ATOMIC_RELAXED, __HIP_MEMORY_SCOPE_AGENT); }
__device__ __forceinline__ unsigned xb_add(unsigned* p, unsigned v) { return __hip_atomic_fetch_add(p, v, __ATOMIC_RELAXED, __HIP_MEMORY_SCOPE_AGENT); }
__device__ __forceinline__ unsigned xb_xcc_id() { return (unsigned)__builtin_amdgcn_s_getreg((3 << 11) | 20) & 0xFu; }
#define XB_SPIN(cond, bar) do { unsigned _sp = 0; while (cond) { __builtin_amdgcn_s_sleep(1); \
    if ((++_sp & 255u) == 0u) { if (xb_ld(&(bar)[XB_TMO])) break; if (_sp > XB_SPIN_CAP) { atomicAdd(&(bar)[XB_TMO], 1u); break; } } } } while (0)
struct XcdBarrier { unsigned* bar; unsigned x; volatile LAS unsigned* st; };
__device__ __forceinline__ XcdBarrier xcd_barrier_post(unsigned* bar, volatile LAS unsigned* st) {
    XcdBarrier b; b.bar = bar; b.x = xb_xcc_id(); b.st = st;
    if (threadIdx.x == 0) (void)xb_add(&bar[XB_XCNT(b.x)], 1u);
    return b;
}
__device__ __forceinline__ void xcd_barrier_complete(unsigned* bar, unsigned x, unsigned& nloc, unsigned& nx) {
    const unsigned G = gridDim.x * gridDim.y * gridDim.z;
    unsigned sum, cnt, mine, sp = 0u;
    for (;;) {
        sum = 0u; cnt = 0u; mine = 0u;
#pragma unroll
        for (unsigned j = 0; j < 16; ++j) { const unsigned c = xb_ld(&bar[XB_XCNT(j)]); sum += c; cnt += (c > 0u) ? 1u : 0u; mine = (j == x) ? c : mine; }
        if (sum == G) break;
        __builtin_amdgcn_s_sleep(1);
        if ((++sp & 255u) == 0u) { if (xb_ld(&bar[XB_TMO])) break; if (sp > XB_SPIN_CAP) { atomicAdd(&bar[XB_TMO], 1u); break; } }
    }
    nloc = mine > 0u ? mine : 1u; nx = cnt > 0u ? cnt : 1u;
}
__device__ __forceinline__ void xcd_barrier(const XcdBarrier& b, int wave_id) {
    asm volatile("s_waitcnt vmcnt(0)" ::: "memory");
    __syncthreads();
    if (wave_id == 0 && __builtin_amdgcn_mbcnt_hi(~0u, __builtin_amdgcn_mbcnt_lo(~0u, 0u)) == 0u) {
        unsigned* bar = b.bar;
        __builtin_amdgcn_s_waitcnt(0);
        unsigned nloc = b.st[0], nx = b.st[1];
        if (nloc == 0u) { xcd_barrier_complete(bar, b.x, nloc, nx); b.st[0] = nloc; b.st[1] = nx; }
        const unsigned old = xb_add(&bar[XB_XSUB(b.x)], 1u);
        const unsigned gen = old / nloc;
        if (old + 1u == (gen + 1u) * nloc) {
            __builtin_amdgcn_fence(__ATOMIC_RELEASE, "agent");
            asm volatile("s_waitcnt vmcnt(0)" ::: "memory");
            const unsigned og = xb_add(&bar[XB_TOP], 1u);
            const unsigned tg = og / nx;
            if (og + 1u == (tg + 1u) * nx) xb_add(&bar[XB_TOPGEN], 1u);
            else XB_SPIN(xb_ld(&bar[XB_TOPGEN]) == tg, bar);
            __builtin_amdgcn_fence(__ATOMIC_ACQUIRE, "agent");
            xb_add(&bar[XB_XGEN(b.x)], 1u);
            asm volatile("s_waitcnt vmcnt(0)" ::: "memory");
        } else {
            XB_SPIN(xb_ld(&bar[XB_XGEN(b.x)]) == gen, bar);
            __builtin_amdgcn_fence(__ATOMIC_ACQUIRE, "agent");
            asm volatile("s_waitcnt vmcnt(0)" ::: "memory");
        }
    }
    __syncthreads();
}

namespace pg8 {
constexpr int BM = 256, BK = 64, HALF = 128, HTB = HALF * BK * 2, NXCD = 8, WGM = 4;
__host__ __device__ __forceinline__ int lds_byte(int r, int c) { const int st = (r >> 4) * 2 + (c >> 5), rr = r & 15, cc = c & 31, ob = rr * 64 + cc * 2; return st * 1024 + (ob ^ (((ob >> 9) & 1) << 5)); }
__host__ __device__ __forceinline__ void stage_rc(int b, int& R, int& C) { const int st = b / 1024, sb = b % 1024, swz = sb ^ (((sb >> 9) & 1) << 5); R = (st >> 1) * 16 + swz / 64; C = (st & 1) * 32 + (swz % 64) / 2; }
__host__ __device__ __forceinline__ int perm32(int rho) { const int n = rho >> 4, i = rho & 15; return 8 * (i >> 2) + 4 * n + (i & 3); }

struct Unit { int pm, pn, e, s = 0; };
struct Gemm { const bf16_t* A; const bf16_t* Bt; int lda, ldb, K; size_t bstride; size_t astride = 0; size_t astride2 = 0, bstride2 = 0; };

struct GridOrder {
    int nM, nN, nwg, G, c, xm0, xn0, xnm, nX; const LAS int* tile_e;
    __device__ __forceinline__ void init(int nM_, int nN_, int G_, int c_) { nM = nM_; nN = nN_; nwg = nM * nN; G = G_; c = c_; xm0 = xn0 = 0; xnm = 1; nX = 0; tile_e = nullptr; }
    __device__ __forceinline__ bool next(int i, Unit& u) const {
        long L = (long)i * G + c;
        if (L < nwg) {
            int wgid = (int)L; { const int q = nwg / NXCD, r = nwg % NXCD, xcd = wgid % NXCD, off = wgid / NXCD; wgid = (xcd < r ? xcd * (q + 1) : r * (q + 1) + (xcd - r) * q) + off; }
            const int nig = WGM * nN, gid = wgid / nig, fm = gid * WGM, gsz = (nM - fm) < WGM ? (nM - fm) : WGM;
            u.pm = fm + ((wgid % nig) % gsz); u.pn = (wgid % nig) / gsz; u.e = tile_e ? tile_e[u.pm] : 0; u.s = 0; return true;
        }
        L -= nwg; if (L >= nX) return false;
        u.pm = xm0 + (int)(L % xnm); u.pn = xn0 + (int)(L / xnm); u.e = 0; u.s = 0; return true;
    }
};

struct CtxSplitOrder {
    int nsl, G, c;
    __device__ __forceinline__ bool next(int i, Unit& u) const { const int L = i * G + c; if (L >= 8 * nsl) return false; u.e = L % nsl; u.s = 0; const int q = L / nsl; u.pn = q & 3; u.pm = 64 + (q >> 2); return true; }
};
struct MoeOvOrder {
    int nov, G, c; const LAS int* tile_e;
    __device__ __forceinline__ bool next(int i, Unit& u) const { const int L = i * G + c; if (L >= nov * 8) return false; u.s = L & 1; const int q = L >> 1; u.pn = q & 3; u.pm = 128 + (q >> 2); u.e = tile_e[u.pm]; return true; }
};
template <class Epi, class Sched, bool ALIGN_EPI>
__device__ __forceinline__ void gemm_phase(LAS unsigned char* lds, const Gemm g, const Sched& S, const Epi& E, int wave_id) {
    int wid_l = wave_id; asm volatile("" : "+s"(wid_l)); int lane_l = (int)__builtin_amdgcn_mbcnt_hi(~0u, __builtin_amdgcn_mbcnt_lo(~0u, 0u)); asm volatile("" : "+v"(lane_l));
    const int wid = wid_l, lane = lane_l, tid = wid * 64 + lane, wr = wid >> 2, wc = wid & 3, fr = lane & 15, fq = lane >> 4;
    const int K = g.K, nt = K / BK;
    unsigned voffA[2], voffB[2];
#pragma unroll
    for (int i = 0; i < 2; ++i) { int R, C; stage_rc(tid * 16 + i * 8192, R, C); const int Rb = Epi::PERM ? ((R & ~31) + perm32(R & 31)) : R;
        voffA[i] = (unsigned)(R * g.lda + C) * 2u; voffB[i] = (unsigned)(Rb * g.ldb + C) * 2u; }
    const size_t kstep = (size_t)(BK * 2);
    const size_t hstepA = (size_t)HALF * g.lda * 2, hstepB = (size_t)HALF * g.ldb * 2;
    const unsigned ldsw = (unsigned)wid * 1024u;
    const int aoff = lds_byte(wr * 64 + fr, fq * 8), boff = lds_byte(wc * 32 + fr, fq * 8);
#define PG8_SA(b, h) (((b) * 2 + (h)) * HTB)
#define PG8_SB(b, h) ((4 + (b) * 2 + (h)) * HTB)
#define PG8_STAGE(bufoff, gbase, voff) do { _Pragma("unroll") for (int _i = 0; _i < 2; ++_i) \
        __builtin_amdgcn_global_load_lds((const unsigned*)((const char*)(gbase) + (voff)[_i]), (LAS unsigned*)(lds + (bufoff) + ldsw + _i * 8192), 16, 0, 0); } while (0)
#define PG8_LDA(dst, b, h) do { _Pragma("unroll") for (int m = 0; m < 4; ++m) _Pragma("unroll") for (int k = 0; k < 2; ++k) dst[m][k] = *(const LAS bf16x8*)(lds + PG8_SA(b, h) + aoff + m * 2048 + k * 1024); } while (0)
#define PG8_LDB(dst, b, h) do { _Pragma("unroll") for (int n = 0; n < 2; ++n) _Pragma("unroll") for (int k = 0; k < 2; ++k) dst[n][k] = *(const LAS bf16x8*)(lds + PG8_SB(b, h) + boff + n * 2048 + k * 1024); } while (0)
#define PG8_MMA(ai, bj, At, Bt) do { __builtin_amdgcn_s_setprio(1); _Pragma("unroll") for (int m = 0; m < 4; ++m) _Pragma("unroll") for (int n = 0; n < 2; ++n) _Pragma("unroll") for (int k = 0; k < 2; ++k) \
        acc[ai][bj][m][n] = __builtin_amdgcn_mfma_f32_16x16x32_bf16(Bt[n][k], At[m][k], acc[ai][bj][m][n], 0, 0, 0); __builtin_amdgcn_s_setprio(0); } while (0)
#define PG8_WAIT_V(n) asm volatile("s_waitcnt vmcnt(" #n ")" ::: "memory")
#define PG8_WAIT_L(n) asm volatile("s_waitcnt lgkmcnt(" #n ")" ::: "memory")
#define PG8_BAR __builtin_amdgcn_s_barrier()
#define PG8_SCHED __builtin_amdgcn_sched_barrier(0)
    Unit cur, nxt; int ui = 0;
    if (!S.next(0, cur)) return;
    f32x4 acc[2][2][4][2];
#pragma unroll
    for (int a = 0; a < 2; ++a)
#pragma unroll
        for (int b = 0; b < 2; ++b)
#pragma unroll
            for (int m = 0; m < 4; ++m)
#pragma unroll
                for (int n = 0; n < 2; ++n) acc[a][b][m][n] = (f32x4){0.f, 0.f, 0.f, 0.f};
    bf16x8 At[4][2], B0[2][2], B1[2][2];
    const char* cA = (const char*)g.A + (size_t)cur.pm * 2 * hstepA + (size_t)cur.e * g.astride + (size_t)cur.s * g.astride2; const char* cB = (const char*)g.Bt + (size_t)cur.e * g.bstride + (size_t)cur.s * g.bstride2 + (size_t)cur.pn * 2 * hstepB;
    PG8_STAGE(PG8_SB(0, 0), cB, voffB); PG8_STAGE(PG8_SB(0, 1), cB + hstepB, voffB); PG8_STAGE(PG8_SA(0, 0), cA, voffA); PG8_STAGE(PG8_SA(0, 1), cA + hstepA, voffA);
    if (wr == 1) PG8_BAR;
    PG8_WAIT_V(2); PG8_BAR;
    PG8_STAGE(PG8_SB(1, 0), cB + kstep, voffB); PG8_STAGE(PG8_SA(1, 0), cA + kstep, voffA); PG8_STAGE(PG8_SB(1, 1), cB + hstepB + kstep, voffB);
    PG8_WAIT_V(6); PG8_BAR;
    for (;;) {
        const bool has_next = S.next(ui + 1, nxt);
        const char* nA = has_next ? (const char*)g.A + (size_t)nxt.pm * 2 * hstepA + (size_t)nxt.e * g.astride + (size_t)nxt.s * g.astride2 : cA;
        const char* nB = has_next ? (const char*)g.Bt + (size_t)nxt.e * g.bstride + (size_t)nxt.s * g.bstride2 + (size_t)nxt.pn * 2 * hstepB : cB;
        for (int t = 0; t < nt; t += 2) {
            const bool last = (t == nt - 2);
            const char* a1 = cA + (size_t)(t + 1) * kstep;
            const char* a2 = last ? nA : cA + (size_t)(t + 2) * kstep; const char* b2 = last ? nB : cB + (size_t)(t + 2) * kstep;
            const char* a3 = a2 + kstep; const char* b3 = b2 + kstep;
            PG8_LDB(B0, 0, 0); PG8_LDB(B1, 0, 1); PG8_SCHED; PG8_LDA(At, 0, 0); PG8_STAGE(PG8_SA(1, 1), a1 + hstepA, voffA);
            PG8_WAIT_V(8); PG8_WAIT_L(0); PG8_BAR; PG8_MMA(0, 0, At, B0); PG8_MMA(0, 1, At, B1); PG8_BAR; PG8_SCHED;
            PG8_LDA(At, 0, 1); PG8_STAGE(PG8_SB(0, 0), b2, voffB); PG8_STAGE(PG8_SB(0, 1), b2 + hstepB, voffB); PG8_STAGE(PG8_SA(0, 0), a2, voffA);
            PG8_WAIT_V(8); PG8_WAIT_L(0); PG8_BAR; PG8_MMA(1, 0, At, B0); PG8_MMA(1, 1, At, B1); PG8_BAR; PG8_SCHED;
            PG8_LDB(B0, 1, 0); PG8_LDB(B1, 1, 1); PG8_SCHED; PG8_LDA(At, 1, 0); PG8_STAGE(PG8_SA(0, 1), a2 + hstepA, voffA);
            PG8_WAIT_V(8); PG8_WAIT_L(0); PG8_BAR; PG8_MMA(0, 0, At, B0); PG8_MMA(0, 1, At, B1); PG8_BAR; PG8_SCHED;
            PG8_LDA(At, 1, 1); PG8_STAGE(PG8_SB(1, 0), b3, voffB); PG8_STAGE(PG8_SB(1, 1), b3 + hstepB, voffB); PG8_STAGE(PG8_SA(1, 0), a3, voffA);
            PG8_WAIT_V(8); PG8_WAIT_L(0); PG8_BAR; PG8_MMA(1, 0, At, B0); PG8_MMA(1, 1, At, B1); PG8_BAR; PG8_SCHED;
        }
        if constexpr (ALIGN_EPI) { if (wr == 0) PG8_BAR; }
        E(acc, cur, wr, wc, fr, fq);
        if (!has_next) break;
#pragma unroll
        for (int a = 0; a < 2; ++a)
#pragma unroll
            for (int b = 0; b < 2; ++b)
#pragma unroll
                for (int m = 0; m < 4; ++m)
#pragma unroll
                    for (int n = 0; n < 2; ++n) acc[a][b][m][n] = (f32x4){0.f, 0.f, 0.f, 0.f};
        cur = nxt; cA = nA; cB = nB; ++ui;
        if constexpr (ALIGN_EPI) { if (wr == 1) PG8_BAR; }
    }
    PG8_WAIT_V(0);
    if constexpr (!ALIGN_EPI) { if (wr == 0) PG8_BAR; }
    PG8_BAR;
#undef PG8_SA
#undef PG8_SB
#undef PG8_STAGE
#undef PG8_LDA
#undef PG8_LDB
#undef PG8_MMA
#undef PG8_WAIT_V
#undef PG8_WAIT_L
#undef PG8_BAR
#undef PG8_SCHED
}
typedef f32x4 Acc[2][2][4][2];

struct EpiWin {
    static constexpr bool PERM = true;
    bf16_t* P; bf16_t* G; const float* bgate; float* ssq;
    __device__ __forceinline__ void operator()(const Acc& acc, const Unit& u, int wr, int wc, int fr, int fq) const {
        asm volatile("" : "+v"(fr), "+v"(fq));
        const int row0 = u.pm * BM + wr * 64 + fr;
        if (u.pn < 7) {
#pragma unroll
            for (int bj = 0; bj < 2; ++bj) {
                const int colb = u.pn * BM + bj * HALF + wc * 32, col0 = colb + 8 * fq;
#pragma unroll
                for (int ai = 0; ai < 2; ++ai)
#pragma unroll
                    for (int m = 0; m < 4; ++m) {
                        const int row = row0 + ai * HALF + m * 16;
                        const f32x4 v0 = acc[ai][bj][m][0], v1 = acc[ai][bj][m][1];
                        if (colb < OFF_KR) {
                            float s = (v0[0] * v0[0] + v0[1] * v0[1]) + (v0[2] * v0[2] + v0[3] * v0[3]) + (v1[0] * v1[0] + v1[1] * v1[1]) + (v1[2] * v1[2] + v1[3] * v1[3]);
                            { const int ln = fr + 16 * fq; s += shx(s, 16, ln); s += shx(s, 32, ln); }
                            if (fq == 0) ssq[(size_t)row * 20 + (colb >> 5)] = s;
                        }
                        u32x4 w; w.x = cvt_pk_bf16(v0[0], v0[1]); w.y = cvt_pk_bf16(v0[2], v0[3]); w.z = cvt_pk_bf16(v1[0], v1[1]); w.w = cvt_pk_bf16(v1[2], v1[3]);
                        *(u32x4*)(P + (size_t)row * PP + col0) = w;
                    }
            }
        } else {
            const int g = u.pn - 7, lane = fr + 16 * fq, wid = wr * 4 + wc;
            bf16_t* gt = G + ((size_t)(u.pm * 12 + g) * 8192 + (size_t)wid * 1024 + lane) * 8;
#pragma unroll
            for (int bj = 0; bj < 2; ++bj) {
                const int bc = g * BM + bj * HALF + wc * 32 + 8 * fq;
                const f32x4 b0 = *(const f32x4*)(bgate + bc), b1 = *(const f32x4*)(bgate + bc + 4);
#pragma unroll
                for (int ai = 0; ai < 2; ++ai)
#pragma unroll
                    for (int m = 0; m < 4; ++m) {
                        f32x4 v0 = acc[ai][bj][m][0] + b0, v1 = acc[ai][bj][m][1] + b1;
#pragma unroll
                        for (int i = 0; i < 4; ++i) { v0[i] = sigmoidf_fast(v0[i]); v1[i] = sigmoidf_fast(v1[i]); }
                        u32x4 w; w.x = cvt_pk_bf16(v0[0], v0[1]); w.y = cvt_pk_bf16(v0[2], v0[3]); w.z = cvt_pk_bf16(v1[0], v1[1]); w.w = cvt_pk_bf16(v1[2], v1[3]);
                        *(u32x4*)(gt + (size_t)(((ai * 4 + m) * 2 + bj) * 64) * 8) = w;
                    }
            }
        }
    }
};
struct EpiPlain {
    static constexpr bool PERM = true;
    bf16_t* O; bf16_t* O2; int ldc;
    __device__ __forceinline__ void operator()(const Acc& acc, const Unit& u, int wr, int wc, int fr, int fq) const {
        asm volatile("" : "+v"(fr), "+v"(fq));
        bf16_t* base = O; int pm = u.pm; if (O2 && pm >= 64) { base = O2; pm -= 64; }
        const int row0 = pm * BM + wr * 64 + fr, col0 = u.pn * BM + wc * 32 + 8 * fq;
#pragma unroll
        for (int ai = 0; ai < 2; ++ai)
#pragma unroll
            for (int m = 0; m < 4; ++m) { bf16_t* rowp = base + (size_t)(row0 + ai * HALF + m * 16) * ldc + col0;
#pragma unroll
                for (int bj = 0; bj < 2; ++bj) { const f32x4 v0 = acc[ai][bj][m][0], v1 = acc[ai][bj][m][1];
                    u32x4 w; w.x = cvt_pk_bf16(v0[0], v0[1]); w.y = cvt_pk_bf16(v0[2], v0[3]); w.z = cvt_pk_bf16(v1[0], v1[1]); w.w = cvt_pk_bf16(v1[2], v1[3]);
                    *(u32x4*)(rowp + bj * HALF) = w; } }
    }
};
template <int PASS> struct EpiMerge {
    static constexpr bool PERM = true;
    const bf16_t* G; bf16_t* ytmp; bf16_t* y;
    __device__ __forceinline__ void operator()(const Acc& acc, const Unit& u, int wr, int wc, int fr, int fq) const {
        asm volatile("" : "+v"(fr), "+v"(fq));
        const int lane = fr + 16 * fq, wid = wr * 4 + wc;
        const bf16_t* gt = G + ((size_t)(u.pm * 12 + PASS * 4 + u.pn) * 8192 + (size_t)wid * 1024 + lane) * 8;
        bf16_t* yt = ytmp + ((size_t)(u.pm * 4 + u.pn) * 8192 + (size_t)wid * 1024 + lane) * 8;
        const int row0 = u.pm * BM + wr * 64 + fr, col0 = u.pn * BM + wc * 32 + 8 * fq;
#pragma unroll
        for (int ai = 0; ai < 2; ++ai)
#pragma unroll
            for (int m = 0; m < 4; ++m)
#pragma unroll
                for (int bj = 0; bj < 2; ++bj) {
                    const size_t eo = (size_t)(((ai * 4 + m) * 2 + bj) * 64) * 8;
                    const u32x4 gw = *(const u32x4*)(gt + eo);
                    f32x4 v0 = acc[ai][bj][m][0] * (f32x4){bflo(gw.x), bfhi(gw.x), bflo(gw.y), bfhi(gw.y)}, v1 = acc[ai][bj][m][1] * (f32x4){bflo(gw.z), bfhi(gw.z), bflo(gw.w), bfhi(gw.w)};
                    if (PASS > 0) { const u32x4 o = *(const u32x4*)(yt + eo); v0 += (f32x4){bflo(o.x), bfhi(o.x), bflo(o.y), bfhi(o.y)}; v1 += (f32x4){bflo(o.z), bfhi(o.z), bflo(o.w), bfhi(o.w)}; }
                    u32x4 w; w.x = cvt_pk_bf16(v0[0], v0[1]); w.y = cvt_pk_bf16(v0[2], v0[3]); w.z = cvt_pk_bf16(v1[0], v1[1]); w.w = cvt_pk_bf16(v1[2], v1[3]);
                    if (PASS < 2) *(u32x4*)(yt + eo) = w;
                    else *(u32x4*)(y + (size_t)(row0 + ai * HALF + m * 16) * D + col0 + bj * HALF) = w;
                }
    }
};
struct EpiResid {
    static constexpr bool PERM = true;
    float* X; const float* gates;
    const float* Xin_lat; const float* Xin_ctx;
    __device__ __forceinline__ void operator()(const Acc& acc, const Unit& u, int wr, int wc, int fr, int fq) const {
        asm volatile("" : "+v"(fr), "+v"(fq));
        const int row0 = u.pm * BM + wr * 64 + fr, col0 = u.pn * BM + wc * 32 + 8 * fq;
        const int set = u.pm < 64 ? (u.pm >> 5) : 2;
        const float* gp = gates + set * 6144;
        const float* xin = u.pm < 64 ? Xin_lat + (size_t)row0 * D + col0 : Xin_ctx + (size_t)(row0 - TL) * D + col0;
        f32x4 gv[2][2];
#pragma unroll
        for (int bj = 0; bj < 2; ++bj)
#pragma unroll
            for (int n = 0; n < 2; ++n) gv[bj][n] = *(const f32x4*)(gp + col0 + bj * HALF + n * 4);
#pragma unroll
        for (int ai = 0; ai < 2; ++ai)
#pragma unroll
            for (int m = 0; m < 4; ++m) {
                const size_t ro = (size_t)(ai * HALF + m * 16) * D;
                float* rowp = X + (size_t)row0 * D + col0 + ro;
#pragma unroll
                for (int bj = 0; bj < 2; ++bj)
#pragma unroll
                    for (int n = 0; n < 2; ++n) { *(f32x4*)(rowp + bj * HALF + n * 4) = *(const f32x4*)(xin + ro + bj * HALF + n * 4) + gv[bj][n] * acc[ai][bj][m][n]; }
            }
    }
};
struct EpiCtxPart {
    static constexpr bool PERM = true;
    float* part; const float* gates;
    __device__ __forceinline__ void operator()(const Acc& acc, const Unit& u, int wr, int wc, int fr, int fq) const {
        asm volatile("" : "+v"(fr), "+v"(fq));
        const int row0 = (u.pm - 64) * BM + wr * 64 + fr, col0 = u.pn * BM + wc * 32 + 8 * fq;
        float* pb = part + (size_t)u.e * TC * D;
#pragma unroll
        for (int ai = 0; ai < 2; ++ai)
#pragma unroll
            for (int m = 0; m < 4; ++m) {
                float* rowp = pb + (size_t)(row0 + ai * HALF + m * 16) * D + col0;
#pragma unroll
                for (int bj = 0; bj < 2; ++bj)
#pragma unroll
                    for (int n = 0; n < 2; ++n) *(f32x4*)(rowp + bj * HALF + n * 4) = *(const f32x4*)(gates + col0 + bj * HALF + n * 4) * acc[ai][bj][m][n];
            }
    }
};
struct EpiSwiglu {
    static constexpr bool PERM = false;
    bf16_t* U; int ldu;
    __device__ __forceinline__ void operator()(const Acc& acc, const Unit& u, int wr, int wc, int fr, int fq) const {
        asm volatile("" : "+v"(fr), "+v"(fq));
        const int row0 = u.pm * BM + wr * 64 + fr;
#pragma unroll
        for (int ai = 0; ai < 2; ++ai)
#pragma unroll
            for (int m = 0; m < 4; ++m) {
                bf16_t* rowp = U + (size_t)(row0 + ai * HALF + m * 16) * ldu;
#pragma unroll
                for (int bj = 0; bj < 2; ++bj) {
                    const int gcol = u.pn * BM + bj * HALF + wc * 32;
                    const f32x4 a = acc[ai][bj][m][0], b = acc[ai][bj][m][1];
                    f32x4 o;
#pragma unroll
                    for (int i = 0; i < 4; ++i) o[i] = a[i] * sigmoidf_fast(a[i]) * b[i];
                    u32x2 w; w.x = cvt_pk_bf16(o[0], o[1]); w.y = cvt_pk_bf16(o[2], o[3]);
                    *(u32x2*)(rowp + (gcol >> 1) + 4 * fq) = w;
                }
            }
    }
};
struct EpiMoeDown {
    static constexpr bool PERM = true;
    bf16_t* Y; bf16_t* Y2;
    __device__ __forceinline__ void operator()(const Acc& acc, const Unit& u, int wr, int wc, int fr, int fq) const {
        asm volatile("" : "+v"(fr), "+v"(fq));
        bf16_t* base = u.s ? Y2 + (size_t)(u.pm - 128) * BM * D : Y + (size_t)u.pm * BM * D;
        const int row0 = wr * 64 + fr, col0 = u.pn * BM + wc * 32 + 8 * fq;
#pragma unroll
        for (int ai = 0; ai < 2; ++ai)
#pragma unroll
            for (int m = 0; m < 4; ++m) {
                bf16_t* rowp = base + (size_t)(row0 + ai * HALF + m * 16) * D + col0;
#pragma unroll
                for (int bj = 0; bj < 2; ++bj) { const f32x4 v0 = acc[ai][bj][m][0], v1 = acc[ai][bj][m][1];
                    u32x4 w; w.x = cvt_pk_bf16(v0[0], v0[1]); w.y = cvt_pk_bf16(v0[2], v0[3]); w.z = cvt_pk_bf16(v1[0], v1[1]); w.w = cvt_pk_bf16(v1[2], v1[3]);
                    *(u32x4*)(rowp + bj * HALF) = w; }
            }
    }
};
}

struct Params { const float* in[29]; float* out; unsigned char* ws; };
enum { I_X = 0, I_C, I_CTX, I_CCTX, I_WMOD, I_BMOD, I_GN1, I_WIN, I_BGATE, I_GQ, I_WUQ, I_GKV, I_WUKV, I_WPOOL, I_SPOOL, I_WOA, I_WOB, I_WOC, I_WOUT, I_GN2,
       I_FW1, I_FW3, I_FW2, I_ROUTER, I_RBIAS, I_MW1, I_MW3, I_MW2, I_GFINAL };

struct Ctx {
    LAS unsigned char* lds; int tid, lane, wave, G, bid, gw, ngw;
};

__device__ __forceinline__ Ctx fresh(const Ctx& C0) {
    Ctx C = C0; int w = C0.wave; asm volatile("" : "+s"(w)); int l = (int)__builtin_amdgcn_mbcnt_hi(~0u, __builtin_amdgcn_mbcnt_lo(~0u, 0u)); asm volatile("" : "+v"(l));
    C.wave = w; C.lane = l; C.tid = w * 64 + l; C.gw = C.bid * 8 + w; return C;
}
template <class RowMap>
__device__ __forceinline__ void tr_item(const float* src, int ldn, int k0, int n0, const float* kscale, bf16_t* dst, int dld, int dk0, RowMap rowmap, LAS float* scr, int lane) {
    float v[32];
#pragma unroll
    for (int i = 0; i < 32; ++i) { const int kk = 2 * i + (lane >> 5); v[i] = src[(size_t)(k0 + kk) * ldn + n0 + (lane & 31)]; }
    if (kscale) {
#pragma unroll
        for (int i = 0; i < 32; ++i) v[i] *= kscale[k0 + 2 * i + (lane >> 5)];
    }
#pragma unroll
    for (int i = 0; i < 32; ++i) scr[(2 * i + (lane >> 5)) * 33 + (lane & 31)] = v[i];
    LDS_WAIT(); asm volatile("" ::: "memory");
    const int c = lane & 7;
#pragma unroll
    for (int j = 0; j < 4; ++j) { const int n = (lane >> 3) + 8 * j; const LAS float* s = scr + (8 * c) * 33 + n;
        u32x4 o; o.x = cvt_pk_bf16(s[0 * 33], s[1 * 33]); o.y = cvt_pk_bf16(s[2 * 33], s[3 * 33]); o.z = cvt_pk_bf16(s[4 * 33], s[5 * 33]); o.w = cvt_pk_bf16(s[6 * 33], s[7 * 33]);
        *(u32x4*)(dst + (size_t)rowmap(n0 + n) * dld + dk0 + 8 * c) = o; }
    LDS_WAIT(); asm volatile("" ::: "memory");
}
struct RowId { __device__ __forceinline__ int operator()(int n) const { return n; } };
struct RowWin { __device__ __forceinline__ int operator()(int n) const { return n < OFF_GATE ? n : n + (PP - OFF_GATE); } };
struct RowQ { __device__ __forceinline__ int operator()(int n) const { const int h = n / QKD, d = n % QKD; if (d < 64) return n; const int j = d - 64, a = j >> 4, rh = (j >> 3) & 1, f = j & 7; return h * QKD + 64 + rh * 16 + a * 8 + f; } };
struct RowGU { int add; __device__ __forceinline__ int operator()(int n) const { return 32 * (n >> 4) + (n & 15) + add; } };

__device__ __forceinline__ void norm_row(const float* xrow, const float* g, const float* sh, const float* sc, bf16_t* drow, int lane, f32x4 (&v)[4]) {
    const f32x4* xr = (const f32x4*)xrow + lane;
    float s = 0.f;
#pragma unroll
    for (int j = 0; j < 4; ++j) { v[j] = xr[64 * j]; s += (v[j][0] * v[j][0] + v[j][1] * v[j][1]) + (v[j][2] * v[j][2] + v[j][3] * v[j][3]); }
    const float rstd = __builtin_amdgcn_rsqf(wave_sum(s, lane) * (1.0f / D) + EPS);
#pragma unroll
    for (int j = 0; j < 4; ++j) {
        const f32x4 gg = *((const f32x4*)g + lane + 64 * j), s1 = *((const f32x4*)sc + lane + 64 * j), s0 = *((const f32x4*)sh + lane + 64 * j);
        v[j] = v[j] * rstd * gg * (s1 + 1.0f) + s0;
        u32x2 w; w.x = cvt_pk_bf16(v[j][0], v[j][1]); w.y = cvt_pk_bf16(v[j][2], v[j][3]);
        *((u32x2*)drow + lane + 64 * j) = w;
    }
}
__device__ __forceinline__ void norm_rows(const float* xrow0, int nr, const float* gn, const float* mp, bf16_t* drow0, int lane) {
    f32x4 gsc[4], shv[4], xn[4];
#pragma unroll
    for (int j = 0; j < 4; ++j) { const f32x4 gg = *((const f32x4*)gn + lane + 64 * j), s1 = *((const f32x4*)(mp + 1024) + lane + 64 * j); gsc[j] = gg * (s1 + 1.0f); shv[j] = *((const f32x4*)mp + lane + 64 * j);
        xn[j] = *((const f32x4*)xrow0 + lane + 64 * j); }
#pragma unroll 1
    for (int rr = 0; rr < nr; ++rr) {
        f32x4 v[4];
#pragma unroll
        for (int j = 0; j < 4; ++j) v[j] = xn[j];
        if (rr + 1 < nr) {
#pragma unroll
            for (int j = 0; j < 4; ++j) xn[j] = *((const f32x4*)(xrow0 + (size_t)(rr + 1) * D) + lane + 64 * j);
        }
        float ssx = 0.f;
#pragma unroll
        for (int j = 0; j < 4; ++j) ssx += (v[j][0] * v[j][0] + v[j][1] * v[j][1]) + (v[j][2] * v[j][2] + v[j][3] * v[j][3]);
        const float rstd = __builtin_amdgcn_rsqf(wave_sum(ssx, lane) * (1.0f / D) + EPS);
#pragma unroll
        for (int j = 0; j < 4; ++j) { const f32x4 o = v[j] * rstd * gsc[j] + shv[j]; u32x2 w; w.x = cvt_pk_bf16(o[0], o[1]); w.y = cvt_pk_bf16(o[2], o[3]); *((u32x2*)(drow0 + (size_t)rr * D) + lane + 64 * j) = w; }
    }
}
__device__ __forceinline__ void norm_ctx_row(const float* xsrc, const float* part, int nsl, float* xdst, const float* gn, const float* mp, bf16_t* drow, int lane) {
    f32x4 v[4];
#pragma unroll
    for (int j = 0; j < 4; ++j) v[j] = *((const f32x4*)xsrc + lane + 64 * j);
    for (int s = 0; s < nsl; ++s) {
#pragma unroll
        for (int j = 0; j < 4; ++j) v[j] += *((const f32x4*)(part + (size_t)s * TC * D) + lane + 64 * j);
    }
    float ssx = 0.f;
#pragma unroll
    for (int j = 0; j < 4; ++j) { if (xdst) *((f32x4*)xdst + lane + 64 * j) = v[j]; ssx += (v[j][0] * v[j][0] + v[j][1] * v[j][1]) + (v[j][2] * v[j][2] + v[j][3] * v[j][3]); }
    const float rstd = __builtin_amdgcn_rsqf(wave_sum(ssx, lane) * (1.0f / D) + EPS);
#pragma unroll
    for (int j = 0; j < 4; ++j) { const f32x4 gg = *((const f32x4*)gn + lane + 64 * j), s1 = *((const f32x4*)(mp + 1024) + lane + 64 * j), s0 = *((const f32x4*)mp + lane + 64 * j);
        const f32x4 o = v[j] * rstd * gg * (s1 + 1.0f) + s0; u32x2 w; w.x = cvt_pk_bf16(o[0], o[1]); w.y = cvt_pk_bf16(o[2], o[3]); *((u32x2*)drow + lane + 64 * j) = w; }
}
__device__ __forceinline__ void norm_phase(const Ctx& C, const float* xlat, const float* xctx, const float* gn, const float* mods_l, int which, bf16_t* dst, int nrows, const float* part = nullptr, int nsl = 0, float* xdst = nullptr) {
    for (int ch = C.gw; ch < TL / 8; ch += C.ngw) { const int row = ch * 8; norm_rows(xlat + (size_t)row * D, 8, gn, mods_l + (row >> 13) * 6144 + which * 3072, dst + (size_t)row * D, C.lane); }
    if (nrows > TL) for (int r = C.gw; r < TC; r += C.ngw) {
        if (nsl > 0) norm_ctx_row(xctx + (size_t)r * D, part + (size_t)r * D, nsl, xdst ? xdst + (size_t)r * D : nullptr, gn, mods_l + 2 * 6144 + which * 3072, dst + (size_t)(TL + r) * D, C.lane);
        else norm_rows(xctx + (size_t)r * D, 1, gn, mods_l + 2 * 6144 + which * 3072, dst + (size_t)(TL + r) * D, C.lane);
    }
}

constexpr int FX_LD = 272;
template <class AL, class BL, class EP>
__device__ __forceinline__ void flex_tile(const Ctx& C, int KC, AL aload, BL bload, EP epi) {
    LAS unsigned char* As = C.lds; LAS unsigned char* Bs = C.lds + 128 * FX_LD;
    const int wm = C.wave >> 1, wn = C.wave & 1, r32 = C.lane & 31, hi = C.lane >> 5;
    f32x16 acc[2];
#pragma unroll
    for (int j = 0; j < 2; ++j)
#pragma unroll
        for (int r = 0; r < 16; ++r) acc[j][r] = 0.f;
    for (int kc = 0; kc < KC; kc += 128) {
        __syncthreads();
#pragma unroll
        for (int i = 0; i < 4; ++i) { const int task = C.tid + 512 * i, m = task & 127, c8 = task >> 7;
            const bf16x8 va = aload(m, kc + c8 * 8); *(LAS bf16x8*)(As + m * FX_LD + c8 * 16) = va;
            const bf16x8 vb = bload(m, kc + c8 * 8); *(LAS bf16x8*)(Bs + m * FX_LD + c8 * 16) = vb; }
        __syncthreads();
#pragma unroll
        for (int s = 0; s < 8; ++s) {
            const bf16x8 a = *(const LAS bf16x8*)(As + (32 * wm + r32) * FX_LD + (2 * s + hi) * 16);
#pragma unroll
            for (int j = 0; j < 2; ++j) { const bf16x8 b = *(const LAS bf16x8*)(Bs + (64 * wn + 32 * j + r32) * FX_LD + (2 * s + hi) * 16);
                acc[j] = __builtin_amdgcn_mfma_f32_32x32x16_bf16(b, a, acc[j], 0, 0, 0); }
        }
    }
    const int m = 32 * wm + r32;
#pragma unroll
    for (int j = 0; j < 2; ++j)
#pragma unroll
        for (int r = 0; r < 16; r += 2) epi(m, 64 * wn + 32 * j + crow(r, hi), acc[j][r], acc[j][r + 1]);
}
template <class AL, class BL, class EP>
__device__ __forceinline__ void flex_tile_n256(const Ctx& C, AL aload, BL bload, EP epi) {
    LAS unsigned char* As = C.lds; LAS unsigned char* Bs = C.lds + 128 * FX_LD;
    const int wm = C.wave >> 1, wn = C.wave & 1, r32 = C.lane & 31, hi = C.lane >> 5;
    f32x16 acc[4];
#pragma unroll
    for (int j = 0; j < 4; ++j)
#pragma unroll
        for (int r = 0; r < 16; ++r) acc[j][r] = 0.f;
    __syncthreads();
#pragma unroll
    for (int i = 0; i < 4; ++i) { const int task = C.tid + 512 * i, m = task & 127, c8 = task >> 7;
        const bf16x8 va = aload(m, c8 * 8); *(LAS bf16x8*)(As + m * FX_LD + c8 * 16) = va; }
#pragma unroll
    for (int i = 0; i < 8; ++i) { const int task = C.tid + 512 * i, n = task & 255, c8 = task >> 8;
        const bf16x8 vb = bload(n, c8 * 8); *(LAS bf16x8*)(Bs + n * FX_LD + c8 * 16) = vb; }
    __syncthreads();
#pragma unroll
    for (int s = 0; s < 8; ++s) {
        const bf16x8 a = *(const LAS bf16x8*)(As + (32 * wm + r32) * FX_LD + (2 * s + hi) * 16);
#pragma unroll
        for (int j = 0; j < 4; ++j) { const bf16x8 b = *(const LAS bf16x8*)(Bs + (128 * wn + 32 * j + r32) * FX_LD + (2 * s + hi) * 16);
            acc[j] = __builtin_amdgcn_mfma_f32_32x32x16_bf16(b, a, acc[j], 0, 0, 0); }
    }
    const int m = 32 * wm + r32;
#pragma unroll
    for (int j = 0; j < 4; ++j)
#pragma unroll
        for (int r = 0; r < 16; r += 2) epi(m, 128 * wn + 32 * j + crow(r, hi), acc[j][r], acc[j][r + 1]);
}
__device__ __forceinline__ bf16x8 gather8(const bf16_t* p, size_t ld) {
    bf16x8 v;
#pragma unroll
    for (int t = 0; t < 8; ++t) v[t] = (short)p[(size_t)t * ld];
    return v;
}

struct TT { static constexpr bool value = true; }; struct FF { static constexpr bool value = false; };
constexpr int AT_KT = 128;
constexpr int AT_KLD = 208, AT_VLD = 264, AT_KB = AT_KT * AT_KLD, AT_VB = 64 * AT_VLD, AT_VOFF = 2 * AT_KB;
__device__ __forceinline__ void attn_unit(const Ctx& C, const bf16_t* Q, const bf16_t* Kb, const bf16_t* Vt, bf16_t* O, const float* ssqp, const float* ropep, int b, int h, int qrow0, int NT) {
    const int tid = C.tid, lane = C.lane, wid = C.wave, r32 = lane & 31, hi = lane >> 5;
    LAS unsigned char* L = C.lds;
    const bf16_t* Kh = Kb + (size_t)(b * NH + h) * NKEY * QKD;
    const bf16_t* Vh = Vt + (size_t)(b * NH + h) * VD * NKEY;
    const int qrow = qrow0 + wid * 32 + r32;
    bf16x8 qr[6];
    { const bf16_t* qp = Q + (size_t)qrow * 768 + h * QKD + hi * 8;
      u32x4 raw[6];
#pragma unroll
      for (int s = 0; s < 6; ++s) raw[s] = *(const u32x4*)(qp + 16 * s);
      float rq;
      { const float* sp = ssqp + (size_t)qrow * 20; const f32x4 a = *(const f32x4*)sp, b2 = *(const f32x4*)(sp + 4), c = *(const f32x4*)(sp + 8);
        rq = __builtin_amdgcn_rsqf((((a[0] + a[1]) + (a[2] + a[3])) + ((b2[0] + b2[1]) + (b2[2] + b2[3])) + ((c[0] + c[1]) + (c[2] + c[3]))) * (1.0f / QL) + EPS) * QSCALE; }
#pragma unroll
      for (int s = 0; s < 4; ++s) { u32x4 o; const unsigned wv[4] = {raw[s].x, raw[s].y, raw[s].z, raw[s].w}; unsigned ov[4];
#pragma unroll
          for (int q = 0; q < 4; ++q) ov[q] = cvt_pk_bf16(bflo(wv[q]) * rq, bfhi(wv[q]) * rq);
          o.x = ov[0]; o.y = ov[1]; o.z = ov[2]; o.w = ov[3]; qr[s] = __builtin_bit_cast(bf16x8, o); }
      float cs[8], sn[8];
      if (qrow < TL) { const int l = qrow & (SEQ - 1), pos = hi ? (l & 63) : (l >> 6); const float* rp = ropep + pos * 16;
#pragma unroll
          for (int q = 0; q < 4; ++q) { const f32x4 t = *(const f32x4*)(rp + 4 * q); cs[2 * q] = t[0]; sn[2 * q] = t[1]; cs[2 * q + 1] = t[2]; sn[2 * q + 1] = t[3]; } }
      else {
#pragma unroll
          for (int j = 0; j < 8; ++j) { cs[j] = 1.f; sn[j] = 0.f; } }
      const unsigned w1[4] = {raw[4].x, raw[4].y, raw[4].z, raw[4].w}, w2[4] = {raw[5].x, raw[5].y, raw[5].z, raw[5].w}; unsigned o1[4], o2[4];
#pragma unroll
      for (int q = 0; q < 4; ++q) { const float a0 = bflo(w1[q]), a1 = bfhi(w1[q]), b0 = bflo(w2[q]), b1 = bfhi(w2[q]);
          o1[q] = cvt_pk_bf16((a0 * cs[2 * q] - b0 * sn[2 * q]) * rq, (a1 * cs[2 * q + 1] - b1 * sn[2 * q + 1]) * rq);
          o2[q] = cvt_pk_bf16((b0 * cs[2 * q] + a0 * sn[2 * q]) * rq, (b1 * cs[2 * q + 1] + a1 * sn[2 * q + 1]) * rq); }
      qr[4] = __builtin_bit_cast(bf16x8, ((u32x4){o1[0], o1[1], o1[2], o1[3]})); qr[5] = __builtin_bit_cast(bf16x8, ((u32x4){o2[0], o2[1], o2[2], o2[3]})); }
    int kdst[3], vdst[2]; const bf16_t* vsrc[2];
#pragma unroll
    for (int i = 0; i < 3; ++i) { const int id = tid + 512 * i; kdst[i] = (id / 12) * AT_KLD + (id % 12) * 16; }
#pragma unroll
    for (int i = 0; i < 2; ++i) { const int id = tid + 512 * i, d = id >> 4, ch = id & 15; vdst[i] = AT_VOFF + d * AT_VLD + ch * 16; vsrc[i] = Vh + (size_t)d * NKEY + ch * 8; }
    const bf16_t* ksrc = Kh + (size_t)tid * 8;
    u32x4 kr[3], vr[2];
#pragma unroll
    for (int i = 0; i < 3; ++i) kr[i] = *(const u32x4*)(ksrc + 4096 * i);
#pragma unroll
    for (int i = 0; i < 2; ++i) vr[i] = *(const u32x4*)vsrc[i];
    __syncthreads();
#pragma unroll
    for (int i = 0; i < 3; ++i) *(LAS u32x4*)(L + kdst[i]) = kr[i];
#pragma unroll
    for (int i = 0; i < 2; ++i) { *(LAS u32x2*)(L + vdst[i]) = (u32x2){vr[i].x, vr[i].y}; *(LAS u32x2*)(L + vdst[i] + 8) = (u32x2){vr[i].z, vr[i].w}; }
    __syncthreads();
    constexpr float ATHR = 8.0f;
    float mrun = 0.f, lsum = 0.f;
    f32x16 o0, o1, negm;
#pragma unroll
    for (int r = 0; r < 16; ++r) { o0[r] = 0.f; o1[r] = 0.f; negm[r] = 0.f; }
    auto tile = [&](const int t, auto first) {
        constexpr bool FIRST = decltype(first)::value;
        const int buf = t & 1;
        const bool more = (t + 1 < NT);
        if (more) {
#pragma unroll
            for (int i = 0; i < 3; ++i) kr[i] = *(const u32x4*)(ksrc + (size_t)(t + 1) * (AT_KT * QKD) + 4096 * i);
#pragma unroll
            for (int i = 0; i < 2; ++i) vr[i] = *(const u32x4*)(vsrc[i] + (size_t)(t + 1) * AT_KT);
        }
        const LAS unsigned char* Kt = L + buf * AT_KB; const LAS unsigned char* Vtile = L + AT_VOFF + buf * AT_VB;
        f32x16 p[4];
#pragma unroll
        for (int kb = 0; kb < 4; ++kb)
#pragma unroll
            for (int s = 0; s < 6; ++s) {
                const bf16x8 kf = *(const LAS bf16x8*)(Kt + (32 * kb + r32) * AT_KLD + (2 * s + hi) * 16);
                p[kb] = __builtin_amdgcn_mfma_f32_32x32x16_bf16(kf, qr[s], s == 0 ? negm : p[kb], 0, 0, 0);
            }
        if (more) {
            LAS unsigned char* Ln = L + (buf ^ 1) * AT_KB; LAS unsigned char* Vn = L + (buf ^ 1) * AT_VB;
#pragma unroll
            for (int i = 0; i < 3; ++i) *(LAS u32x4*)(Ln + kdst[i]) = kr[i];
#pragma unroll
            for (int i = 0; i < 2; ++i) { *(LAS u32x2*)(Vn + vdst[i]) = (u32x2){vr[i].x, vr[i].y}; *(LAS u32x2*)(Vn + vdst[i] + 8) = (u32x2){vr[i].z, vr[i].w}; }
        }
        float mx = fmaxf(fmaxf(p[0][0], p[0][1]), p[0][2]);
#pragma unroll
        for (int kb = 0; kb < 4; ++kb)
#pragma unroll
            for (int r = (kb == 0 ? 3 : 0); r + 1 < 16 + (kb == 0 ? 1 : 0); r += 2) { if (r + 1 < 16) mx = fmaxf(fmaxf(mx, p[kb][r]), p[kb][r + 1]); else mx = fmaxf(mx, p[kb][r]); }
        if constexpr (FIRST) {
            if (__any(mx < -64.0f)) {
                mx = fmaxf(mx, shx(mx, 32, lane)); const float dl = fminf(mx, 0.f); mrun = dl;
#pragma unroll
                for (int kb = 0; kb < 4; ++kb)
#pragma unroll
                    for (int r = 0; r < 16; ++r) p[kb][r] -= dl;
#pragma unroll
                for (int r = 0; r < 16; ++r) negm[r] = -dl;
                mx -= dl;
            }
        }
        if (__any(mx > ATHR)) {
            mx = fmaxf(mx, shx(mx, 32, lane));
            const float dl = fmaxf(mx, 0.f); mrun += dl;
            const float alpha = __builtin_amdgcn_exp2f(-dl);
            lsum *= alpha;
#pragma unroll
            for (int kb = 0; kb < 4; ++kb)
#pragma unroll
                for (int r = 0; r < 16; ++r) p[kb][r] -= dl;
#pragma unroll
            for (int r = 0; r < 16; ++r) { o0[r] *= alpha; o1[r] *= alpha; negm[r] = -mrun; }
        }
        bf16x8 pf[8];
        { f32x2 sa = (f32x2){0.f, 0.f};
#pragma unroll
          for (int kb = 0; kb < 4; ++kb) {
#pragma unroll
              for (int r = 0; r < 16; ++r) p[kb][r] = __builtin_amdgcn_exp2f(p[kb][r]);
#pragma unroll
              for (int r = 0; r < 16; r += 2) sa += (f32x2){p[kb][r], p[kb][r + 1]};
#pragma unroll
              for (int s2 = 0; s2 < 2; ++s2) { u32x4 w; w.x = cvt_pk_bf16(p[kb][8 * s2 + 0], p[kb][8 * s2 + 1]); w.y = cvt_pk_bf16(p[kb][8 * s2 + 2], p[kb][8 * s2 + 3]); w.z = cvt_pk_bf16(p[kb][8 * s2 + 4], p[kb][8 * s2 + 5]); w.w = cvt_pk_bf16(p[kb][8 * s2 + 6], p[kb][8 * s2 + 7]);
                  pf[2 * kb + s2] = __builtin_bit_cast(bf16x8, w); }
          }
          lsum += sa[0] + sa[1]; }
#pragma unroll
        for (int st = 0; st < 8; ++st) {
            const int ko = (16 * st + 4 * hi) * 2;
            { const s16x4 lo = *(const LAS s16x4*)(Vtile + r32 * AT_VLD + ko), h4 = *(const LAS s16x4*)(Vtile + r32 * AT_VLD + ko + 16);
              const bf16x8 vf = (bf16x8){lo[0], lo[1], lo[2], lo[3], h4[0], h4[1], h4[2], h4[3]};
              o0 = __builtin_amdgcn_mfma_f32_32x32x16_bf16(vf, pf[st], o0, 0, 0, 0); }
            { const s16x4 lo = *(const LAS s16x4*)(Vtile + (32 + r32) * AT_VLD + ko), h4 = *(const LAS s16x4*)(Vtile + (32 + r32) * AT_VLD + ko + 16);
              const bf16x8 vf = (bf16x8){lo[0], lo[1], lo[2], lo[3], h4[0], h4[1], h4[2], h4[3]};
              o1 = __builtin_amdgcn_mfma_f32_32x32x16_bf16(vf, pf[st], o1, 0, 0, 0); }
        }
        __syncthreads();
    };
    tile(0, TT{});
    for (int t = 1; t < NT; ++t) tile(t, FF{});
    lsum += shx(lsum, 32, lane);
    const float inv = __builtin_amdgcn_rcpf(lsum);
    bf16_t* op = O + (size_t)qrow * 512 + h * VD + 4 * hi;
#pragma unroll
    for (int g = 0; g < 4; ++g) {
        u32x2 w0, w1;
        w0.x = cvt_pk_bf16(o0[4 * g] * inv, o0[4 * g + 1] * inv); w0.y = cvt_pk_bf16(o0[4 * g + 2] * inv, o0[4 * g + 3] * inv);
        w1.x = cvt_pk_bf16(o1[4 * g] * inv, o1[4 * g + 1] * inv); w1.y = cvt_pk_bf16(o1[4 * g + 2] * inv, o1[4 * g + 3] * inv);
        *(u32x2*)(op + 8 * g) = w0; *(u32x2*)(op + 32 + 8 * g) = w1;
    }
}

#ifndef PH
#define PH 0xFFFFFFFFu
#endif
#define PHON(k) ((PH >> (k)) & 1u)
#define PHASE_WS size_t wso_ = 0; asm volatile("" : "+s"(wso_)); unsigned char* ws = ws0 + wso_;
#define PHASE_CTX PHASE_WS const Ctx& Cb_ = C; const Ctx C = fresh(Cb_);

#ifndef DBG
#define DBG 0
#endif
constexpr int CW_DBG = 64;
__device__ __forceinline__ void dbg_scan(const Ctx& C, unsigned char* ws, const void* p, size_t nbytes, bool isf32, int id) {
#if DBG
    const size_t n16 = nbytes / 16; bool bad = false;
    for (size_t i = (size_t)C.bid * 512 + C.tid; i < n16; i += (size_t)C.G * 512) {
        const u32x4 v = ((const u32x4*)p)[i]; const unsigned w[4] = {v.x, v.y, v.z, v.w};
#pragma unroll
        for (int q = 0; q < 4; ++q) { if (isf32) bad |= ((w[q] & 0x7F800000u) >= (145u << 23)); else bad |= ((w[q] & 0x7F80u) >= (145u << 7)) || ((w[q] & 0x7F800000u) >= (145u << 23)); }
    }
    if (bad) atomicMax((unsigned*)(ws + WS_CTL) + CW_DBG, (unsigned)(100 - id));
#endif
}
__device__ __forceinline__ void dbg_max(const Ctx& C, unsigned char* ws, const void* p, size_t nbytes, int slot) {
    const size_t n16 = nbytes / 16; unsigned mx = 0u;
    for (size_t i = (size_t)C.bid * 512 + C.tid; i < n16; i += (size_t)C.G * 512) {
        const u32x4 v = ((const u32x4*)p)[i]; const unsigned w[4] = {v.x, v.y, v.z, v.w};
#pragma unroll
        for (int q = 0; q < 4; ++q) { const unsigned a = (w[q] & 0x7FFFu) << 16, b = w[q] & 0x7FFF0000u; mx = a > mx ? a : mx; mx = b > mx ? b : mx; }
    }
    if (mx > 0x7E000000u) mx = 0x7E000000u;
    atomicMax((unsigned*)(ws + WS_CTL) + CW_DBG + 1 + slot, mx);
}
#define DBGMAX(p, nbytes, slot) do { if (DBG) { PHASE_CTX dbg_max(C, ws, (p), (nbytes), (slot)); } } while (0)
#define DBGSCAN(p, nbytes, isf32, id) do { if (DBG) { PHASE_CTX dbg_scan(C, ws, (p), (nbytes), (isf32), (id)); } } while (0)
#define GRID_BAR() xcd_barrier(bar, C.wave)
#define mods ((float*)(ws + WS_MODS))
#define ropet ((float*)(ws + WS_ROPE))
#define twt ((float*)(ws + WS_TW))
#define dft128 ((bf16_t*)(ws + WS_DFT128))
#define m64 ((bf16_t*)(ws + WS_M64))
#define dft256 ((bf16_t*)(ws + WS_DFT256))
#define ssq ((float*)(ws + WS_SSQ))
#define xw ((float*)(ws + WS_XW))
#define Pb ((bf16_t*)(ws + WS_P))
#define Gt ((bf16_t*)(ws + WS_G))
#define A1 ((bf16_t*)(ws + WS_A1))
#define Qb ((bf16_t*)(ws + WS_Q))
#define Kb ((bf16_t*)(ws + WS_K))
#define Vtb ((bf16_t*)(ws + WS_VT))
#define ytmp ((float*)(ws + WS_A2))
#define AO ((bf16_t*)(ws + WS_AO))
#define MIXb ((bf16_t*)(ws + WS_MIX))
#define YY ((bf16_t*)(ws + WS_YY))
template <int layer>
__device__ __forceinline__ void layer_body(const Ctx& C, const Params& prm, unsigned char* ws0, const XcdBarrier& bar) {
    constexpr bool last = (layer == 1);
        const int nrt = last ? 64 : 66;
#define mods_l (mods + (size_t)layer * 3 * 6144)
#define lw (ws + WS_PERM + (size_t)layer * LW_SIZE)
        if (PHON(2)) { PHASE_WS
            pg8::Gemm g{A1, (const bf16_t*)(lw + LW_IN), 1024, 1024, 1024, 0};
            pg8::GridOrder S; S.init(nrt, NIN / 256, C.G, C.bid);
            if (last) { S.xm0 = 64; S.xn0 = 1; S.xnm = 2; S.nX = 4; }
            pg8::EpiWin E{Pb, Gt, prm.in[I_BGATE] + layer * 3072, ssq};
            pg8::gemm_phase<pg8::EpiWin, pg8::GridOrder, true>(C.lds, g, S, E, C.wave);
        }
        GRID_BAR();
        DBGSCAN(Pb, (size_t)nrt * 256 * NIN * 2, false, 15 * layer + 3); DBGSCAN(ssq, (size_t)nrt * 256 * 20 * 4, true, 15 * layer + 3);
        {
            if (PHON(3)) { PHASE_WS pg8::Gemm g{Pb, (const bf16_t*)(lw + LW_UQ), PP, QL, QL, 0};
              pg8::GridOrder S; S.init(nrt, 3, C.G, C.bid);
              pg8::EpiPlain E{Qb, nullptr, 768};
              pg8::gemm_phase<pg8::EpiPlain, pg8::GridOrder, true>(C.lds, g, S, E, C.wave); }
            if (PHON(4)) { PHASE_CTX
              pg8::Gemm g{Pb + OFF_KV, (const bf16_t*)(lw + LW_UKV), PP, KVL, KVL, 0};
              pg8::GridOrder S; S.init(66, 4, C.G, (C.bid + C.G / 2) % C.G);
              pg8::EpiPlain E{YY, AO, 1024};
              pg8::gemm_phase<pg8::EpiPlain, pg8::GridOrder, true>(C.lds, g, S, E, C.wave);
              VM_WAIT(); __syncthreads();
              pg8::Unit u;
              for (int i = 0; S.next(i, u); ++i) {
                  const bool lat = u.pm < 64;
                  const int bb = lat ? (u.pm >> 5) : (u.pm - 64), key0 = lat ? (NCTX + (u.pm & 31) * 256) : 0;
                  const int row = C.tid >> 1, hh = C.tid & 1, grow = u.pm * 256 + row;
                  const bf16_t* rawrow = (lat ? YY + (size_t)grow * 1024 : AO + (size_t)(grow - TL) * 1024) + u.pn * 256 + hh * 128;
                  float r;
                  { const float* sp = ssq + (size_t)grow * 20 + 12; const f32x4 a = *(const f32x4*)sp, b = *(const f32x4*)(sp + 4);
                    r = __builtin_amdgcn_rsqf((((a[0] + a[1]) + (a[2] + a[3])) + ((b[0] + b[1]) + (b[2] + b[3]))) * (1.0f / KVL) + EPS); }
                  const int h = u.pn * 2 + hh;
                  { bf16_t* kdst = Kb + ((size_t)(bb * NH + h) * NKEY + key0 + row) * QKD;
#pragma unroll
                    for (int c = 0; c < 8; ++c) { const u32x4 v = *(const u32x4*)(rawrow + 8 * c); u32x4 o;
                        o.x = cvt_pk_bf16(bflo(v.x) * r, bfhi(v.x) * r); o.y = cvt_pk_bf16(bflo(v.y) * r, bfhi(v.y) * r); o.z = cvt_pk_bf16(bflo(v.z) * r, bfhi(v.z) * r); o.w = cvt_pk_bf16(bflo(v.w) * r, bfhi(v.w) * r);
                        *(u32x4*)(kdst + 8 * c) = o; } }
                  constexpr int VSLD = 528;
#pragma unroll 1
                  for (int hv = 0; hv < 2; ++hv) {
                      __syncthreads();
                      { const bf16_t* vr = rawrow - hh * 128 + hv * 128 + 64 + hh * 32;
#pragma unroll
                        for (int c = 0; c < 4; ++c) { const u32x4 v = *(const u32x4*)(vr + 8 * c); const unsigned wv[4] = {v.x, v.y, v.z, v.w};
#pragma unroll
                            for (int q = 0; q < 4; ++q) { const unsigned pk = cvt_pk_bf16(bflo(wv[q]) * r, bfhi(wv[q]) * r); const int d = hh * 32 + c * 8 + q * 2;
                                *(LAS bf16_t*)(C.lds + d * VSLD + row * 2) = (bf16_t)(pk & 0xffffu); *(LAS bf16_t*)(C.lds + (d + 1) * VSLD + row * 2) = (bf16_t)(pk >> 16); } } }
                      __syncthreads();
                      { const int d = C.tid >> 3, ch = C.tid & 7; bf16_t* vdst = Vtb + ((size_t)(bb * NH + u.pn * 2 + hv) * VD + d) * NKEY + key0;
#pragma unroll
                        for (int c = 0; c < 4; ++c) { const int k8 = ch * 4 + c; *(u32x4*)(vdst + 8 * k8) = *(const LAS u32x4*)(C.lds + d * VSLD + k8 * 16); } }
                  }
                  __syncthreads();
              } }
            if (PHON(5)) { PHASE_CTX for (int row = C.gw; row < T; row += C.ngw) {
                const bool lat = row < TL;
                const int t = lat ? (row & (SEQ - 1)) : ((row - TL) & 255), Ls = lat ? SEQ : NCTX;
                if (lat || !last) {
                    const int g = C.lane >> 4, w = 2 << g, left = w >> 1, right = w - 1 - left;
                    const int lo = max(t - left, 0), hiE = min(t + right + 1, Ls);
                    float s[8] = {0.f, 0.f, 0.f, 0.f, 0.f, 0.f, 0.f, 0.f};
                    const bf16_t* base = Pb + (size_t)(row - t) * PP + OFF_POOL + C.lane * 8;
                    u32x4 wv[16];
#pragma unroll
                    for (int j = 0; j < 16; ++j) { const int tt = t + j - 8; wv[j] = (tt >= lo && tt < hiE) ? *(const u32x4*)(base + (size_t)tt * PP) : (u32x4){0u, 0u, 0u, 0u}; }
#pragma unroll
                    for (int j = 0; j < 16; ++j) { const u32x4 v = wv[j];
                        s[0] += bflo(v.x); s[1] += bfhi(v.x); s[2] += bflo(v.y); s[3] += bfhi(v.y); s[4] += bflo(v.z); s[5] += bfhi(v.z); s[6] += bflo(v.w); s[7] += bfhi(v.w); }
                    const u32x4 me = wv[8];
                    const float ic = 1.0f / (float)(hiE - lo);
                    u32x4 o; o.x = cvt_pk_bf16(s[0] * ic - bflo(me.x), s[1] * ic - bfhi(me.x)); o.y = cvt_pk_bf16(s[2] * ic - bflo(me.y), s[3] * ic - bfhi(me.y));
                    o.z = cvt_pk_bf16(s[4] * ic - bflo(me.z), s[5] * ic - bfhi(me.z)); o.w = cvt_pk_bf16(s[6] * ic - bflo(me.w), s[7] * ic - bfhi(me.w));
                    *(u32x4*)(MIXb + (size_t)row * 512 + C.lane * 8) = o;
                }
                if (C.lane < 16) {
                    const int a = C.lane >> 3, f = C.lane & 7;
                    const float x1 = bf2f(Pb[(size_t)row * PP + OFF_KR + a * 16 + f]), x2 = bf2f(Pb[(size_t)row * PP + OFF_KR + a * 16 + 8 + f]);
                    float cs = 1.f, sn = 0.f;
                    if (lat) { const int pos = a ? (t & 63) : (t >> 6); cs = ropet[(pos * 8 + f) * 2]; sn = ropet[(pos * 8 + f) * 2 + 1]; }
                    const bf16_t o1 = f2bf(x1 * cs - x2 * sn), o2 = f2bf(x2 * cs + x1 * sn);
                    const int bb = lat ? (row >> 13) : ((row - TL) >> 8), key = lat ? (NCTX + t) : t;
#pragma unroll
                    for (int h = 0; h < NH; ++h) { bf16_t* kp = Kb + ((size_t)(bb * NH + h) * NKEY + key) * QKD + 64 + a * 8 + f; kp[0] = o1; kp[16] = o2; }
                }
            } }
            if (PHON(6)) { PHASE_CTX for (int un = C.bid; un < 512; un += C.G) {
                const int cch = un & 3, l2 = (un >> 2) & 63, b = un >> 8;
                const bf16_t* src = Pb + (size_t)(b * SEQ + l2) * PP + OFF_FFT + cch * 128;
                flex_tile_n256(C,
                    [&](int m, int k) { return gather8(src + (size_t)k * 64 * PP + m, (size_t)64 * PP); },
                    [&](int n, int k) { return *(const bf16x8*)(dft128 + (size_t)n * 128 + k); },
                    [&](int m, int n, float re, float im) {
                        const int k1 = n >> 1; const float tc = twt[(k1 * 64 + l2) * 2], ts = twt[(k1 * 64 + l2) * 2 + 1];
                        bf16_t* dp = A1 + ((size_t)((b * 128 + k1) * 64 + l2) * 2) * 512 + cch * 128 + m;
                        dp[0] = f2bf(re * tc + im * ts); dp[512] = f2bf(im * tc - re * ts); });
            } }
            if (PHON(7) && !last) { PHASE_CTX for (int un = C.bid; un < 32; un += C.G) {
                const int nch = un & 3, cch = (un >> 2) & 3, b = un >> 4;
                const bf16_t* src = Pb + (size_t)(TL + b * NCTX) * PP + OFF_FFT + cch * 128;
                flex_tile(C, 256,
                    [&](int m, int k) { return gather8(src + (size_t)k * PP + m, (size_t)PP); },
                    [&](int n, int k) { return *(const bf16x8*)(dft256 + (size_t)(nch * 128 + n) * 256 + k); },
                    [&](int m, int n, float re, float im) {
                        const int kf = (nch * 128 + n) >> 1;
                        bf16_t* dp = YY + (size_t)(TL + b * NCTX + kf) * 1024 + cch * 256 + m;
                        dp[0] = f2bf(re * 5.656854249f); dp[128] = f2bf(im * 5.656854249f); });
            } }
        }
        GRID_BAR();
        DBGSCAN(Qb, (size_t)nrt * 256 * 768 * 2, false, 15 * layer + 4); DBGSCAN(Kb, (size_t)NB * NH * NKEY * QKD * 2, false, 15 * layer + 4); DBGSCAN(Vtb, (size_t)NB * NH * VD * NKEY * 2, false, 15 * layer + 4);
        DBGSCAN(MIXb, (size_t)nrt * 256 * 512 * 2, false, 15 * layer + 5); DBGSCAN(A1, (size_t)TL * 1024 * 2, false, 15 * layer + 5); if (!last) DBGSCAN(YY + (size_t)TL * 1024, (size_t)TC * 1024 * 2, false, 15 * layer + 5);
        {
            if (PHON(8)) { PHASE_CTX for (int un = C.bid; un < 1024; un += C.G) {
                const int cch = un & 3, k1 = (un >> 2) & 127, b = un >> 9;
                const bf16_t* src = A1 + (size_t)((b * 128 + k1) * 128) * 512 + cch * 128;
                flex_tile(C, 128,
                    [&](int m, int k) { return gather8(src + (size_t)k * 512 + m, (size_t)512); },
                    [&](int n, int k) { return *(const bf16x8*)(m64 + (size_t)n * 128 + k); },
                    [&](int m, int n, float yr, float yi) {
                        const int k2 = n >> 1;
                        bf16_t* dp = YY + (size_t)(b * SEQ + k1 + 128 * k2) * 1024 + cch * 256 + m;
                        dp[0] = f2bf(yr); dp[128] = f2bf(yi); });
            } }
            __syncthreads();
            const int vcu = (C.G % 8 == 0) ? (C.bid % 8) * (C.G / 8) + C.bid / 8 : C.bid;
            if (PHON(9)) { PHASE_CTX for (int un = vcu; un < 512; un += C.G) { const int bh = un >> 5, qb = un & 31; attn_unit(C, Qb, Kb, Vtb, AO, ssq, ropet, bh >> 3, bh & 7, (bh >> 3) * SEQ + qb * 256, NKEY / AT_KT); } }
            if (PHON(9) && !last) { PHASE_CTX for (int un = C.bid; un < 16; un += C.G) { const int b = un >> 3, h = un & 7; attn_unit(C, Qb, Kb, Vtb, AO, ssq, ropet, b, h, TL + b * NCTX, NCTX / AT_KT); } }
            __syncthreads();
        }
        GRID_BAR();
        DBGSCAN(AO, (size_t)nrt * 256 * 512 * 2, false, 15 * layer + 13); DBGSCAN(YY, (size_t)nrt * 256 * 1024 * 2, false, 15 * layer + 6);
        {
            pg8::GridOrder S; S.init(nrt, 4, C.G, C.bid);
            if (PHON(10)) { PHASE_WS pg8::Gemm g{AO, (const bf16_t*)(lw + LW_OA), 512, 512, 512, 0}; pg8::EpiMerge<0> E{Gt, (bf16_t*)ytmp, A1};
              pg8::gemm_phase<pg8::EpiMerge<0>, pg8::GridOrder, true>(C.lds, g, S, E, C.wave); }
            if (PHON(11)) { PHASE_WS pg8::Gemm g{MIXb, (const bf16_t*)(lw + LW_PB), 512, 512, 512, 0}; pg8::EpiMerge<1> E{Gt, (bf16_t*)ytmp, A1};
              pg8::gemm_phase<pg8::EpiMerge<1>, pg8::GridOrder, true>(C.lds, g, S, E, C.wave); }
            if (PHON(12)) { PHASE_WS pg8::Gemm g{YY, (const bf16_t*)(lw + LW_FC), 1024, 1024, 1024, 0}; pg8::EpiMerge<2> E{Gt, (bf16_t*)ytmp, A1};
              pg8::gemm_phase<pg8::EpiMerge<2>, pg8::GridOrder, true>(C.lds, g, S, E, C.wave); }
        }
        GRID_BAR();
        DBGSCAN(A1, (size_t)nrt * 256 * 1024 * 2, false, 15 * layer + 7);
        if (PHON(13)) { PHASE_WS
            { pg8::Gemm g{A1, (const bf16_t*)(lw + LW_OUT), 1024, 1024, 1024, 0};
              pg8::GridOrder S; S.init(64, 4, C.G, C.bid);
              pg8::EpiResid E{xw, mods_l + 2 * 1024, last ? (const float*)xw : prm.in[I_X], xw + (size_t)TL * D};
              pg8::gemm_phase<pg8::EpiResid, pg8::GridOrder, true>(C.lds, g, S, E, C.wave); }
            if (!last) { pg8::Gemm g{A1, (const bf16_t*)(lw + LW_OUT), 1024, 1024, 256, 512, 512};
              pg8::CtxSplitOrder S{4, C.G, (C.bid + 128) % C.G};
              pg8::EpiCtxPart E{ytmp, mods_l + 2 * 6144 + 2 * 1024};
              pg8::gemm_phase<pg8::EpiCtxPart, pg8::CtxSplitOrder, true>(C.lds, g, S, E, C.wave); }
        }
        GRID_BAR();
        DBGSCAN(xw, (size_t)T * 1024 * 4, true, 15 * layer + 8);
        if (!last) {
            if (PHON(14)) { PHASE_CTX norm_phase(C, xw, prm.in[I_CTX], prm.in[I_GN2] + layer * D, mods_l, 1, A1, T, ytmp, 4, xw + (size_t)TL * D); }
            GRID_BAR();
            DBGSCAN(A1, (size_t)T * 1024 * 2, false, 15 * layer + 9);
            if (PHON(15)) { PHASE_WS
                pg8::Gemm g{A1, (const bf16_t*)(ws + WS_FFN13), 1024, 1024, 1024, 0};
                pg8::GridOrder S; S.init(66, 22, C.G, C.bid);
                pg8::EpiSwiglu E{(bf16_t*)(ws + WS_U), DFF};
                pg8::gemm_phase<pg8::EpiSwiglu, pg8::GridOrder, true>(C.lds, g, S, E, C.wave);
            }
            GRID_BAR();
            DBGSCAN(ws + WS_U, (size_t)T * DFF * 2, false, 15 * layer + 10);
            if (PHON(16)) { PHASE_WS
                { pg8::Gemm g{(const bf16_t*)(ws + WS_U), (const bf16_t*)(ws + WS_FFN2), DFF, DFF, DFF, 0};
                  pg8::GridOrder S; S.init(64, 4, C.G, C.bid);
                  pg8::EpiResid E{xw, mods_l + 5 * 1024, xw, xw + (size_t)TL * D};
                  pg8::gemm_phase<pg8::EpiResid, pg8::GridOrder, true>(C.lds, g, S, E, C.wave); }
                { pg8::Gemm g{(const bf16_t*)(ws + WS_U), (const bf16_t*)(ws + WS_FFN2), DFF, DFF, 256, 512, 512};
                  pg8::CtxSplitOrder S{11, C.G, (C.bid + 128) % C.G};
                  pg8::EpiCtxPart E{ytmp, mods_l + 2 * 6144 + 5 * 1024};
                  pg8::gemm_phase<pg8::EpiCtxPart, pg8::CtxSplitOrder, true>(C.lds, g, S, E, C.wave); }
            }
            GRID_BAR();
            DBGSCAN(xw, (size_t)T * 1024 * 4, true, 15 * layer + 11);
            if (PHON(17)) { PHASE_CTX norm_phase(C, xw, xw + (size_t)TL * D, prm.in[I_GN1] + D, mods + (size_t)3 * 6144, 0, A1, T, ytmp, 11, nullptr); }
            GRID_BAR();
        } else {
#define route_e ((int*)(ws + WS_ROUTE_E))
#define route_w ((float*)(ws + WS_ROUTE_W))
#define tokslot ((int*)(ws + WS_TOKSLOT))
#define blkcnt ((int*)(ws + WS_BLKCNT))
#define h2m ((bf16_t*)(ws + WS_H2M))
#define h2g ((bf16_t*)(ws + WS_H2G))
#define uf ((bf16_t*)(ws + WS_UF))
#define yx2 ((bf16_t*)(ws + WS_YX2))
#define yexp ((bf16_t*)(ws + WS_YEXP))
            LAS int* tile_e = (LAS int*)(C.lds + TILE_E_OFF);
            LAS int* sc_i = (LAS int*)(C.lds + SCR_OFF);
            if (PHON(18)) { PHASE_CTX
                LAS float* wscr = (LAS float*)(C.lds + C.wave * 8448);
                const float* wrt = prm.in[I_ROUTER]; const float* rb = prm.in[I_RBIAS];
                for (int blk = C.bid; blk < 256; blk += C.G) {
                    const int rowb = blk * 64 + C.wave * 8, set = rowb >> 13;
                    const float* mp = mods_l + set * 6144 + 3072; const float* gn = prm.in[I_GN2] + D;
                    f32x4 gsc[4], shv[4]; float wreg[4][4][8];
#pragma unroll
                    for (int j = 0; j < 4; ++j) { const f32x4 gg = *((const f32x4*)gn + C.lane + 64 * j), s1 = *((const f32x4*)(mp + 1024) + C.lane + 64 * j); gsc[j] = gg * (s1 + 1.0f); shv[j] = *((const f32x4*)mp + C.lane + 64 * j);
#pragma unroll
                        for (int i = 0; i < 4; ++i) { const float* wp = wrt + (size_t)(4 * (C.lane + 64 * j) + i) * 8; const f32x4 w0 = *(const f32x4*)wp, w1 = *(const f32x4*)(wp + 4);
                            wreg[j][i][0] = w0[0]; wreg[j][i][1] = w0[1]; wreg[j][i][2] = w0[2]; wreg[j][i][3] = w0[3]; wreg[j][i][4] = w1[0]; wreg[j][i][5] = w1[1]; wreg[j][i][6] = w1[2]; wreg[j][i][7] = w1[3]; } }
                    f32x4 xn[4];
#pragma unroll
                    for (int j = 0; j < 4; ++j) xn[j] = *((const f32x4*)(xw + (size_t)rowb * D) + C.lane + 64 * j);
#pragma unroll 1
                    for (int rr = 0; rr < 8; ++rr) {
                        const int row = rowb + rr;
                        f32x4 v[4];
#pragma unroll
                        for (int j = 0; j < 4; ++j) v[j] = xn[j];
                        if (rr < 7) {
#pragma unroll
                            for (int j = 0; j < 4; ++j) xn[j] = *((const f32x4*)(xw + (size_t)(row + 1) * D) + C.lane + 64 * j);
                        }
                        float ssx = 0.f;
#pragma unroll
                        for (int j = 0; j < 4; ++j) ssx += (v[j][0] * v[j][0] + v[j][1] * v[j][1]) + (v[j][2] * v[j][2] + v[j][3] * v[j][3]);
                        const float rstd = __builtin_amdgcn_rsqf(wave_sum(ssx, C.lane) * (1.0f / D) + EPS);
                        float lg[8] = {0.f, 0.f, 0.f, 0.f, 0.f, 0.f, 0.f, 0.f};
#pragma unroll
                        for (int j = 0; j < 4; ++j) {
                            v[j] = v[j] * rstd * gsc[j] + shv[j];
                            u32x2 w; w.x = cvt_pk_bf16(v[j][0], v[j][1]); w.y = cvt_pk_bf16(v[j][2], v[j][3]);
                            *((u32x2*)(h2m + (size_t)row * D) + C.lane + 64 * j) = w;
#pragma unroll
                            for (int i = 0; i < 4; ++i)
#pragma unroll
                                for (int e = 0; e < 8; ++e) lg[e] += v[j][i] * wreg[j][i][e];
                        }
#pragma unroll
                        for (int e = 0; e < 8; ++e) lg[e] = wave_sum(lg[e], C.lane) + rb[e];
                        int ea = 0; float va = lg[0];
#pragma unroll
                        for (int e = 1; e < 8; ++e) if (lg[e] > va) { va = lg[e]; ea = e; }
                        int eb = (ea + 1) & 7; float vb = -3.0e38f;
#pragma unroll
                        for (int e = 0; e < 8; ++e) if (e != ea && lg[e] > vb) { vb = lg[e]; eb = e; }
                        const float wa = 1.0f / (1.0f + expf(vb - va));
                        if (C.lane == 0) { route_e[row] = ea | (eb << 8); route_w[2 * row] = wa; route_w[2 * row + 1] = 1.0f - wa; }
                    }
                    __syncthreads();
                    VM_WAIT(); __syncthreads();
                    if (C.tid < 8) { int c = 0; for (int i = 0; i < 64; ++i) { const int e2 = __hip_atomic_load(route_e + blk * 64 + i, __ATOMIC_RELAXED, __HIP_MEMORY_SCOPE_AGENT); c += ((e2 & 255) == C.tid) + ((e2 >> 8) == C.tid); }
                        blkcnt[blk * 8 + C.tid] = c; }
                    __syncthreads();
                }
                constexpr int IE1 = 16 * 88, IE2 = 44 * 32, IE = 2 * IE1 + IE2;
                for (int it = C.gw; it < NE * IE; it += C.ngw) {
                    const int e = it / IE; int r = it % IE;
                    if (r < 2 * IE1) { const int w3 = r >= IE1; if (w3) r -= IE1; const int kb = r / 88, nb = r % 88;
                        tr_item(prm.in[w3 ? I_MW3 : I_MW1] + (size_t)e * D * DFF, DFF, 64 * kb, 32 * nb, nullptr, (bf16_t*)(ws + WS_MW13) + (size_t)e * 5632 * 1024, 1024, 64 * kb, RowGU{w3 ? 16 : 0}, wscr, C.lane); }
                    else { r -= 2 * IE1; const int kb = r / 32, nb = r % 32;
                        tr_item(prm.in[I_MW2] + (size_t)e * DFF * D, 1024, 64 * kb, 32 * nb, nullptr, (bf16_t*)(ws + WS_MW2) + (size_t)e * 1024 * DFF, DFF, 64 * kb, RowId{}, wscr, C.lane); }
                }
            }
            GRID_BAR();
            DBGSCAN(h2m, (size_t)TL * 1024 * 2, false, 24); DBGSCAN(ws + WS_MW13, (size_t)NE * 5632 * 1024 * 2 + (size_t)NE * 1024 * DFF * 2, false, 25);
            if (PHON(19)) { PHASE_CTX
                __syncthreads();
                if (C.tid < 8) { int tot = 0; for (int b2 = 0; b2 < 256; ++b2) tot += blkcnt[b2 * 8 + C.tid]; sc_i[128 + C.tid] = tot; }
                __syncthreads();
                if (C.tid == 0) { int seg = 0, tl = 0; for (int e = 0; e < 8; ++e) { sc_i[136 + e] = seg; const int ntl = (sc_i[128 + e] + 255) >> 8; for (int q = 0; q < ntl; ++q) tile_e[tl++] = e; seg += ntl * 256; } tile_e[140] = tl; }
                __syncthreads();
                for (int blk = C.bid; blk < 256; blk += C.G) {
                    if (C.tid < 8) { int run = sc_i[136 + C.tid]; for (int b2 = 0; b2 < blk; ++b2) run += blkcnt[b2 * 8 + C.tid];
                        for (int i = 0; i < 64; ++i) { const int e2 = route_e[blk * 64 + i]; if ((e2 & 255) == C.tid) { sc_i[256 + 2 * i] = run; tokslot[2 * (blk * 64 + i)] = run; ++run; } if ((e2 >> 8) == C.tid) { sc_i[256 + 2 * i + 1] = run; tokslot[2 * (blk * 64 + i) + 1] = run; ++run; } } }
                    __syncthreads();
                    for (int rr = 0; rr < 8; ++rr) { const int lr = C.wave * 8 + rr, row = blk * 64 + lr;
                        const u32x4* sp = (const u32x4*)(h2m + (size_t)row * D) + C.lane; const u32x4 v0 = sp[0], v1 = sp[64];
                        u32x4* d0 = (u32x4*)(h2g + (size_t)sc_i[256 + 2 * lr] * D) + C.lane; u32x4* d1 = (u32x4*)(h2g + (size_t)sc_i[256 + 2 * lr + 1] * D) + C.lane;
                        d0[0] = v0; d0[64] = v1; d1[0] = v0; d1[64] = v1; }
                    __syncthreads();
                }
                if (C.bid < 8) { const int e = C.bid, cnt = sc_i[128 + e], s0 = sc_i[136 + e] + cnt, s1 = sc_i[136 + e] + (((cnt + 255) >> 8) << 8);
                    for (int i = C.tid; i < (s1 - s0) * 128; i += 512) *((u32x4*)(h2g + (size_t)s0 * D) + i) = (u32x4){0u, 0u, 0u, 0u}; }
            }
            GRID_BAR();
            const int ntiles = tile_e[140];
            DBGSCAN(h2g, (size_t)ntiles * 256 * 1024 * 2, false, 26);
            {
                if (PHON(20)) { PHASE_WS pg8::Gemm g{h2g, (const bf16_t*)(ws + WS_MW13), 1024, 1024, 1024, (size_t)5632 * 1024 * 2};
                  pg8::GridOrder S; S.init(ntiles, 22, C.G, C.bid); S.tile_e = tile_e;
                  pg8::EpiSwiglu E{uf, DFF};
                  pg8::gemm_phase<pg8::EpiSwiglu, pg8::GridOrder, true>(C.lds, g, S, E, C.wave); }
                GRID_BAR();
                if (PHON(21)) { PHASE_WS
                  { pg8::Gemm g{uf, (const bf16_t*)(ws + WS_MW2), DFF, DFF, DFF, (size_t)1024 * DFF * 2};
                    pg8::GridOrder S; S.init(ntiles < 128 ? ntiles : 128, 4, C.G, C.bid); S.tile_e = tile_e;
                    pg8::EpiMoeDown E{yexp, yx2};
                    pg8::gemm_phase<pg8::EpiMoeDown, pg8::GridOrder, true>(C.lds, g, S, E, C.wave); }
                  if (ntiles > 128) { pg8::Gemm g{uf, (const bf16_t*)(ws + WS_MW2), DFF, DFF, DFH, (size_t)1024 * DFF * 2, 0, (size_t)DFH * 2, (size_t)DFH * 2};
                    pg8::MoeOvOrder S{ntiles - 128, C.G, (C.bid + 128) % C.G, tile_e};
                    pg8::EpiMoeDown E{yexp, yx2};
                    pg8::gemm_phase<pg8::EpiMoeDown, pg8::MoeOvOrder, true>(C.lds, g, S, E, C.wave); }
                }
                GRID_BAR();
            }
            if (PHON(24)) { PHASE_CTX for (int row = C.gw; row < TL; row += C.ngw) {
                const int set = row >> 13; const float* gt = mods_l + set * 6144 + 5 * 1024;
                const float wa = route_w[2 * row], wb = route_w[2 * row + 1]; const int sa = tokslot[2 * row], sb = tokslot[2 * row + 1];
                f32x4 v[4]; float s = 0.f;
#pragma unroll
                for (int j = 0; j < 4; ++j) {
                    const f32x4 x = *((const f32x4*)(xw + (size_t)row * D) + C.lane + 64 * j), gg = *((const f32x4*)gt + C.lane + 64 * j);
                    const u32x2 ya = *((const u32x2*)(yexp + (size_t)sa * D) + C.lane + 64 * j), yb = *((const u32x2*)(yexp + (size_t)sb * D) + C.lane + 64 * j);
                    f32x4 fa = (f32x4){bflo(ya.x), bfhi(ya.x), bflo(ya.y), bfhi(ya.y)}, fb = (f32x4){bflo(yb.x), bfhi(yb.x), bflo(yb.y), bfhi(yb.y)};
                    if (sa >= 32768) { const u32x2 y2 = *((const u32x2*)(yx2 + (size_t)(sa - 32768) * D) + C.lane + 64 * j); fa += (f32x4){bflo(y2.x), bfhi(y2.x), bflo(y2.y), bfhi(y2.y)}; }
                    if (sb >= 32768) { const u32x2 y2 = *((const u32x2*)(yx2 + (size_t)(sb - 32768) * D) + C.lane + 64 * j); fb += (f32x4){bflo(y2.x), bfhi(y2.x), bflo(y2.y), bfhi(y2.y)}; }
                    v[j] = x + gg * (fa * wa + fb * wb);
                    s += (v[j][0] * v[j][0] + v[j][1] * v[j][1]) + (v[j][2] * v[j][2] + v[j][3] * v[j][3]);
                }
                const float rstd = __builtin_amdgcn_rsqf(wave_sum(s, C.lane) * (1.0f / D) + EPS);
#pragma unroll
                for (int j = 0; j < 4; ++j) { const f32x4 gf = *((const f32x4*)prm.in[I_GFINAL] + C.lane + 64 * j); f32x4 o = v[j] * rstd * gf;
#if DBG
                    { const unsigned fl = *((volatile unsigned*)(ws + WS_CTL) + CW_DBG); if (fl) { const float big = exp2f(2.0f * (float)(100 - (int)fl)); o = (f32x4){big, big, big, big}; }
                      else {
#pragma unroll
                          for (int i = 0; i < 4; ++i) if (!(fabsf(o[i]) < 1e30f)) o[i] = 0.f; } }
#endif
                    *((f32x4*)(prm.out + (size_t)row * D) + C.lane + 64 * j) = o; }
            } }
        }

}
__global__ void __launch_bounds__(512, 2) mega_fwd(Params prm) {
    extern __shared__ __attribute__((aligned(16))) unsigned char lds_raw[];
    Ctx C;
    C.lds = (LAS unsigned char*)lds_raw;
    C.tid = threadIdx.x; C.lane = C.tid & 63; C.wave = __builtin_amdgcn_readfirstlane(C.tid >> 6);
    C.G = gridDim.x; C.bid = blockIdx.x; C.gw = C.bid * 8 + C.wave; C.ngw = C.G * 8;
    unsigned char* ws0 = prm.ws;
    for (int u = C.tid; u < (LDS_BYTES - LDSCTL_OFF) / 4; u += 512) ((LAS unsigned*)(C.lds + LDSCTL_OFF))[u] = 0u;
    __syncthreads();
    XcdBarrier bar = xcd_barrier_post((unsigned*)(ws0 + WS_CTL) + CW_BAR, (volatile LAS unsigned*)(C.lds + MISC_OFF) + 8);
    if (PHON(0)) { PHASE_CTX
        const int gtid = C.bid * 512 + C.tid, gthreads = C.G * 512;
        LAS float* wscr = (LAS float*)(C.lds + C.wave * 8448);
        for (int item = C.bid; item < 192; item += C.G) {
            const int layer = item / 96, c0 = (item % 96) * 64;
            const float* wm = prm.in[I_WMOD] + (size_t)layer * D * 6144 + c0 + C.lane;
            float a0 = 0.f, a1 = 0.f, a2 = 0.f;
#pragma unroll 1
            for (int kh = 0; kh < 2; ++kh) {
                const int k0 = C.wave * 128 + kh * 64;
                float s0 = prm.in[I_C][k0 + C.lane], s1 = prm.in[I_C][D + k0 + C.lane], s2 = prm.in[I_CCTX][k0 + C.lane];
                s0 = s0 * sigmoidf_fast(s0); s1 = s1 * sigmoidf_fast(s1); s2 = s2 * sigmoidf_fast(s2);
                float wv[64];
#pragma unroll
                for (int j = 0; j < 64; ++j) wv[j] = wm[(size_t)(k0 + j) * 6144];
#pragma unroll
                for (int j = 0; j < 64; ++j) {
                    a0 += __int_as_float(__builtin_amdgcn_readlane(__float_as_int(s0), j)) * wv[j];
                    a1 += __int_as_float(__builtin_amdgcn_readlane(__float_as_int(s1), j)) * wv[j];
                    a2 += __int_as_float(__builtin_amdgcn_readlane(__float_as_int(s2), j)) * wv[j];
                }
            }
            LAS float* red = (LAS float*)(C.lds + 80000);
            __syncthreads();
            red[(C.wave * 3 + 0) * 64 + C.lane] = a0; red[(C.wave * 3 + 1) * 64 + C.lane] = a1; red[(C.wave * 3 + 2) * 64 + C.lane] = a2;
            __syncthreads();
            if (C.tid < 192) { const int set = C.tid >> 6, l = C.tid & 63; float s = 0.f;
#pragma unroll
                for (int w = 0; w < 8; ++w) s += red[(w * 3 + set) * 64 + l];
                mods[(size_t)(layer * 3 + set) * 6144 + c0 + l] = s + prm.in[I_BMOD][layer * 6144 + c0 + l]; }
            __syncthreads();
        }
        for (int i = gtid; i < 128 * 8; i += gthreads) { const int pos = i >> 3, f = i & 7; const float inv = exp2f(-(float)f * (13.287712379549449f / 8.0f)); const float a = (float)pos * inv;
            ropet[2 * i] = cosf(a); ropet[2 * i + 1] = sinf(a); }
        for (int i = gtid; i < 128 * 64; i += gthreads) { const int k1 = i >> 6, l2 = i & 63; const float x = (float)((k1 * l2) & 8191) * (2.0f / 8192.0f); twt[2 * i] = cospif(x); twt[2 * i + 1] = sinpif(x); }
        for (int i = gtid; i < 256 * 128; i += gthreads) { const int n = i >> 7, l1 = i & 127, k1 = n >> 1; const float x = (float)((k1 * l1) & 127) * (2.0f / 128.0f); dft128[i] = f2bf((n & 1) ? -sinpif(x) : cospif(x)); }
        for (int i = gtid; i < 128 * 128; i += gthreads) { const int n = i >> 7, kk = i & 127, k2 = n >> 1, ro = n & 1, l2 = kk >> 1, ri = kk & 1; const float x = (float)((k2 * l2) & 63) * (2.0f / 64.0f);
            const float c = cospif(x), s = sinpif(x); m64[i] = f2bf(ro == ri ? c : (ro == 0 ? s : -s)); }
        for (int i = gtid; i < 512 * 256; i += gthreads) { const int n = i >> 8, l = i & 255, k = n >> 1; const float x = (float)((k * l) & 255) * (2.0f / 256.0f); dft256[i] = f2bf((n & 1) ? -sinpif(x) : cospif(x)); }
        {
            constexpr int IL_IN = 16 * 149, IL_UQ = 6 * 24, IL_UKV = 4 * 32, IL_OA = 8 * 32, IL_OUT = 16 * 32, IL = IL_IN + IL_UQ + IL_UKV + IL_OA + IL_OUT;
            constexpr int IF1 = 16 * 88, IF2 = 44 * 32, NIT = 2 * IL + 2 * IF1 + IF2;
            for (int it = C.gw; it < NIT; it += C.ngw) {
                int r = it;
                if (r < 2 * IL) {
                    const int layer = r / IL; r -= layer * IL;
                    bf16_t* lwp = (bf16_t*)(ws + WS_PERM + (size_t)layer * LW_SIZE);
                    if (r < IL_IN) { tr_item(prm.in[I_WIN] + (size_t)layer * D * IN_COLS, IN_COLS, 64 * (r / 149), 32 * (r % 149), nullptr, (bf16_t*)((char*)lwp + LW_IN), 1024, 64 * (r / 149), RowWin{}, wscr, C.lane); continue; } r -= IL_IN;
                    if (r < IL_UQ) { tr_item(prm.in[I_WUQ] + (size_t)layer * QL * 768, 768, 64 * (r / 24), 32 * (r % 24), prm.in[I_GQ] + layer * QL, (bf16_t*)((char*)lwp + LW_UQ), QL, 64 * (r / 24), RowQ{}, wscr, C.lane); continue; } r -= IL_UQ;
                    if (r < IL_UKV) { tr_item(prm.in[I_WUKV] + (size_t)layer * KVL * 1024, 1024, 64 * (r / 32), 32 * (r % 32), prm.in[I_GKV] + layer * KVL, (bf16_t*)((char*)lwp + LW_UKV), KVL, 64 * (r / 32), RowId{}, wscr, C.lane); continue; } r -= IL_UKV;
                    if (r < IL_OA) { tr_item(prm.in[I_WOA] + (size_t)layer * 512 * 1024, 1024, 64 * (r / 32), 32 * (r % 32), nullptr, (bf16_t*)((char*)lwp + LW_OA), 512, 64 * (r / 32), RowId{}, wscr, C.lane); continue; } r -= IL_OA;
                    tr_item(prm.in[I_WOUT] + (size_t)layer * D * D, 1024, 64 * (r / 32), 32 * (r % 32), nullptr, (bf16_t*)((char*)lwp + LW_OUT), 1024, 64 * (r / 32), RowId{}, wscr, C.lane); continue;
                }
                r -= 2 * IL;
                if (r < IF1) { tr_item(prm.in[I_FW1], DFF, 64 * (r / 88), 32 * (r % 88), nullptr, (bf16_t*)(ws + WS_FFN13), 1024, 64 * (r / 88), RowGU{0}, wscr, C.lane); continue; } r -= IF1;
                if (r < IF1) { tr_item(prm.in[I_FW3], DFF, 64 * (r / 88), 32 * (r % 88), nullptr, (bf16_t*)(ws + WS_FFN13), 1024, 64 * (r / 88), RowGU{16}, wscr, C.lane); continue; } r -= IF1;
                tr_item(prm.in[I_FW2], 1024, 64 * (r / 32), 32 * (r % 32), nullptr, (bf16_t*)(ws + WS_FFN2), DFF, 64 * (r / 32), RowId{}, wscr, C.lane);
            }
            for (int i = gtid; i < 2 * 96 * 128; i += gthreads) { const int layer = i / (96 * 128), r = i % (96 * 128);
                *(u32x4*)(ws + WS_PERM + (size_t)layer * LW_SIZE + LW_IN + (size_t)OFF_GATE * 2048 + (size_t)r * 16) = (u32x4){0u, 0u, 0u, 0u}; }
        }
        {
            LAS float* ctab = (LAS float*)(C.lds + 90000);
            __syncthreads();
            if (C.tid < 128) ctab[C.tid] = cospif((float)C.tid * (2.0f / 128.0f));
            __syncthreads();
            for (int un = C.bid; un < 64 + 128; un += C.G) {
                if (un < 64) {
                    const int layer = un >> 5, g = (un >> 3) & 3, dch = un & 7;
                    const float* wo = prm.in[I_WOB] + ((size_t)layer * 512 + g * 128) * 1024 + dch * 128;
                    const float* wp = prm.in[I_WPOOL] + (size_t)(layer * 4 + g) * 128 * 128; const float* sp = prm.in[I_SPOOL] + layer * 512 + g * 128;
                    bf16_t* dst = (bf16_t*)(ws + WS_PERM + (size_t)layer * LW_SIZE + LW_PB) + (size_t)dch * 128 * 512 + g * 128;
                    flex_tile(C, 128,
                        [&](int m, int k) { u32x4 o; float f[8];
#pragma unroll
                            for (int t = 0; t < 8; ++t) f[t] = wo[(size_t)(k + t) * 1024 + m];
                            o.x = cvt_pk_bf16(f[0], f[1]); o.y = cvt_pk_bf16(f[2], f[3]); o.z = cvt_pk_bf16(f[4], f[5]); o.w = cvt_pk_bf16(f[6], f[7]); return __builtin_bit_cast(bf16x8, o); },
                        [&](int n, int k) { const f32x4 a0 = *(const f32x4*)(wp + (size_t)n * 128 + k), a1 = *(const f32x4*)(wp + (size_t)n * 128 + k + 4), s0 = *(const f32x4*)(sp + k), s1 = *(const f32x4*)(sp + k + 4);
                            u32x4 o; o.x = cvt_pk_bf16(a0[0] * s0[0], a0[1] * s0[1]); o.y = cvt_pk_bf16(a0[2] * s0[2], a0[3] * s0[3]); o.z = cvt_pk_bf16(a1[0] * s1[0], a1[1] * s1[1]); o.w = cvt_pk_bf16(a1[2] * s1[2], a1[3] * s1[3]);
                            return __builtin_bit_cast(bf16x8, o); },
                        [&](int m, int n, float v0, float v1) { *(unsigned*)(dst + (size_t)m * 512 + n) = cvt_pk_bf16(v0, v1); });
                } else {
                    const int u2 = un - 64, layer = u2 >> 6, g = (u2 >> 4) & 3, dch = (u2 >> 1) & 7, nch = u2 & 1, sh = nch ? 96 : 0;
                    const float* wo = prm.in[I_WOC] + ((size_t)layer * 512 + g * 128) * 1024 + dch * 128;
                    bf16_t* dst = (bf16_t*)(ws + WS_PERM + (size_t)layer * LW_SIZE + LW_FC) + (size_t)dch * 128 * 1024 + g * 256 + nch * 128;
                    flex_tile(C, 128,
                        [&](int m, int k) { u32x4 o; float f[8];
#pragma unroll
                            for (int t = 0; t < 8; ++t) f[t] = wo[(size_t)(k + t) * 1024 + m];
                            o.x = cvt_pk_bf16(f[0], f[1]); o.y = cvt_pk_bf16(f[2], f[3]); o.z = cvt_pk_bf16(f[4], f[5]); o.w = cvt_pk_bf16(f[6], f[7]); return __builtin_bit_cast(bf16x8, o); },
                        [&](int n, int k) { float f[8];
#pragma unroll
                            for (int t = 0; t < 8; ++t) f[t] = ctab[((k + t) * n + sh) & 127];
                            u32x4 o; o.x = cvt_pk_bf16(f[0], f[1]); o.y = cvt_pk_bf16(f[2], f[3]); o.z = cvt_pk_bf16(f[4], f[5]); o.w = cvt_pk_bf16(f[6], f[7]); return __builtin_bit_cast(bf16x8, o); },
                        [&](int m, int n, float v0, float v1) { *(unsigned*)(dst + (size_t)m * 1024 + n) = cvt_pk_bf16(v0 * (1.0f / 1024.0f), v1 * (1.0f / 1024.0f)); });
                }
            }
        }
    }
    GRID_BAR();
    DBGSCAN(ws0 + WS_DFT128, WS_ROUTE_E - WS_DFT128, false, 1); DBGSCAN(ws0 + WS_ROPE, WS_DFT128 - WS_ROPE, true, 1); DBGSCAN(ws0 + WS_PERM, WS_ARENA - WS_PERM, false, 1); DBGSCAN(ws0 + WS_MODS, (size_t)2 * 3 * 6144 * 4, true, 1); DBGSCAN(ws0 + WS_XW, (size_t)T * D * 4, true, 1);
    if (PHON(1)) { PHASE_CTX norm_phase(C, prm.in[I_X], prm.in[I_CTX], prm.in[I_GN1], mods, 0, A1, T); }
    GRID_BAR();
    DBGSCAN(ws0 + WS_A1, (size_t)T * D * 2, false, 2);

    layer_body<0>(C, prm, ws0, bar);
    layer_body<1>(C, prm, ws0, bar);
#undef GRID_BAR
}

extern "C" void kernel_launch(void* const* d_in, const int* in_sizes, int n_in, void* d_out, int out_size, void* d_ws, size_t ws_size, hipStream_t stream) {
    static int grid = 0;
    if (grid == 0) {
        if (n_in != 29 || out_size != TL * D || ws_size < WS_NEED) { fprintf(stderr, "kernel_launch: unexpected shapes (n_in %d out %d ws %zu need %zu)\n", n_in, out_size, ws_size, (size_t)WS_NEED); grid = -1; return; }
        int dev = 0, cus = 0, per_cu = 0;
        if (hipGetDevice(&dev) != hipSuccess || hipDeviceGetAttribute(&cus, hipDeviceAttributeMultiprocessorCount, dev) != hipSuccess) { grid = -1; return; }
        if (hipFuncSetAttribute((const void*)mega_fwd, hipFuncAttributeMaxDynamicSharedMemorySize, LDS_BYTES) != hipSuccess) { fprintf(stderr, "kernel_launch: hipFuncSetAttribute failed\n"); grid = -1; return; }
        if (hipOccupancyMaxActiveBlocksPerMultiprocessor(&per_cu, (const void*)mega_fwd, 512, LDS_BYTES) != hipSuccess || per_cu < 1) { fprintf(stderr, "kernel_launch: occupancy query reports %d\n", per_cu); }
        (void)hipGetLastError();
        grid = cus;
        if (grid != 256) { fprintf(stderr, "kernel_launch: built for a 256-CU device (got %d)\n", cus); if (grid > 256) grid = 256; }
    }
    if (grid < 0) return;
    if (hipMemsetAsync((char*)d_ws + WS_CTL, 0, CTL_ZERO_BYTES, stream) != hipSuccess) return;
    Params p{};
    for (int i = 0; i < 29; ++i) p.in[i] = (const float*)d_in[i];
    p.out = (float*)d_out; p.ws = (unsigned char*)d_ws;
    hipLaunchKernelGGL(mega_fwd, dim3(grid), dim3(512), LDS_BYTES, stream, p);
}
```

```cpp
#include <hip/hip_runtime.h>
#include <cstdio>
#include <cstdint>

#define LAS __attribute__((address_space(3)))
#define GAS __attribute__((address_space(1)))
typedef unsigned short bf16_t;
typedef short bf16x8 __attribute__((ext_vector_type(8)));
typedef short s16x4 __attribute__((ext_vector_type(4)));
typedef float f32x2 __attribute__((ext_vector_type(2)));
typedef float f32x4 __attribute__((ext_vector_type(4)));
typedef float f32x16 __attribute__((ext_vector_type(16)));
typedef unsigned u32x2 __attribute__((ext_vector_type(2)));
typedef unsigned u32x4 __attribute__((ext_vector_type(4)));

constexpr int D = 1024, NB = 2, SEQ = 8192, NCTX = 256;
constexpr int TL = NB * SEQ;
constexpr int TC = NB * NCTX;
constexpr int T = TL + TC;
constexpr int NH = 8, QKD = 96, VD = 64, QL = 384, KVL = 256;
constexpr int NKEY = NCTX + SEQ;
constexpr int OFF_KV = 384, OFF_KR = 640, OFF_POOL = 672, OFF_FFT = 1184, OFF_GATE = 1696, IN_COLS = 4768, NIN = 4864;
constexpr int PP = 1792;
constexpr int DFF = 2816, NE = 8, DFH = 1408;
constexpr int MOE_ROWS = 34816;
constexpr float EPS = 1e-6f;
constexpr float QSCALE = 0.10206207261596577f * 1.4426950408889634f;

constexpr size_t MiB = 1u << 20;
constexpr size_t WS_CTL = 0, CTL_ZERO_BYTES = 64 * 1024;
constexpr size_t WS_MODS = 1 * MiB;
constexpr size_t WS_ROPE = WS_MODS + 2 * 3 * 6144 * 4;
constexpr size_t WS_TW = WS_ROPE + 128 * 8 * 2 * 4;
constexpr size_t WS_DFT128 = WS_TW + 128 * 64 * 2 * 4;
constexpr size_t WS_M64 = WS_DFT128 + 256 * 128 * 2;
constexpr size_t WS_DFT256 = WS_M64 + 128 * 128 * 2;
constexpr size_t WS_ROUTE_E = WS_DFT256 + 512 * 256 * 2;
constexpr size_t WS_ROUTE_W = WS_ROUTE_E + 16384 * 4;
constexpr size_t WS_TOKSLOT = WS_ROUTE_W + 16384 * 8;
constexpr size_t WS_BLKCNT = WS_TOKSLOT + 16384 * 8;
constexpr size_t WS_SSQ = 4 * MiB;
constexpr size_t WS_XW = 8 * MiB;
constexpr size_t WS_PERM = WS_XW + (size_t)T * D * 4;
constexpr size_t LW_IN = 0, LW_UQ = LW_IN + (size_t)NIN * 1024 * 2, LW_UKV = LW_UQ + 768 * 384 * 2, LW_OA = LW_UKV + 1024 * 256 * 2,
                 LW_PB = LW_OA + 1024 * 512 * 2, LW_FC = LW_PB + 1024 * 512 * 2, LW_OUT = LW_FC + 1024 * 1024 * 2, LW_SIZE = LW_OUT + 1024 * 1024 * 2;
constexpr size_t WS_FFN13 = WS_PERM + 2 * LW_SIZE;
constexpr size_t WS_FFN2 = WS_FFN13 + (size_t)5632 * 1024 * 2;
constexpr size_t WS_ARENA = WS_FFN2 + (size_t)1024 * 2816 * 2;
constexpr size_t WS_P = WS_ARENA;
constexpr size_t WS_G = WS_P + (size_t)T * PP * 2;
constexpr size_t WS_A1 = WS_P + (size_t)T * NIN * 2;
constexpr size_t WS_A2 = WS_A1 + (size_t)T * D * 2;
constexpr size_t WS_Q = WS_A2, WS_K = WS_Q + (size_t)T * 768 * 2, WS_VT = WS_K + (size_t)NB * NH * NKEY * QKD * 2;
constexpr size_t WS_A3 = WS_A2 + (size_t)T * D * 4;
constexpr size_t WS_AO = WS_A3, WS_MIX = WS_AO + (size_t)T * 512 * 2, WS_YY = WS_MIX + (size_t)T * 512 * 2;
constexpr size_t WS_MIXER_END = WS_YY + (size_t)T * 1024 * 2;
static_assert(WS_VT + (size_t)NB * NH * VD * NKEY * 2 <= WS_A3, "QKV fits A2");
constexpr size_t WS_U = WS_P;
static_assert((size_t)T * DFF * 2 <= (size_t)T * NIN * 2, "u fits p");
constexpr size_t WS_MW13 = WS_PERM;
constexpr size_t WS_MW2 = WS_MW13 + (size_t)NE * 5632 * 1024 * 2;
constexpr size_t WS_H2G = WS_MW2 + (size_t)NE * 1024 * DFF * 2;
constexpr size_t WS_UF = WS_H2G + (size_t)MOE_ROWS * 1024 * 2;
constexpr size_t WS_YX2 = WS_UF + (size_t)MOE_ROWS * DFF * 2;
constexpr size_t WS_YEXP = WS_H2G;
constexpr size_t WS_MOE_END = WS_YX2 + (size_t)2048 * 1024 * 2;
constexpr size_t WS_NEED = WS_MIXER_END > WS_MOE_END ? WS_MIXER_END : WS_MOE_END;
static_assert(WS_NEED <= 496000000ull, "workspace budget");
constexpr size_t WS_H2M = WS_UF;

constexpr int CW_BAR = 1024;

constexpr int RING_BYTES = 131072;
constexpr int LDSCTL_OFF = RING_BYTES;
constexpr int MISC_OFF = LDSCTL_OFF;
constexpr int TILE_E_OFF = LDSCTL_OFF + 256;
constexpr int SCR_OFF = LDSCTL_OFF + 1024;
constexpr int LDS_BYTES = 147456;

typedef __bf16 bf16x2_t __attribute__((ext_vector_type(2)));
__device__ __forceinline__ unsigned cvt_pk_bf16(float lo, float hi) { const f32x2 v = {lo, hi}; const bf16x2_t b = __builtin_convertvector(v, bf16x2_t); return __builtin_bit_cast(unsigned, b); }
__device__ __forceinline__ float bf2f(unsigned short v) { return __uint_as_float((unsigned)v << 16); }
__device__ __forceinline__ float bflo(unsigned v) { return __uint_as_float(v << 16); }
__device__ __forceinline__ float bfhi(unsigned v) { return __uint_as_float(v & 0xffff0000u); }
__device__ __forceinline__ bf16_t f2bf(float f) { return (bf16_t)(cvt_pk_bf16(f, 0.f) & 0xffffu); }
__device__ __forceinline__ float shx(float v, int o, int lane) { return __int_as_float(__builtin_amdgcn_ds_bpermute((lane ^ o) << 2, __float_as_int(v))); }
__device__ __forceinline__ float wave_sum(float v, int lane) {
#pragma unroll
    for (int o = 1; o < 64; o <<= 1) v += shx(v, o, lane);
    return v;
}
__device__ __forceinline__ float sigmoidf_fast(float x) { return __builtin_amdgcn_rcpf(1.0f + __builtin_amdgcn_exp2f(-1.4426950408889634f * x)); }
__device__ __forceinline__ int crow(int r, int hi) { return (r & 3) + 8 * (r >> 2) + 4 * hi; }
#define LDS_WAIT() asm volatile("s_waitcnt lgkmcnt(0)" ::: "memory")
#define VM_WAIT() asm volatile("s_waitcnt vmcnt(0)" ::: "memory")

#define XB_TMO      128
#define XB_XCNT(j)  (256  + 64 * (j))
#define XB_XSUB(j)  (1280 + 64 * (j))
#define XB_XGEN(j)  (2304 + 64 * (j))
#define XB_TOP      3328
#define XB_TOPGEN   3392
#define XCD_BAR_WORDS 3456
#define XB_SPIN_CAP (1u << 18)
__device__ __forceinline__ unsigned xb_ld(unsigned* p)              { return __hip_atomic_load(p, __ATOMIC_RELAXED, __HIP_MEMORY_SCOPE_AGENT); }
__device__ __forceinline__ unsigned xb_add(unsigned* p, unsigned v) { return __hip_atomic_fetch_add(p, v, __ATOMIC_RELAXED, __HIP_MEMORY_SCOPE_AGENT); }
__device__ __forceinline__ unsigned xb_xcc_id() { return (unsigned)__builtin_amdgcn_s_getreg((3 << 11) | 20) & 0xFu; }
#define XB_SPIN(cond, bar) do { unsigned _sp = 0; while (cond) { __builtin_amdgcn_s_sleep(1); \
    if ((++_sp & 255u) == 0u) { if (xb_ld(&(bar)[XB_TMO])) break; if (_sp > XB_SPIN_CAP) { atomicAdd(&(bar)[XB_TMO], 1u); break; } } } } while (0)
struct XcdBarrier { unsigned* bar; unsigned x; volatile LAS unsigned* st; };
__device__ __forceinline__ XcdBarrier xcd_barrier_post(unsigned* bar, volatile LAS unsigned* st) {
    XcdBarrier b; b.bar = bar; b.x = xb_xcc_id(); b.st = st;
    if (threadIdx.x == 0) (void)xb_add(&bar[XB_XCNT(b.x)], 1u);
    return b;
}
__device__ __forceinline__ void xcd_barrier_complete(unsigned* bar, unsigned x, unsigned& nloc, unsigned& nx) {
    const unsigned G = gridDim.x * gridDim.y * gridDim.z;
    unsigned sum, cnt, mine, sp = 0u;
    for (;;) {
        sum = 0u; cnt = 0u; mine = 0u;
#pragma unroll
        for (unsigned j = 0; j < 16; ++j) { const unsigned c = xb_ld(&bar[XB_XCNT(j)]); sum += c; cnt += (c > 0u) ? 1u : 0u; mine = (j == x) ? c : mine; }
        if (sum == G) break;
        __builtin_amdgcn_s_sleep(1);
        if ((++sp & 255u) == 0u) { if (xb_ld(&bar[XB_TMO])) break; if (sp > XB_SPIN_CAP) { atomicAdd(&bar[XB_TMO], 1u); break; } }
    }
    nloc = mine > 0u ? mine : 1u; nx = cnt > 0u ? cnt : 1u;
}
__device__ __forceinline__ void xcd_barrier(const XcdBarrier& b, int wave_id) {
    asm volatile("s_waitcnt vmcnt(0)" ::: "memory");
    __syncthreads();
    if (wave_id == 0 && __builtin_amdgcn_mbcnt_hi(~0u, __builtin_amdgcn_mbcnt_lo(~0u, 0u)) == 0u) {
        unsigned* bar = b.bar;
        __builtin_amdgcn_s_waitcnt(0);
        unsigned nloc = b.st[0], nx = b.st[1];
        if (nloc == 0u) { xcd_barrier_complete(bar, b.x, nloc, nx); b.st[0] = nloc; b.st[1] = nx; }
        const unsigned old = xb_add(&bar[XB_XSUB(b.x)], 1u);
        const unsigned gen = old / nloc;
        if (old + 1u == (gen + 1u) * nloc) {
            __builtin_amdgcn_fence(__ATOMIC_RELEASE, "agent");
            asm volatile("s_waitcnt vmcnt(0)" ::: "memory");
            const unsigned og = xb_add(&bar[XB_TOP], 1u);
            const unsigned tg = og / nx;
            if (og + 1u == (tg + 1u) * nx) xb_add(&bar[XB_TOPGEN], 1u);
            else XB_SPIN(xb_ld(&bar[XB_TOPGEN]) == tg, bar);
            __builtin_amdgcn_fence(__ATOMIC_ACQUIRE, "agent");
            xb_add(&bar[XB_XGEN(b.x)], 1u);
            asm volatile("s_waitcnt vmcnt(0)" ::: "memory");
        } else {
            XB_SPIN(xb_ld(&bar[XB_XGEN(b.x)]) == gen, bar);
            __builtin_amdgcn_fence(__ATOMIC_ACQUIRE, "agent");
            asm volatile("s_waitcnt vmcnt(0)" ::: "memory");
        }
    }
    __syncthreads();
}

namespace pg8 {
constexpr int BM = 256, BK = 64, HALF = 128, HTB = HALF * BK * 2, NXCD = 8, WGM = 4;
__host__ __device__ __forceinline__ int lds_byte(int r, int c) { const int st = (r >> 4) * 2 + (c >> 5), rr = r & 15, cc = c & 31, ob = rr * 64 + cc * 2; return st * 1024 + (ob ^ (((ob >> 9) & 1) << 5)); }
__host__ __device__ __forceinline__ void stage_rc(int b, int& R, int& C) { const int st = b / 1024, sb = b % 1024, swz = sb ^ (((sb >> 9) & 1) << 5); R = (st >> 1) * 16 + swz / 64; C = (st & 1) * 32 + (swz % 64) / 2; }
__host__ __device__ __forceinline__ int perm32(int rho) { const int n = rho >> 4, i = rho & 15; return 8 * (i >> 2) + 4 * n + (i & 3); }

struct Unit { int pm, pn, e, s = 0; };
struct Gemm { const bf16_t* A; const bf16_t* Bt; int lda, ldb, K; size_t bstride; size_t astride = 0; size_t astride2 = 0, bstride2 = 0; };

struct GridOrder {
    int nM, nN, nwg, G, c, xm0, xn0, xnm, nX; const LAS int* tile_e;
    __device__ __forceinline__ void init(int nM_, int nN_, int G_, int c_) { nM = nM_; nN = nN_; nwg = nM * nN; G = G_; c = c_; xm0 = xn0 = 0; xnm = 1; nX = 0; tile_e = nullptr; }
    __device__ __forceinline__ bool next(int i, Unit& u) const {
        long L = (long)i * G + c;
        if (L < nwg) {
            int wgid = (int)L; { const int q = nwg / NXCD, r = nwg % NXCD, xcd = wgid % NXCD, off = wgid / NXCD; wgid = (xcd < r ? xcd * (q + 1) : r * (q + 1) + (xcd - r) * q) + off; }
            const int nig = WGM * nN, gid = wgid / nig, fm = gid * WGM, gsz = (nM - fm) < WGM ? (nM - fm) : WGM;
            u.pm = fm + ((wgid % nig) % gsz); u.pn = (wgid % nig) / gsz; u.e = tile_e ? tile_e[u.pm] : 0; u.s = 0; return true;
        }
        L -= nwg; if (L >= nX) return false;
        u.pm = xm0 + (int)(L % xnm); u.pn = xn0 + (int)(L / xnm); u.e = 0; u.s = 0; return true;
    }
};

struct CtxSplitOrder {
    int nsl, G, c;
    __device__ __forceinline__ bool next(int i, Unit& u) const { const int L = i * G + c; if (L >= 8 * nsl) return false; u.e = L % nsl; u.s = 0; const int q = L / nsl; u.pn = q & 3; u.pm = 64 + (q >> 2); return true; }
};
struct MoeOvOrder {
    int nov, G, c; const LAS int* tile_e;
    __device__ __forceinline__ bool next(int i, Unit& u) const { const int L = i * G + c; if (L >= nov * 8) return false; u.s = L & 1; const int q = L >> 1; u.pn = q & 3; u.pm = 128 + (q >> 2); u.e = tile_e[u.pm]; return true; }
};
template <class Epi, class Sched, bool ALIGN_EPI>
__device__ __forceinline__ void gemm_phase(LAS unsigned char* lds, const Gemm g, const Sched& S, const Epi& E, int wave_id) {
    int wid_l = wave_id; asm volatile("" : "+s"(wid_l)); int lane_l = (int)__builtin_amdgcn_mbcnt_hi(~0u, __builtin_amdgcn_mbcnt_lo(~0u, 0u)); asm volatile("" : "+v"(lane_l));
    const int wid = wid_l, lane = lane_l, tid = wid * 64 + lane, wr = wid >> 2, wc = wid & 3, fr = lane & 15, fq = lane >> 4;
    const int K = g.K, nt = K / BK;
    unsigned voffA[2], voffB[2];
#pragma unroll
    for (int i = 0; i < 2; ++i) { int R, C; stage_rc(tid * 16 + i * 8192, R, C); const int Rb = Epi::PERM ? ((R & ~31) + perm32(R & 31)) : R;
        voffA[i] = (unsigned)(R * g.lda + C) * 2u; voffB[i] = (unsigned)(Rb * g.ldb + C) * 2u; }
    const size_t kstep = (size_t)(BK * 2);
    const size_t hstepA = (size_t)HALF * g.lda * 2, hstepB = (size_t)HALF * g.ldb * 2;
    const unsigned ldsw = (unsigned)wid * 1024u;
    const int aoff = lds_byte(wr * 64 + fr, fq * 8), boff = lds_byte(wc * 32 + fr, fq * 8);
#define PG8_SA(b, h) (((b) * 2 + (h)) * HTB)
#define PG8_SB(b, h) ((4 + (b) * 2 + (h)) * HTB)
#define PG8_STAGE(bufoff, gbase, voff) do { _Pragma("unroll") for (int _i = 0; _i < 2; ++_i) \
        __builtin_amdgcn_global_load_lds((const unsigned*)((const char*)(gbase) + (voff)[_i]), (LAS unsigned*)(lds + (bufoff) + ldsw + _i * 8192), 16, 0, 0); } while (0)
#define PG8_LDA(dst, b, h) do { _Pragma("unroll") for (int m = 0; m < 4; ++m) _Pragma("unroll") for (int k = 0; k < 2; ++k) dst[m][k] = *(const LAS bf16x8*)(lds + PG8_SA(b, h) + aoff + m * 2048 + k * 1024); } while (0)
#define PG8_LDB(dst, b, h) do { _Pragma("unroll") for (int n = 0; n < 2; ++n) _Pragma("unroll") for (int k = 0; k < 2; ++k) dst[n][k] = *(const LAS bf16x8*)(lds + PG8_SB(b, h) + boff + n * 2048 + k * 1024); } while (0)
#define PG8_MMA(ai, bj, At, Bt) do { __builtin_amdgcn_s_setprio(1); _Pragma("unroll") for (int m = 0; m < 4; ++m) _Pragma("unroll") for (int n = 0; n < 2; ++n) _Pragma("unroll") for (int k = 0; k < 2; ++k) \
        acc[ai][bj][m][n] = __builtin_amdgcn_mfma_f32_16x16x32_bf16(Bt[n][k], At[m][k], acc[ai][bj][m][n], 0, 0, 0); __builtin_amdgcn_s_setprio(0); } while (0)
#define PG8_WAIT_V(n) asm volatile("s_waitcnt vmcnt(" #n ")" ::: "memory")
#define PG8_WAIT_L(n) asm volatile("s_waitcnt lgkmcnt(" #n ")" ::: "memory")
#define PG8_BAR __builtin_amdgcn_s_barrier()
#define PG8_SCHED __builtin_amdgcn_sched_barrier(0)
    Unit cur, nxt; int ui = 0;
    if (!S.next(0, cur)) return;
    f32x4 acc[2][2][4][2];
#pragma unroll
    for (int a = 0; a < 2; ++a)
#pragma unroll
        for (int b = 0; b < 2; ++b)
#pragma unroll
            for (int m = 0; m < 4; ++m)
#pragma unroll
                for (int n = 0; n < 2; ++n) acc[a][b][m][n] = (f32x4){0.f, 0.f, 0.f, 0.f};
    bf16x8 At[4][2], B0[2][2], B1[2][2];
    const char* cA = (const char*)g.A + (size_t)cur.pm * 2 * hstepA + (size_t)cur.e * g.astride + (size_t)cur.s * g.astride2; const char* cB = (const char*)g.Bt + (size_t)cur.e * g.bstride + (size_t)cur.s * g.bstride2 + (size_t)cur.pn * 2 * hstepB;
    PG8_STAGE(PG8_SB(0, 0), cB, voffB); PG8_STAGE(PG8_SB(0, 1), cB + hstepB, voffB); PG8_STAGE(PG8_SA(0, 0), cA, voffA); PG8_STAGE(PG8_SA(0, 1), cA + hstepA, voffA);
    if (wr == 1) PG8_BAR;
    PG8_WAIT_V(2); PG8_BAR;
    PG8_STAGE(PG8_SB(1, 0), cB + kstep, voffB); PG8_STAGE(PG8_SA(1, 0), cA + kstep, voffA); PG8_STAGE(PG8_SB(1, 1), cB + hstepB + kstep, voffB);
    PG8_WAIT_V(6); PG8_BAR;
    for (;;) {
        const bool has_next = S.next(ui + 1, nxt);
        const char* nA = has_next ? (const char*)g.A + (size_t)nxt.pm * 2 * hstepA + (size_t)nxt.e * g.astride + (size_t)nxt.s * g.astride2 : cA;
        const char* nB = has_next ? (const char*)g.Bt + (size_t)nxt.e * g.bstride + (size_t)nxt.s * g.bstride2 + (size_t)nxt.pn * 2 * hstepB : cB;
        for (int t = 0; t < nt; t += 2) {
            const bool last = (t == nt - 2);
            const char* a1 = cA + (size_t)(t + 1) * kstep;
            const char* a2 = last ? nA : cA + (size_t)(t + 2) * kstep; const char* b2 = last ? nB : cB + (size_t)(t + 2) * kstep;
            const char* a3 = a2 + kstep; const char* b3 = b2 + kstep;
            PG8_LDB(B0, 0, 0); PG8_LDB(B1, 0, 1); PG8_SCHED; PG8_LDA(At, 0, 0); PG8_STAGE(PG8_SA(1, 1), a1 + hstepA, voffA);
            PG8_WAIT_V(8); PG8_WAIT_L(0); PG8_BAR; PG8_MMA(0, 0, At, B0); PG8_MMA(0, 1, At, B1); PG8_BAR; PG8_SCHED;
            PG8_LDA(At, 0, 1); PG8_STAGE(PG8_SB(0, 0), b2, voffB); PG8_STAGE(PG8_SB(0, 1), b2 + hstepB, voffB); PG8_STAGE(PG8_SA(0, 0), a2, voffA);
            PG8_WAIT_V(8); PG8_WAIT_L(0); PG8_BAR; PG8_MMA(1, 0, At, B0); PG8_MMA(1, 1, At, B1); PG8_BAR; PG8_SCHED;
            PG8_LDB(B0, 1, 0); PG8_LDB(B1, 1, 1); PG8_SCHED; PG8_LDA(At, 1, 0); PG8_STAGE(PG8_SA(0, 1), a2 + hstepA, voffA);
            PG8_WAIT_V(8); PG8_WAIT_L(0); PG8_BAR; PG8_MMA(0, 0, At, B0); PG8_MMA(0, 1, At, B1); PG8_BAR; PG8_SCHED;
            PG8_LDA(At, 1, 1); PG8_STAGE(PG8_SB(1, 0), b3, voffB); PG8_STAGE(PG8_SB(1, 1), b3 + hstepB, voffB); PG8_STAGE(PG8_SA(1, 0), a3, voffA);
            PG8_WAIT_V(8); PG8_WAIT_L(0); PG8_BAR; PG8_MMA(1, 0, At, B0); PG8_MMA(1, 1, At, B1); PG8_BAR; PG8_SCHED;
        }
        if constexpr (ALIGN_EPI) { if (wr == 0) PG8_BAR; }
        E(acc, cur, wr, wc, fr, fq);
        if (!has_next) break;
#pragma unroll
        for (int a = 0; a < 2; ++a)
#pragma unroll
            for (int b = 0; b < 2; ++b)
#pragma unroll
                for (int m = 0; m < 4; ++m)
#pragma unroll
                    for (int n = 0; n < 2; ++n) acc[a][b][m][n] = (f32x4){0.f, 0.f, 0.f, 0.f};
        cur = nxt; cA = nA; cB = nB; ++ui;
        if constexpr (ALIGN_EPI) { if (wr == 1) PG8_BAR; }
    }
    PG8_WAIT_V(0);
    if constexpr (!ALIGN_EPI) { if (wr == 0) PG8_BAR; }
    PG8_BAR;
#undef PG8_SA
#undef PG8_SB
#undef PG8_STAGE
#undef PG8_LDA
#undef PG8_LDB
#undef PG8_MMA
#undef PG8_WAIT_V
#undef PG8_WAIT_L
#undef PG8_BAR
#undef PG8_SCHED
}
typedef f32x4 Acc[2][2][4][2];

struct EpiWin {
    static constexpr bool PERM = true;
    bf16_t* P; bf16_t* G; const float* bgate; float* ssq;
    __device__ __forceinline__ void operator()(const Acc& acc, const Unit& u, int wr, int wc, int fr, int fq) const {
        asm volatile("" : "+v"(fr), "+v"(fq));
        const int row0 = u.pm * BM + wr * 64 + fr;
        if (u.pn < 7) {
#pragma unroll
            for (int bj = 0; bj < 2; ++bj) {
                const int colb = u.pn * BM + bj * HALF + wc * 32, col0 = colb + 8 * fq;
#pragma unroll
                for (int ai = 0; ai < 2; ++ai)
#pragma unroll
                    for (int m = 0; m < 4; ++m) {
                        const int row = row0 + ai * HALF + m * 16;
                        const f32x4 v0 = acc[ai][bj][m][0], v1 = acc[ai][bj][m][1];
                        if (colb < OFF_KR) {
                            float s = (v0[0] * v0[0] + v0[1] * v0[1]) + (v0[2] * v0[2] + v0[3] * v0[3]) + (v1[0] * v1[0] + v1[1] * v1[1]) + (v1[2] * v1[2] + v1[3] * v1[3]);
                            { const int ln = fr + 16 * fq; s += shx(s, 16, ln); s += shx(s, 32, ln); }
                            if (fq == 0) ssq[(size_t)row * 20 + (colb >> 5)] = s;
                        }
                        u32x4 w; w.x = cvt_pk_bf16(v0[0], v0[1]); w.y = cvt_pk_bf16(v0[2], v0[3]); w.z = cvt_pk_bf16(v1[0], v1[1]); w.w = cvt_pk_bf16(v1[2], v1[3]);
                        *(u32x4*)(P + (size_t)row * PP + col0) = w;
                    }
            }
        } else {
            const int g = u.pn - 7, lane = fr + 16 * fq, wid = wr * 4 + wc;
            bf16_t* gt = G + ((size_t)(u.pm * 12 + g) * 8192 + (size_t)wid * 1024 + lane) * 8;
#pragma unroll
            for (int bj = 0; bj < 2; ++bj) {
                const int bc = g * BM + bj * HALF + wc * 32 + 8 * fq;
                const f32x4 b0 = *(const f32x4*)(bgate + bc), b1 = *(const f32x4*)(bgate + bc + 4);
#pragma unroll
                for (int ai = 0; ai < 2; ++ai)
#pragma unroll
                    for (int m = 0; m < 4; ++m) {
                        f32x4 v0 = acc[ai][bj][m][0] + b0, v1 = acc[ai][bj][m][1] + b1;
#pragma unroll
                        for (int i = 0; i < 4; ++i) { v0[i] = sigmoidf_fast(v0[i]); v1[i] = sigmoidf_fast(v1[i]); }
                        u32x4 w; w.x = cvt_pk_bf16(v0[0], v0[1]); w.y = cvt_pk_bf16(v0[2], v0[3]); w.z = cvt_pk_bf16(v1[0], v1[1]); w.w = cvt_pk_bf16(v1[2], v1[3]);
                        *(u32x4*)(gt + (size_t)(((ai * 4 + m) * 2 + bj) * 64) * 8) = w;
                    }
            }
        }
    }
};
struct EpiPlain {
    static constexpr bool PERM = true;
    bf16_t* O; bf16_t* O2; int ldc;
    __device__ __forceinline__ void operator()(const Acc& acc, const Unit& u, int wr, int wc, int fr, int fq) const {
        asm volatile("" : "+v"(fr), "+v"(fq));
        bf16_t* base = O; int pm = u.pm; if (O2 && pm >= 64) { base = O2; pm -= 64; }
        const int row0 = pm * BM + wr * 64 + fr, col0 = u.pn * BM + wc * 32 + 8 * fq;
#pragma unroll
        for (int ai = 0; ai < 2; ++ai)
#pragma unroll
            for (int m = 0; m < 4; ++m) { bf16_t* rowp = base + (size_t)(row0 + ai * HALF + m * 16) * ldc + col0;
#pragma unroll
                for (int bj = 0; bj < 2; ++bj) { const f32x4 v0 = acc[ai][bj][m][0], v1 = acc[ai][bj][m][1];
                    u32x4 w; w.x = cvt_pk_bf16(v0[0], v0[1]); w.y = cvt_pk_bf16(v0[2], v0[3]); w.z = cvt_pk_bf16(v1[0], v1[1]); w.w = cvt_pk_bf16(v1[2], v1[3]);
                    *(u32x4*)(rowp + bj * HALF) = w; } }
    }
};
template <int PASS> struct EpiMerge {
    static constexpr bool PERM = true;
    const bf16_t* G; bf16_t* ytmp; bf16_t* y;
    __device__ __forceinline__ void operator()(const Acc& acc, const Unit& u, int wr, int wc, int fr, int fq) const {
        asm volatile("" : "+v"(fr), "+v"(fq));
        const int lane = fr + 16 * fq, wid = wr * 4 + wc;
        const bf16_t* gt = G + ((size_t)(u.pm * 12 + PASS * 4 + u.pn) * 8192 + (size_t)wid * 1024 + lane) * 8;
        bf16_t* yt = ytmp + ((size_t)(u.pm * 4 + u.pn) * 8192 + (size_t)wid * 1024 + lane) * 8;
        const int row0 = u.pm * BM + wr * 64 + fr, col0 = u.pn * BM + wc * 32 + 8 * fq;
#pragma unroll
        for (int ai = 0; ai < 2; ++ai)
#pragma unroll
            for (int m = 0; m < 4; ++m)
#pragma unroll
                for (int bj = 0; bj < 2; ++bj) {
                    const size_t eo = (size_t)(((ai * 4 + m) * 2 + bj) * 64) * 8;
                    const u32x4 gw = *(const u32x4*)(gt + eo);
                    f32x4 v0 = acc[ai][bj][m][0] * (f32x4){bflo(gw.x), bfhi(gw.x), bflo(gw.y), bfhi(gw.y)}, v1 = acc[ai][bj][m][1] * (f32x4){bflo(gw.z), bfhi(gw.z), bflo(gw.w), bfhi(gw.w)};
                    if (PASS > 0) { const u32x4 o = *(const u32x4*)(yt + eo); v0 += (f32x4){bflo(o.x), bfhi(o.x), bflo(o.y), bfhi(o.y)}; v1 += (f32x4){bflo(o.z), bfhi(o.z), bflo(o.w), bfhi(o.w)}; }
                    u32x4 w; w.x = cvt_pk_bf16(v0[0], v0[1]); w.y = cvt_pk_bf16(v0[2], v0[3]); w.z = cvt_pk_bf16(v1[0], v1[1]); w.w = cvt_pk_bf16(v1[2], v1[3]);
                    if (PASS < 2) *(u32x4*)(yt + eo) = w;
                    else *(u32x4*)(y + (size_t)(row0 + ai * HALF + m * 16) * D + col0 + bj * HALF) = w;
                }
    }
};
struct EpiResid {
    static constexpr bool PERM = true;
    float* X; const float* gates;
    const float* Xin_lat; const float* Xin_ctx;
    __device__ __forceinline__ void operator()(const Acc& acc, const Unit& u, int wr, int wc, int fr, int fq) const {
        asm volatile("" : "+v"(fr), "+v"(fq));
        const int row0 = u.pm * BM + wr * 64 + fr, col0 = u.pn * BM + wc * 32 + 8 * fq;
        const int set = u.pm < 64 ? (u.pm >> 5) : 2;
        const float* gp = gates + set * 6144;
        const float* xin = u.pm < 64 ? Xin_lat + (size_t)row0 * D + col0 : Xin_ctx + (size_t)(row0 - TL) * D + col0;
        f32x4 gv[2][2];
#pragma unroll
        for (int bj = 0; bj < 2; ++bj)
#pragma unroll
            for (int n = 0; n < 2; ++n) gv[bj][n] = *(const f32x4*)(gp + col0 + bj * HALF + n * 4);
#pragma unroll
        for (int ai = 0; ai < 2; ++ai)
#pragma unroll
            for (int m = 0; m < 4; ++m) {
                const size_t ro = (size_t)(ai * HALF + m * 16) * D;
                float* rowp = X + (size_t)row0 * D + col0 + ro;
#pragma unroll
                for (int bj = 0; bj < 2; ++bj)
#pragma unroll
                    for (int n = 0; n < 2; ++n) { *(f32x4*)(rowp + bj * HALF + n * 4) = *(const f32x4*)(xin + ro + bj * HALF + n * 4) + gv[bj][n] * acc[ai][bj][m][n]; }
            }
    }
};
struct EpiCtxPart {
    static constexpr bool PERM = true;
    float* part; const float* gates;
    __device__ __forceinline__ void operator()(const Acc& acc, const Unit& u, int wr, int wc, int fr, int fq) const {
        asm volatile("" : "+v"(fr), "+v"(fq));
        const int row0 = (u.pm - 64) * BM + wr * 64 + fr, col0 = u.pn * BM + wc * 32 + 8 * fq;
        float* pb = part + (size_t)u.e * TC * D;
#pragma unroll
        for (int ai = 0; ai < 2; ++ai)
#pragma unroll
            for (int m = 0; m < 4; ++m) {
                float* rowp = pb + (size_t)(row0 + ai * HALF + m * 16) * D + col0;
#pragma unroll
                for (int bj = 0; bj < 2; ++bj)
#pragma unroll
                    for (int n = 0; n < 2; ++n) *(f32x4*)(rowp + bj * HALF + n * 4) = *(const f32x4*)(gates + col0 + bj * HALF + n * 4) * acc[ai][bj][m][n];
            }
    }
};
struct EpiSwiglu {
    static constexpr bool PERM = false;
    bf16_t* U; int ldu;
    __device__ __forceinline__ void operator()(const Acc& acc, const Unit& u, int wr, int wc, int fr, int fq) const {
        asm volatile("" : "+v"(fr), "+v"(fq));
        const int row0 = u.pm * BM + wr * 64 + fr;
#pragma unroll
        for (int ai = 0; ai < 2; ++ai)
#pragma unroll
            for (int m = 0; m < 4; ++m) {
                bf16_t* rowp = U + (size_t)(row0 + ai * HALF + m * 16) * ldu;
#pragma unroll
                for (int bj = 0; bj < 2; ++bj) {
                    const int gcol = u.pn * BM + bj * HALF + wc * 32;
                    const f32x4 a = acc[ai][bj][m][0], b = acc[ai][bj][m][1];
                    f32x4 o;
#pragma unroll
                    for (int i = 0; i < 4; ++i) o[i] = a[i] * sigmoidf_fast(a[i]) * b[i];
                    u32x2 w; w.x = cvt_pk_bf16(o[0], o[1]); w.y = cvt_pk_bf16(o[2], o[3]);
                    *(u32x2*)(rowp + (gcol >> 1) + 4 * fq) = w;
                }
            }
    }
};
struct EpiMoeDown {
    static constexpr bool PERM = true;
    bf16_t* Y; bf16_t* Y2;
    __device__ __forceinline__ void operator()(const Acc& acc, const Unit& u, int wr, int wc, int fr, int fq) const {
        asm volatile("" : "+v"(fr), "+v"(fq));
        bf16_t* base = u.s ? Y2 + (size_t)(u.pm - 128) * BM * D : Y + (size_t)u.pm * BM * D;
        const int row0 = wr * 64 + fr, col0 = u.pn * BM + wc * 32 + 8 * fq;
#pragma unroll
        for (int ai = 0; ai < 2; ++ai)
#pragma unroll
            for (int m = 0; m < 4; ++m) {
                bf16_t* rowp = base + (size_t)(row0 + ai * HALF + m * 16) * D + col0;
#pragma unroll
                for (int bj = 0; bj < 2; ++bj) { const f32x4 v0 = acc[ai][bj][m][0], v1 = acc[ai][bj][m][1];
                    u32x4 w; w.x = cvt_pk_bf16(v0[0], v0[1]); w.y = cvt_pk_bf16(v0[2], v0[3]); w.z = cvt_pk_bf16(v1[0], v1[1]); w.w = cvt_pk_bf16(v1[2], v1[3]);
                    *(u32x4*)(rowp + bj * HALF) = w; }
            }
    }
};
}

struct Params { const float* in[29]; float* out; unsigned char* ws; };
enum { I_X = 0, I_C, I_CTX, I_CCTX, I_WMOD, I_BMOD, I_GN1, I_WIN, I_BGATE, I_GQ, I_WUQ, I_GKV, I_WUKV, I_WPOOL, I_SPOOL, I_WOA, I_WOB, I_WOC, I_WOUT, I_GN2,
       I_FW1, I_FW3, I_FW2, I_ROUTER, I_RBIAS, I_MW1, I_MW3, I_MW2, I_GFINAL };

struct Ctx {
    LAS unsigned char* lds; int tid, lane, wave, G, bid, gw, ngw;
};

__device__ __forceinline__ Ctx fresh(const Ctx& C0) {
    Ctx C = C0; int w = C0.wave; asm volatile("" : "+s"(w)); int l = (int)__builtin_amdgcn_mbcnt_hi(~0u, __builtin_amdgcn_mbcnt_lo(~0u, 0u)); asm volatile("" : "+v"(l));
    C.wave = w; C.lane = l; C.tid = w * 64 + l; C.gw = C.bid * 8 + w; return C;
}
template <class RowMap>
__device__ __forceinline__ void tr_item(const float* src, int ldn, int k0, int n0, const float* kscale, bf16_t* dst, int dld, int dk0, RowMap rowmap, LAS float* scr, int lane) {
    float v[32];
#pragma unroll
    for (int i = 0; i < 32; ++i) { const int kk = 2 * i + (lane >> 5); v[i] = src[(size_t)(k0 + kk) * ldn + n0 + (lane & 31)]; }
    if (kscale) {
#pragma unroll
        for (int i = 0; i < 32; ++i) v[i] *= kscale[k0 + 2 * i + (lane >> 5)];
    }
#pragma unroll
    for (int i = 0; i < 32; ++i) scr[(2 * i + (lane >> 5)) * 33 + (lane & 31)] = v[i];
    LDS_WAIT(); asm volatile("" ::: "memory");
    const int c = lane & 7;
#pragma unroll
    for (int j = 0; j < 4; ++j) { const int n = (lane >> 3) + 8 * j; const LAS float* s = scr + (8 * c) * 33 + n;
        u32x4 o; o.x = cvt_pk_bf16(s[0 * 33], s[1 * 33]); o.y = cvt_pk_bf16(s[2 * 33], s[3 * 33]); o.z = cvt_pk_bf16(s[4 * 33], s[5 * 33]); o.w = cvt_pk_bf16(s[6 * 33], s[7 * 33]);
        *(u32x4*)(dst + (size_t)rowmap(n0 + n) * dld + dk0 + 8 * c) = o; }
    LDS_WAIT(); asm volatile("" ::: "memory");
}
struct RowId { __device__ __forceinline__ int operator()(int n) const { return n; } };
struct RowWin { __device__ __forceinline__ int operator()(int n) const { return n < OFF_GATE ? n : n + (PP - OFF_GATE); } };
struct RowQ { __device__ __forceinline__ int operator()(int n) const { const int h = n / QKD, d = n % QKD; if (d < 64) return n; const int j = d - 64, a = j >> 4, rh = (j >> 3) & 1, f = j & 7; return h * QKD + 64 + rh * 16 + a * 8 + f; } };
struct RowGU { int add; __device__ __forceinline__ int operator()(int n) const { return 32 * (n >> 4) + (n & 15) + add; } };

__device__ __forceinline__ void norm_row(const float* xrow, const float* g, const float* sh, const float* sc, bf16_t* drow, int lane, f32x4 (&v)[4]) {
    const f32x4* xr = (const f32x4*)xrow + lane;
    float s = 0.f;
#pragma unroll
    for (int j = 0; j < 4; ++j) { v[j] = xr[64 * j]; s += (v[j][0] * v[j][0] + v[j][1] * v[j][1]) + (v[j][2] * v[j][2] + v[j][3] * v[j][3]); }
    const float rstd = __builtin_amdgcn_rsqf(wave_sum(s, lane) * (1.0f / D) + EPS);
#pragma unroll
    for (int j = 0; j < 4; ++j) {
        const f32x4 gg = *((const f32x4*)g + lane + 64 * j), s1 = *((const f32x4*)sc + lane + 64 * j), s0 = *((const f32x4*)sh + lane + 64 * j);
        v[j] = v[j] * rstd * gg * (s1 + 1.0f) + s0;
        u32x2 w; w.x = cvt_pk_bf16(v[j][0], v[j][1]); w.y = cvt_pk_bf16(v[j][2], v[j][3]);
        *((u32x2*)drow + lane + 64 * j) = w;
    }
}
__device__ __forceinline__ void norm_rows(const float* xrow0, int nr, const float* gn, const float* mp, bf16_t* drow0, int lane) {
    f32x4 gsc[4], shv[4], xn[4];
#pragma unroll
    for (int j = 0; j < 4; ++j) { const f32x4 gg = *((const f32x4*)gn + lane + 64 * j), s1 = *((const f32x4*)(mp + 1024) + lane + 64 * j); gsc[j] = gg * (s1 + 1.0f); shv[j] = *((const f32x4*)mp + lane + 64 * j);
        xn[j] = *((const f32x4*)xrow0 + lane + 64 * j); }
#pragma unroll 1
    for (int rr = 0; rr < nr; ++rr) {
        f32x4 v[4];
#pragma unroll
        for (int j = 0; j < 4; ++j) v[j] = xn[j];
        if (rr + 1 < nr) {
#pragma unroll
            for (int j = 0; j < 4; ++j) xn[j] = *((const f32x4*)(xrow0 + (size_t)(rr + 1) * D) + lane + 64 * j);
        }
        float ssx = 0.f;
#pragma unroll
        for (int j = 0; j < 4; ++j) ssx += (v[j][0] * v[j][0] + v[j][1] * v[j][1]) + (v[j][2] * v[j][2] + v[j][3] * v[j][3]);
        const float rstd = __builtin_amdgcn_rsqf(wave_sum(ssx, lane) * (1.0f / D) + EPS);
#pragma unroll
        for (int j = 0; j < 4; ++j) { const f32x4 o = v[j] * rstd * gsc[j] + shv[j]; u32x2 w; w.x = cvt_pk_bf16(o[0], o[1]); w.y = cvt_pk_bf16(o[2], o[3]); *((u32x2*)(drow0 + (size_t)rr * D) + lane + 64 * j) = w; }
    }
}
__device__ __forceinline__ void norm_ctx_row(const float* xsrc, const float* part, int nsl, float* xdst, const float* gn, const float* mp, bf16_t* drow, int lane) {
    f32x4 v[4];
#pragma unroll
    for (int j = 0; j < 4; ++j) v[j] = *((const f32x4*)xsrc + lane + 64 * j);
    for (int s = 0; s < nsl; ++s) {
#pragma unroll
        for (int j = 0; j < 4; ++j) v[j] += *((const f32x4*)(part + (size_t)s * TC * D) + lane + 64 * j);
    }
    float ssx = 0.f;
#pragma unroll
    for (int j = 0; j < 4; ++j) { if (xdst) *((f32x4*)xdst + lane + 64 * j) = v[j]; ssx += (v[j][0] * v[j][0] + v[j][1] * v[j][1]) + (v[j][2] * v[j][2] + v[j][3] * v[j][3]); }
    const float rstd = __builtin_amdgcn_rsqf(wave_sum(ssx, lane) * (1.0f / D) + EPS);
#pragma unroll
    for (int j = 0; j < 4; ++j) { const f32x4 gg = *((const f32x4*)gn + lane + 64 * j), s1 = *((const f32x4*)(mp + 1024) + lane + 64 * j), s0 = *((const f32x4*)mp + lane + 64 * j);
        const f32x4 o = v[j] * rstd * gg * (s1 + 1.0f) + s0; u32x2 w; w.x = cvt_pk_bf16(o[0], o[1]); w.y = cvt_pk_bf16(o[2], o[3]); *((u32x2*)drow + lane + 64 * j) = w; }
}
__device__ __forceinline__ void norm_phase(const Ctx& C, const float* xlat, const float* xctx, const float* gn, const float* mods_l, int which, bf16_t* dst, int nrows, const float* part = nullptr, int nsl = 0, float* xdst = nullptr) {
    for (int ch = C.gw; ch < TL / 8; ch += C.ngw) { const int row = ch * 8; norm_rows(xlat + (size_t)row * D, 8, gn, mods_l + (row >> 13) * 6144 + which * 3072, dst + (size_t)row * D, C.lane); }
    if (nrows > TL) for (int r = C.gw; r < TC; r += C.ngw) {
        if (nsl > 0) norm_ctx_row(xctx + (size_t)r * D, part + (size_t)r * D, nsl, xdst ? xdst + (size_t)r * D : nullptr, gn, mods_l + 2 * 6144 + which * 3072, dst + (size_t)(TL + r) * D, C.lane);
        else norm_rows(xctx + (size_t)r * D, 1, gn, mods_l + 2 * 6144 + which * 3072, dst + (size_t)(TL + r) * D, C.lane);
    }
}

constexpr int FX_LD = 272;
template <class AL, class BL, class EP>
__device__ __forceinline__ void flex_tile(const Ctx& C, int KC, AL aload, BL bload, EP epi) {
    LAS unsigned char* As = C.lds; LAS unsigned char* Bs = C.lds + 128 * FX_LD;
    const int wm = C.wave >> 1, wn = C.wave & 1, r32 = C.lane & 31, hi = C.lane >> 5;
    f32x16 acc[2];
#pragma unroll
    for (int j = 0; j < 2; ++j)
#pragma unroll
        for (int r = 0; r < 16; ++r) acc[j][r] = 0.f;
    for (int kc = 0; kc < KC; kc += 128) {
        __syncthreads();
#pragma unroll
        for (int i = 0; i < 4; ++i) { const int task = C.tid + 512 * i, m = task & 127, c8 = task >> 7;
            const bf16x8 va = aload(m, kc + c8 * 8); *(LAS bf16x8*)(As + m * FX_LD + c8 * 16) = va;
            const bf16x8 vb = bload(m, kc + c8 * 8); *(LAS bf16x8*)(Bs + m * FX_LD + c8 * 16) = vb; }
        __syncthreads();
#pragma unroll
        for (int s = 0; s < 8; ++s) {
            const bf16x8 a = *(const LAS bf16x8*)(As + (32 * wm + r32) * FX_LD + (2 * s + hi) * 16);
#pragma unroll
            for (int j = 0; j < 2; ++j) { const bf16x8 b = *(const LAS bf16x8*)(Bs + (64 * wn + 32 * j + r32) * FX_LD + (2 * s + hi) * 16);
                acc[j] = __builtin_amdgcn_mfma_f32_32x32x16_bf16(b, a, acc[j], 0, 0, 0); }
        }
    }
    const int m = 32 * wm + r32;
#pragma unroll
    for (int j = 0; j < 2; ++j)
#pragma unroll
        for (int r = 0; r < 16; r += 2) epi(m, 64 * wn + 32 * j + crow(r, hi), acc[j][r], acc[j][r + 1]);
}
template <class AL, class BL, class EP>
__device__ __forceinline__ void flex_tile_n256(const Ctx& C, AL aload, BL bload, EP epi) {
    LAS unsigned char* As = C.lds; LAS unsigned char* Bs = C.lds + 128 * FX_LD;
    const int wm = C.wave >> 1, wn = C.wave & 1, r32 = C.lane & 31, hi = C.lane >> 5;
    f32x16 acc[4];
#pragma unroll
    for (int j = 0; j < 4; ++j)
#pragma unroll
        for (int r = 0; r < 16; ++r) acc[j][r] = 0.f;
    __syncthreads();
#pragma unroll
    for (int i = 0; i < 4; ++i) { const int task = C.tid + 512 * i, m = task & 127, c8 = task >> 7;
        const bf16x8 va = aload(m, c8 * 8); *(LAS bf16x8*)(As + m * FX_LD + c8 * 16) = va; }
#pragma unroll
    for (int i = 0; i < 8; ++i) { const int task = C.tid + 512 * i, n = task & 255, c8 = task >> 8;
        const bf16x8 vb = bload(n, c8 * 8); *(LAS bf16x8*)(Bs + n * FX_LD + c8 * 16) = vb; }
    __syncthreads();
#pragma unroll
    for (int s = 0; s < 8; ++s) {
        const bf16x8 a = *(const LAS bf16x8*)(As + (32 * wm + r32) * FX_LD + (2 * s + hi) * 16);
#pragma unroll
        for (int j = 0; j < 4; ++j) { const bf16x8 b = *(const LAS bf16x8*)(Bs + (128 * wn + 32 * j + r32) * FX_LD + (2 * s + hi) * 16);
            acc[j] = __builtin_amdgcn_mfma_f32_32x32x16_bf16(b, a, acc[j], 0, 0, 0); }
    }
    const int m = 32 * wm + r32;
#pragma unroll
    for (int j = 0; j < 4; ++j)
#pragma unroll
        for (int r = 0; r < 16; r += 2) epi(m, 128 * wn + 32 * j + crow(r, hi), acc[j][r], acc[j][r + 1]);
}
__device__ __forceinline__ bf16x8 gather8(const bf16_t* p, size_t ld) {
    bf16x8 v;
#pragma unroll
    for (int t = 0; t < 8; ++t) v[t] = (short)p[(size_t)t * ld];
    return v;
}

struct TT { static constexpr bool value = true; }; struct FF { static constexpr bool value = false; };
constexpr int AT_KT = 128;
constexpr int NTILE = NKEY / AT_KT;
constexpr int AT_KB = AT_KT * QKD * 2, AT_VB = 64 * AT_KT * 2, AT_VOFF = 2 * AT_KB;
__device__ __forceinline__ void attn_unit(const Ctx& C, const bf16_t* Q, const bf16_t* Kb, const bf16_t* Vt, bf16_t* O, const float* ssqp, const float* ropep, int b, int h, int qrow0, int NT) {
    const int tid = C.tid, lane = C.lane, wid = C.wave, r32 = lane & 31, hi = lane >> 5;
    LAS unsigned char* L = C.lds;
    const bf16_t* Kh = Kb + (size_t)(b * NH + h) * NKEY * QKD;
    const bf16_t* Vh = Vt + (size_t)(b * NH + h) * VD * NKEY;
    const int qrow = qrow0 + wid * 32 + r32;
    bf16x8 qr[6];
    { const bf16_t* qp = Q + (size_t)qrow * 768 + h * QKD + hi * 8;
      u32x4 raw[6];
#pragma unroll
      for (int s = 0; s < 6; ++s) raw[s] = *(const u32x4*)(qp + 16 * s);
      float rq;
      { const float* sp = ssqp + (size_t)qrow * 20; const f32x4 a = *(const f32x4*)sp, b2 = *(const f32x4*)(sp + 4), c = *(const f32x4*)(sp + 8);
        rq = __builtin_amdgcn_rsqf((((a[0] + a[1]) + (a[2] + a[3])) + ((b2[0] + b2[1]) + (b2[2] + b2[3])) + ((c[0] + c[1]) + (c[2] + c[3]))) * (1.0f / QL) + EPS) * QSCALE; }
#pragma unroll
      for (int s = 0; s < 4; ++s) { u32x4 o; const unsigned wv[4] = {raw[s].x, raw[s].y, raw[s].z, raw[s].w}; unsigned ov[4];
#pragma unroll
          for (int q = 0; q < 4; ++q) ov[q] = cvt_pk_bf16(bflo(wv[q]) * rq, bfhi(wv[q]) * rq);
          o.x = ov[0]; o.y = ov[1]; o.z = ov[2]; o.w = ov[3]; qr[s] = __builtin_bit_cast(bf16x8, o); }
      float cs[8], sn[8];
      if (qrow < TL) { const int l = qrow & (SEQ - 1), pos = hi ? (l & 63) : (l >> 6); const float* rp = ropep + pos * 16;
#pragma unroll
          for (int q = 0; q < 4; ++q) { const f32x4 t = *(const f32x4*)(rp + 4 * q); cs[2 * q] = t[0]; sn[2 * q] = t[1]; cs[2 * q + 1] = t[2]; sn[2 * q + 1] = t[3]; } }
      else {
#pragma unroll
          for (int j = 0; j < 8; ++j) { cs[j] = 1.f; sn[j] = 0.f; } }
      const unsigned w1[4] = {raw[4].x, raw[4].y, raw[4].z, raw[4].w}, w2[4] = {raw[5].x, raw[5].y, raw[5].z, raw[5].w}; unsigned o1[4], o2[4];
#pragma unroll
      for (int q = 0; q < 4; ++q) { const float a0 = bflo(w1[q]), a1 = bfhi(w1[q]), b0 = bflo(w2[q]), b1 = bfhi(w2[q]);
          o1[q] = cvt_pk_bf16((a0 * cs[2 * q] - b0 * sn[2 * q]) * rq, (a1 * cs[2 * q + 1] - b1 * sn[2 * q + 1]) * rq);
          o2[q] = cvt_pk_bf16((b0 * cs[2 * q] + a0 * sn[2 * q]) * rq, (b1 * cs[2 * q + 1] + a1 * sn[2 * q + 1]) * rq); }
      qr[4] = __builtin_bit_cast(bf16x8, ((u32x4){o1[0], o1[1], o1[2], o1[3]})); qr[5] = __builtin_bit_cast(bf16x8, ((u32x4){o2[0], o2[1], o2[2], o2[3]})); }
    auto stage = [&](const int tn) {
        const int buf = tn & 1;
#pragma unroll
        for (int i = 0; i < 5; ++i) {
            const int q = wid * 5 + i;
            if (q < 24) __builtin_amdgcn_global_load_lds((const unsigned*)((const char*)Kh + (size_t)tn * AT_KB + q * 1024 + lane * 16), (LAS unsigned*)(L + buf * AT_KB + q * 1024), 16, 0, 0);
            else __builtin_amdgcn_global_load_lds((const unsigned*)((const char*)Vh + (size_t)tn * AT_VB + (q - 24) * 1024 + lane * 16), (LAS unsigned*)(L + AT_VOFF + buf * AT_VB + (q - 24) * 1024), 16, 0, 0);
        }
    };
    __syncthreads();
    stage(0);
    VM_WAIT();
    __syncthreads();
    constexpr float ATHR = 8.0f;
    float mrun = 0.f, lsum = 0.f;
    f32x16 o0, o1, negm;
#pragma unroll
    for (int r = 0; r < 16; ++r) { o0[r] = 0.f; o1[r] = 0.f; negm[r] = 0.f; }
    auto tile = [&](const int t, auto first) {
        constexpr bool FIRST = decltype(first)::value;
        const int buf = t & 1;
        const bool more = (t + 1 < NT);
        if (more) stage(t + 1);
        const LAS unsigned char* Kt = L + buf * AT_KB; const LAS unsigned char* Vtile = L + AT_VOFF + buf * AT_VB;
        f32x16 p[4];
#pragma unroll
        for (int kb = 0; kb < 4; ++kb)
#pragma unroll
            for (int s = 0; s < 6; ++s) {
                const bf16x8 kf = *(const LAS bf16x8*)(Kt + (2 * s + hi) * 2048 + (32 * kb + r32) * 16);
                p[kb] = __builtin_amdgcn_mfma_f32_32x32x16_bf16(kf, qr[s], s == 0 ? negm : p[kb], 0, 0, 0);
            }
        float mx = fmaxf(fmaxf(p[0][0], p[0][1]), p[0][2]);
#pragma unroll
        for (int kb = 0; kb < 4; ++kb)
#pragma unroll
            for (int r = (kb == 0 ? 3 : 0); r + 1 < 16 + (kb == 0 ? 1 : 0); r += 2) { if (r + 1 < 16) mx = fmaxf(fmaxf(mx, p[kb][r]), p[kb][r + 1]); else mx = fmaxf(mx, p[kb][r]); }
        if constexpr (FIRST) {
            if (__any(mx < -64.0f)) {
                mx = fmaxf(mx, shx(mx, 32, lane)); const float dl = fminf(mx, 0.f); mrun = dl;
#pragma unroll
                for (int kb = 0; kb < 4; ++kb)
#pragma unroll
                    for (int r = 0; r < 16; ++r) p[kb][r] -= dl;
#pragma unroll
                for (int r = 0; r < 16; ++r) negm[r] = -dl;
                mx -= dl;
            }
        }
        if (__any(mx > ATHR)) {
            mx = fmaxf(mx, shx(mx, 32, lane));
            const float dl = fmaxf(mx, 0.f); mrun += dl;
            const float alpha = __builtin_amdgcn_exp2f(-dl);
            lsum *= alpha;
#pragma unroll
            for (int kb = 0; kb < 4; ++kb)
#pragma unroll
                for (int r = 0; r < 16; ++r) p[kb][r] -= dl;
#pragma unroll
            for (int r = 0; r < 16; ++r) { o0[r] *= alpha; o1[r] *= alpha; negm[r] = -mrun; }
        }
        bf16x8 pf[8];
        { f32x2 sa = (f32x2){0.f, 0.f};
#pragma unroll
          for (int kb = 0; kb < 4; ++kb) {
#pragma unroll
              for (int r = 0; r < 16; ++r) p[kb][r] = __builtin_amdgcn_exp2f(p[kb][r]);
#pragma unroll
              for (int r = 0; r < 16; r += 2) sa += (f32x2){p[kb][r], p[kb][r + 1]};
#pragma unroll
              for (int s2 = 0; s2 < 2; ++s2) { u32x4 w; w.x = cvt_pk_bf16(p[kb][8 * s2 + 0], p[kb][8 * s2 + 1]); w.y = cvt_pk_bf16(p[kb][8 * s2 + 2], p[kb][8 * s2 + 3]); w.z = cvt_pk_bf16(p[kb][8 * s2 + 4], p[kb][8 * s2 + 5]); w.w = cvt_pk_bf16(p[kb][8 * s2 + 6], p[kb][8 * s2 + 7]);
                  pf[2 * kb + s2] = __builtin_bit_cast(bf16x8, w); }
          }
          lsum += sa[0] + sa[1]; }
#pragma unroll
        for (int st = 0; st < 8; ++st) {
            { const bf16x8 vf = *(const LAS bf16x8*)(Vtile + (2 * st + hi) * 1024 + r32 * 16);
              o0 = __builtin_amdgcn_mfma_f32_32x32x16_bf16(vf, pf[st], o0, 0, 0, 0); }
            { const bf16x8 vf = *(const LAS bf16x8*)(Vtile + (2 * st + hi) * 1024 + (32 + r32) * 16);
              o1 = __builtin_amdgcn_mfma_f32_32x32x16_bf16(vf, pf[st], o1, 0, 0, 0); }
        }
        VM_WAIT();
        __syncthreads();
    };
    tile(0, TT{});
    for (int t = 1; t < NT; ++t) tile(t, FF{});
    lsum += shx(lsum, 32, lane);
    const float inv = __builtin_amdgcn_rcpf(lsum);
    bf16_t* op = O + (size_t)qrow * 512 + h * VD + 4 * hi;
#pragma unroll
    for (int g = 0; g < 4; ++g) {
        u32x2 w0, w1;
        w0.x = cvt_pk_bf16(o0[4 * g] * inv, o0[4 * g + 1] * inv); w0.y = cvt_pk_bf16(o0[4 * g + 2] * inv, o0[4 * g + 3] * inv);
        w1.x = cvt_pk_bf16(o1[4 * g] * inv, o1[4 * g + 1] * inv); w1.y = cvt_pk_bf16(o1[4 * g + 2] * inv, o1[4 * g + 3] * inv);
        *(u32x2*)(op + 8 * g) = w0; *(u32x2*)(op + 32 + 8 * g) = w1;
    }
}

#ifndef PH
#define PH 0xFFFFFFFFu
#endif
#define PHON(k) ((PH >> (k)) & 1u)
#define PHASE_WS size_t wso_ = 0; asm volatile("" : "+s"(wso_)); unsigned char* ws = ws0 + wso_;
#define PHASE_CTX PHASE_WS const Ctx& Cb_ = C; const Ctx C = fresh(Cb_);

#ifndef DBG
#define DBG 0
#endif
constexpr int CW_DBG = 64;
__device__ __forceinline__ void dbg_scan(const Ctx& C, unsigned char* ws, const void* p, size_t nbytes, bool isf32, int id) {
#if DBG
    const size_t n16 = nbytes / 16; bool bad = false;
    for (size_t i = (size_t)C.bid * 512 + C.tid; i < n16; i += (size_t)C.G * 512) {
        const u32x4 v = ((const u32x4*)p)[i]; const unsigned w[4] = {v.x, v.y, v.z, v.w};
#pragma unroll
        for (int q = 0; q < 4; ++q) { if (isf32) bad |= ((w[q] & 0x7F800000u) >= (145u << 23)); else bad |= ((w[q] & 0x7F80u) >= (145u << 7)) || ((w[q] & 0x7F800000u) >= (145u << 23)); }
    }
    if (bad) atomicMax((unsigned*)(ws + WS_CTL) + CW_DBG, (unsigned)(100 - id));
#endif
}
__device__ __forceinline__ void dbg_max(const Ctx& C, unsigned char* ws, const void* p, size_t nbytes, int slot) {
    const size_t n16 = nbytes / 16; unsigned mx = 0u;
    for (size_t i = (size_t)C.bid * 512 + C.tid; i < n16; i += (size_t)C.G * 512) {
        const u32x4 v = ((const u32x4*)p)[i]; const unsigned w[4] = {v.x, v.y, v.z, v.w};
#pragma unroll
        for (int q = 0; q < 4; ++q) { const unsigned a = (w[q] & 0x7FFFu) << 16, b = w[q] & 0x7FFF0000u; mx = a > mx ? a : mx; mx = b > mx ? b : mx; }
    }
    if (mx > 0x7E000000u) mx = 0x7E000000u;
    atomicMax((unsigned*)(ws + WS_CTL) + CW_DBG + 1 + slot, mx);
}
#define DBGMAX(p, nbytes, slot) do { if (DBG) { PHASE_CTX dbg_max(C, ws, (p), (nbytes), (slot)); } } while (0)
#define DBGSCAN(p, nbytes, isf32, id) do { if (DBG) { PHASE_CTX dbg_scan(C, ws, (p), (nbytes), (isf32), (id)); } } while (0)
#define GRID_BAR() xcd_barrier(bar, C.wave)
#define mods ((float*)(ws + WS_MODS))
#define ropet ((float*)(ws + WS_ROPE))
#define twt ((float*)(ws + WS_TW))
#define dft128 ((bf16_t*)(ws + WS_DFT128))
#define m64 ((bf16_t*)(ws + WS_M64))
#define dft256 ((bf16_t*)(ws + WS_DFT256))
#define ssq ((float*)(ws + WS_SSQ))
#define xw ((float*)(ws + WS_XW))
#define Pb ((bf16_t*)(ws + WS_P))
#define Gt ((bf16_t*)(ws + WS_G))
#define A1 ((bf16_t*)(ws + WS_A1))
#define Qb ((bf16_t*)(ws + WS_Q))
#define Kb ((bf16_t*)(ws + WS_K))
#define Vtb ((bf16_t*)(ws + WS_VT))
#define ytmp ((float*)(ws + WS_A2))
#define AO ((bf16_t*)(ws + WS_AO))
#define MIXb ((bf16_t*)(ws + WS_MIX))
#define YY ((bf16_t*)(ws + WS_YY))
template <int layer>
__device__ __forceinline__ void layer_body(const Ctx& C, const Params& prm, unsigned char* ws0, const XcdBarrier& bar) {
    constexpr bool last = (layer == 1);
        const int nrt = last ? 64 : 66;
#define mods_l (mods + (size_t)layer * 3 * 6144)
#define lw (ws + WS_PERM + (size_t)layer * LW_SIZE)
        if (PHON(2)) { PHASE_WS
            pg8::Gemm g{A1, (const bf16_t*)(lw + LW_IN), 1024, 1024, 1024, 0};
            pg8::GridOrder S; S.init(nrt, NIN / 256, C.G, C.bid);
            if (last) { S.xm0 = 64; S.xn0 = 1; S.xnm = 2; S.nX = 4; }
            pg8::EpiWin E{Pb, Gt, prm.in[I_BGATE] + layer * 3072, ssq};
            pg8::gemm_phase<pg8::EpiWin, pg8::GridOrder, true>(C.lds, g, S, E, C.wave);
        }
        GRID_BAR();
        DBGSCAN(Pb, (size_t)nrt * 256 * NIN * 2, false, 15 * layer + 3); DBGSCAN(ssq, (size_t)nrt * 256 * 20 * 4, true, 15 * layer + 3);
        {
            if (PHON(3)) { PHASE_WS pg8::Gemm g{Pb, (const bf16_t*)(lw + LW_UQ), PP, QL, QL, 0};
              pg8::GridOrder S; S.init(nrt, 3, C.G, C.bid);
              pg8::EpiPlain E{Qb, nullptr, 768};
              pg8::gemm_phase<pg8::EpiPlain, pg8::GridOrder, true>(C.lds, g, S, E, C.wave); }
            if (PHON(4)) { PHASE_CTX
              pg8::Gemm g{Pb + OFF_KV, (const bf16_t*)(lw + LW_UKV), PP, KVL, KVL, 0};
              pg8::GridOrder S; S.init(66, 4, C.G, (C.bid + C.G / 2) % C.G);
              pg8::EpiPlain E{YY, AO, 1024};
              pg8::gemm_phase<pg8::EpiPlain, pg8::GridOrder, true>(C.lds, g, S, E, C.wave);
              VM_WAIT(); __syncthreads();
              pg8::Unit u;
              for (int i = 0; S.next(i, u); ++i) {
                  const bool lat = u.pm < 64;
                  const int bb = lat ? (u.pm >> 5) : (u.pm - 64), key0 = lat ? (NCTX + (u.pm & 31) * 256) : 0;
                  const int row = C.tid >> 1, hh = C.tid & 1, grow = u.pm * 256 + row;
                  const bf16_t* rawrow = (lat ? YY + (size_t)grow * 1024 : AO + (size_t)(grow - TL) * 1024) + u.pn * 256 + hh * 128;
                  float r;
                  { const float* sp = ssq + (size_t)grow * 20 + 12; const f32x4 a = *(const f32x4*)sp, b = *(const f32x4*)(sp + 4);
                    r = __builtin_amdgcn_rsqf((((a[0] + a[1]) + (a[2] + a[3])) + ((b[0] + b[1]) + (b[2] + b[3]))) * (1.0f / KVL) + EPS); }
                  const int h = u.pn * 2 + hh;
                  { const int key = key0 + row;
                    bf16_t* kdst = Kb + ((size_t)((bb * NH + h) * NTILE + (key >> 7)) * 12) * 1024 + (key & 127) * 8;
#pragma unroll
                    for (int c = 0; c < 8; ++c) { const u32x4 v = *(const u32x4*)(rawrow + 8 * c); u32x4 o;
                        o.x = cvt_pk_bf16(bflo(v.x) * r, bfhi(v.x) * r); o.y = cvt_pk_bf16(bflo(v.y) * r, bfhi(v.y) * r); o.z = cvt_pk_bf16(bflo(v.z) * r, bfhi(v.z) * r); o.w = cvt_pk_bf16(bflo(v.w) * r, bfhi(v.w) * r);
                        *(u32x4*)(kdst + 1024 * c) = o; } }
                  constexpr int VSLD = 528;
#pragma unroll 1
                  for (int hv = 0; hv < 2; ++hv) {
                      __syncthreads();
                      { const bf16_t* vr = rawrow - hh * 128 + hv * 128 + 64 + hh * 32;
#pragma unroll
                        for (int c = 0; c < 4; ++c) { const u32x4 v = *(const u32x4*)(vr + 8 * c); const unsigned wv[4] = {v.x, v.y, v.z, v.w};
#pragma unroll
                            for (int q = 0; q < 4; ++q) { const unsigned pk = cvt_pk_bf16(bflo(wv[q]) * r, bfhi(wv[q]) * r); const int d = hh * 32 + c * 8 + q * 2;
                                *(LAS bf16_t*)(C.lds + d * VSLD + row * 2) = (bf16_t)(pk & 0xffffu); *(LAS bf16_t*)(C.lds + (d + 1) * VSLD + row * 2) = (bf16_t)(pk >> 16); } } }
                      __syncthreads();
                      { const int d = C.tid & 63, grp = C.tid >> 6;
#pragma unroll
                        for (int c = 0; c < 4; ++c) { const int jj = grp * 4 + c, kb16 = (jj >> 1) * 16, half = jj & 1, key = key0 + kb16;
                            const u32x2 lo = *(const LAS u32x2*)(C.lds + d * VSLD + (kb16 + 4 * half) * 2), h4 = *(const LAS u32x2*)(C.lds + d * VSLD + (kb16 + 8 + 4 * half) * 2);
                            bf16_t* vdst = Vtb + ((size_t)((bb * NH + u.pn * 2 + hv) * NTILE + (key >> 7)) * 16 + 2 * ((key >> 4) & 7) + half) * 512 + d * 8;
                            *(u32x4*)vdst = (u32x4){lo.x, lo.y, h4.x, h4.y}; } }
                  }
                  __syncthreads();
              } }
            if (PHON(5)) { PHASE_CTX for (int row = C.gw; row < T; row += C.ngw) {
                const bool lat = row < TL;
                const int t = lat ? (row & (SEQ - 1)) : ((row - TL) & 255), Ls = lat ? SEQ : NCTX;
                if (lat || !last) {
                    const int g = C.lane >> 4, w = 2 << g, left = w >> 1, right = w - 1 - left;
                    const int lo = max(t - left, 0), hiE = min(t + right + 1, Ls);
                    float s[8] = {0.f, 0.f, 0.f, 0.f, 0.f, 0.f, 0.f, 0.f};
                    const bf16_t* base = Pb + (size_t)(row - t) * PP + OFF_POOL + C.lane * 8;
                    u32x4 wv[16];
#pragma unroll
                    for (int j = 0; j < 16; ++j) { const int tt = t + j - 8; wv[j] = (tt >= lo && tt < hiE) ? *(const u32x4*)(base + (size_t)tt * PP) : (u32x4){0u, 0u, 0u, 0u}; }
#pragma unroll
                    for (int j = 0; j < 16; ++j) { const u32x4 v = wv[j];
                        s[0] += bflo(v.x); s[1] += bfhi(v.x); s[2] += bflo(v.y); s[3] += bfhi(v.y); s[4] += bflo(v.z); s[5] += bfhi(v.z); s[6] += bflo(v.w); s[7] += bfhi(v.w); }
                    const u32x4 me = wv[8];
                    const float ic = 1.0f / (float)(hiE - lo);
                    u32x4 o; o.x = cvt_pk_bf16(s[0] * ic - bflo(me.x), s[1] * ic - bfhi(me.x)); o.y = cvt_pk_bf16(s[2] * ic - bflo(me.y), s[3] * ic - bfhi(me.y));
                    o.z = cvt_pk_bf16(s[4] * ic - bflo(me.z), s[5] * ic - bfhi(me.z)); o.w = cvt_pk_bf16(s[6] * ic - bflo(me.w), s[7] * ic - bfhi(me.w));
                    *(u32x4*)(MIXb + (size_t)row * 512 + C.lane * 8) = o;
                }
                if (C.lane < 16) {
                    const int a = C.lane >> 3, f = C.lane & 7;
                    const float x1 = bf2f(Pb[(size_t)row * PP + OFF_KR + a * 16 + f]), x2 = bf2f(Pb[(size_t)row * PP + OFF_KR + a * 16 + 8 + f]);
                    float cs = 1.f, sn = 0.f;
                    if (lat) { const int pos = a ? (t & 63) : (t >> 6); cs = ropet[(pos * 8 + f) * 2]; sn = ropet[(pos * 8 + f) * 2 + 1]; }
                    const bf16_t o1 = f2bf(x1 * cs - x2 * sn), o2 = f2bf(x2 * cs + x1 * sn);
                    const int bb = lat ? (row >> 13) : ((row - TL) >> 8), key = lat ? (NCTX + t) : t;
#pragma unroll
                    for (int h = 0; h < NH; ++h) { bf16_t* kp = Kb + ((size_t)((bb * NH + h) * NTILE + (key >> 7)) * 12 + 8 + a) * 1024 + (key & 127) * 8 + f; kp[0] = o1; kp[2048] = o2; }
                }
            } }
            if (PHON(6)) { PHASE_CTX for (int un = C.bid; un < 512; un += C.G) {
                const int cch = un & 3, l2 = (un >> 2) & 63, b = un >> 8;
                const bf16_t* src = Pb + (size_t)(b * SEQ + l2) * PP + OFF_FFT + cch * 128;
                flex_tile_n256(C,
                    [&](int m, int k) { return gather8(src + (size_t)k * 64 * PP + m, (size_t)64 * PP); },
                    [&](int n, int k) { return *(const bf16x8*)(dft128 + (size_t)n * 128 + k); },
                    [&](int m, int n, float re, float im) {
                        const int k1 = n >> 1; const float tc = twt[(k1 * 64 + l2) * 2], ts = twt[(k1 * 64 + l2) * 2 + 1];
                        bf16_t* dp = A1 + ((size_t)((b * 128 + k1) * 64 + l2) * 2) * 512 + cch * 128 + m;
                        dp[0] = f2bf(re * tc + im * ts); dp[512] = f2bf(im * tc - re * ts); });
            } }
            if (PHON(7) && !last) { PHASE_CTX for (int un = C.bid; un < 32; un += C.G) {
                const int nch = un & 3, cch = (un >> 2) & 3, b = un >> 4;
                const bf16_t* src = Pb + (size_t)(TL + b * NCTX) * PP + OFF_FFT + cch * 128;
                flex_tile(C, 256,
                    [&](int m, int k) { return gather8(src + (size_t)k * PP + m, (size_t)PP); },
                    [&](int n, int k) { return *(const bf16x8*)(dft256 + (size_t)(nch * 128 + n) * 256 + k); },
                    [&](int m, int n, float re, float im) {
                        const int kf = (nch * 128 + n) >> 1;
                        bf16_t* dp = YY + (size_t)(TL + b * NCTX + kf) * 1024 + cch * 256 + m;
                        dp[0] = f2bf(re * 5.656854249f); dp[128] = f2bf(im * 5.656854249f); });
            } }
        }
        GRID_BAR();
        DBGSCAN(Qb, (size_t)nrt * 256 * 768 * 2, false, 15 * layer + 4); DBGSCAN(Kb, (size_t)NB * NH * NKEY * QKD * 2, false, 15 * layer + 4); DBGSCAN(Vtb, (size_t)NB * NH * VD * NKEY * 2, false, 15 * layer + 4);
        DBGSCAN(MIXb, (size_t)nrt * 256 * 512 * 2, false, 15 * layer + 5); DBGSCAN(A1, (size_t)TL * 1024 * 2, false, 15 * layer + 5); if (!last) DBGSCAN(YY + (size_t)TL * 1024, (size_t)TC * 1024 * 2, false, 15 * layer + 5);
        {
            if (PHON(8)) { PHASE_CTX for (int un = C.bid; un < 1024; un += C.G) {
                const int cch = un & 3, k1 = (un >> 2) & 127, b = un >> 9;
                const bf16_t* src = A1 + (size_t)((b * 128 + k1) * 128) * 512 + cch * 128;
                flex_tile(C, 128,
                    [&](int m, int k) { return gather8(src + (size_t)k * 512 + m, (size_t)512); },
                    [&](int n, int k) { return *(const bf16x8*)(m64 + (size_t)n * 128 + k); },
                    [&](int m, int n, float yr, float yi) {
                        const int k2 = n >> 1;
                        bf16_t* dp = YY + (size_t)(b * SEQ + k1 + 128 * k2) * 1024 + cch * 256 + m;
                        dp[0] = f2bf(yr); dp[128] = f2bf(yi); });
            } }
            __syncthreads();
            const int vcu = (C.G % 8 == 0) ? (C.bid % 8) * (C.G / 8) + C.bid / 8 : C.bid;
            if (PHON(9)) { PHASE_CTX for (int un = vcu; un < 512; un += C.G) { const int bh = un >> 5, qb = un & 31; attn_unit(C, Qb, Kb, Vtb, AO, ssq, ropet, bh >> 3, bh & 7, (bh >> 3) * SEQ + qb * 256, NKEY / AT_KT); } }
            if (PHON(9) && !last) { PHASE_CTX for (int un = C.bid; un < 16; un += C.G) { const int b = un >> 3, h = un & 7; attn_unit(C, Qb, Kb, Vtb, AO, ssq, ropet, b, h, TL + b * NCTX, NCTX / AT_KT); } }
            __syncthreads();
        }
        GRID_BAR();
        DBGSCAN(AO, (size_t)nrt * 256 * 512 * 2, false, 15 * layer + 13); DBGSCAN(YY, (size_t)nrt * 256 * 1024 * 2, false, 15 * layer + 6);
        {
            pg8::GridOrder S; S.init(nrt, 4, C.G, C.bid);
            if (PHON(10)) { PHASE_WS pg8::Gemm g{AO, (const bf16_t*)(lw + LW_OA), 512, 512, 512, 0}; pg8::EpiMerge<0> E{Gt, (bf16_t*)ytmp, A1};
              pg8::gemm_phase<pg8::EpiMerge<0>, pg8::GridOrder, true>(C.lds, g, S, E, C.wave); }
            if (PHON(11)) { PHASE_WS pg8::Gemm g{MIXb, (const bf16_t*)(lw + LW_PB), 512, 512, 512, 0}; pg8::EpiMerge<1> E{Gt, (bf16_t*)ytmp, A1};
              pg8::gemm_phase<pg8::EpiMerge<1>, pg8::GridOrder, true>(C.lds, g, S, E, C.wave); }
            if (PHON(12)) { PHASE_WS pg8::Gemm g{YY, (const bf16_t*)(lw + LW_FC), 1024, 1024, 1024, 0}; pg8::EpiMerge<2> E{Gt, (bf16_t*)ytmp, A1};
              pg8::gemm_phase<pg8::EpiMerge<2>, pg8::GridOrder, true>(C.lds, g, S, E, C.wave); }
        }
        GRID_BAR();
        DBGSCAN(A1, (size_t)nrt * 256 * 1024 * 2, false, 15 * layer + 7);
        if (PHON(13)) { PHASE_WS
            { pg8::Gemm g{A1, (const bf16_t*)(lw + LW_OUT), 1024, 1024, 1024, 0};
              pg8::GridOrder S; S.init(64, 4, C.G, C.bid);
              pg8::EpiResid E{xw, mods_l + 2 * 1024, last ? (const float*)xw : prm.in[I_X], xw + (size_t)TL * D};
              pg8::gemm_phase<pg8::EpiResid, pg8::GridOrder, true>(C.lds, g, S, E, C.wave); }
            if (!last) { pg8::Gemm g{A1, (const bf16_t*)(lw + LW_OUT), 1024, 1024, 256, 512, 512};
              pg8::CtxSplitOrder S{4, C.G, (C.bid + 128) % C.G};
              pg8::EpiCtxPart E{ytmp, mods_l + 2 * 6144 + 2 * 1024};
              pg8::gemm_phase<pg8::EpiCtxPart, pg8::CtxSplitOrder, true>(C.lds, g, S, E, C.wave); }
        }
        GRID_BAR();
        DBGSCAN(xw, (size_t)T * 1024 * 4, true, 15 * layer + 8);
        if (!last) {
            if (PHON(14)) { PHASE_CTX norm_phase(C, xw, prm.in[I_CTX], prm.in[I_GN2] + layer * D, mods_l, 1, A1, T, ytmp, 4, xw + (size_t)TL * D); }
            GRID_BAR();
            DBGSCAN(A1, (size_t)T * 1024 * 2, false, 15 * layer + 9);
            if (PHON(15)) { PHASE_WS
                pg8::Gemm g{A1, (const bf16_t*)(ws + WS_FFN13), 1024, 1024, 1024, 0};
                pg8::GridOrder S; S.init(66, 22, C.G, C.bid);
                pg8::EpiSwiglu E{(bf16_t*)(ws + WS_U), DFF};
                pg8::gemm_phase<pg8::EpiSwiglu, pg8::GridOrder, true>(C.lds, g, S, E, C.wave);
            }
            GRID_BAR();
            DBGSCAN(ws + WS_U, (size_t)T * DFF * 2, false, 15 * layer + 10);
            if (PHON(16)) { PHASE_WS
                { pg8::Gemm g{(const bf16_t*)(ws + WS_U), (const bf16_t*)(ws + WS_FFN2), DFF, DFF, DFF, 0};
                  pg8::GridOrder S; S.init(64, 4, C.G, C.bid);
                  pg8::EpiResid E{xw, mods_l + 5 * 1024, xw, xw + (size_t)TL * D};
                  pg8::gemm_phase<pg8::EpiResid, pg8::GridOrder, true>(C.lds, g, S, E, C.wave); }
                { pg8::Gemm g{(const bf16_t*)(ws + WS_U), (const bf16_t*)(ws + WS_FFN2), DFF, DFF, 256, 512, 512};
                  pg8::CtxSplitOrder S{11, C.G, (C.bid + 128) % C.G};
                  pg8::EpiCtxPart E{ytmp, mods_l + 2 * 6144 + 5 * 1024};
                  pg8::gemm_phase<pg8::EpiCtxPart, pg8::CtxSplitOrder, true>(C.lds, g, S, E, C.wave); }
            }
            GRID_BAR();
            DBGSCAN(xw, (size_t)T * 1024 * 4, true, 15 * layer + 11);
            if (PHON(17)) { PHASE_CTX norm_phase(C, xw, xw + (size_t)TL * D, prm.in[I_GN1] + D, mods + (size_t)3 * 6144, 0, A1, T, ytmp, 11, nullptr); }
            GRID_BAR();
        } else {
#define route_e ((int*)(ws + WS_ROUTE_E))
#define route_w ((float*)(ws + WS_ROUTE_W))
#define tokslot ((int*)(ws + WS_TOKSLOT))
#define blkcnt ((int*)(ws + WS_BLKCNT))
#define h2m ((bf16_t*)(ws + WS_H2M))
#define h2g ((bf16_t*)(ws + WS_H2G))
#define uf ((bf16_t*)(ws + WS_UF))
#define yx2 ((bf16_t*)(ws + WS_YX2))
#define yexp ((bf16_t*)(ws + WS_YEXP))
            LAS int* tile_e = (LAS int*)(C.lds + TILE_E_OFF);
            LAS int* sc_i = (LAS int*)(C.lds + SCR_OFF);
            if (PHON(18)) { PHASE_CTX
                LAS float* wscr = (LAS float*)(C.lds + C.wave * 8448);
                const float* wrt = prm.in[I_ROUTER]; const float* rb = prm.in[I_RBIAS];
                for (int blk = C.bid; blk < 256; blk += C.G) {
                    const int rowb = blk * 64 + C.wave * 8, set = rowb >> 13;
                    const float* mp = mods_l + set * 6144 + 3072; const float* gn = prm.in[I_GN2] + D;
                    f32x4 gsc[4], shv[4]; float wreg[4][4][8];
#pragma unroll
                    for (int j = 0; j < 4; ++j) { const f32x4 gg = *((const f32x4*)gn + C.lane + 64 * j), s1 = *((const f32x4*)(mp + 1024) + C.lane + 64 * j); gsc[j] = gg * (s1 + 1.0f); shv[j] = *((const f32x4*)mp + C.lane + 64 * j);
#pragma unroll
                        for (int i = 0; i < 4; ++i) { const float* wp = wrt + (size_t)(4 * (C.lane + 64 * j) + i) * 8; const f32x4 w0 = *(const f32x4*)wp, w1 = *(const f32x4*)(wp + 4);
                            wreg[j][i][0] = w0[0]; wreg[j][i][1] = w0[1]; wreg[j][i][2] = w0[2]; wreg[j][i][3] = w0[3]; wreg[j][i][4] = w1[0]; wreg[j][i][5] = w1[1]; wreg[j][i][6] = w1[2]; wreg[j][i][7] = w1[3]; } }
                    f32x4 xn[4];
#pragma unroll
                    for (int j = 0; j < 4; ++j) xn[j] = *((const f32x4*)(xw + (size_t)rowb * D) + C.lane + 64 * j);
#pragma unroll 1
                    for (int rr = 0; rr < 8; ++rr) {
                        const int row = rowb + rr;
                        f32x4 v[4];
#pragma unroll
                        for (int j = 0; j < 4; ++j) v[j] = xn[j];
                        if (rr < 7) {
#pragma unroll
                            for (int j = 0; j < 4; ++j) xn[j] = *((const f32x4*)(xw + (size_t)(row + 1) * D) + C.lane + 64 * j);
                        }
                        float ssx = 0.f;
#pragma unroll
                        for (int j = 0; j < 4; ++j) ssx += (v[j][0] * v[j][0] + v[j][1] * v[j][1]) + (v[j][2] * v[j][2] + v[j][3] * v[j][3]);
                        const float rstd = __builtin_amdgcn_rsqf(wave_sum(ssx, C.lane) * (1.0f / D) + EPS);
                        float lg[8] = {0.f, 0.f, 0.f, 0.f, 0.f, 0.f, 0.f, 0.f};
#pragma unroll
                        for (int j = 0; j < 4; ++j) {
                            v[j] = v[j] * rstd * gsc[j] + shv[j];
                            u32x2 w; w.x = cvt_pk_bf16(v[j][0], v[j][1]); w.y = cvt_pk_bf16(v[j][2], v[j][3]);
                            *((u32x2*)(h2m + (size_t)row * D) + C.lane + 64 * j) = w;
#pragma unroll
                            for (int i = 0; i < 4; ++i)
#pragma unroll
                                for (int e = 0; e < 8; ++e) lg[e] += v[j][i] * wreg[j][i][e];
                        }
#pragma unroll
                        for (int e = 0; e < 8; ++e) lg[e] = wave_sum(lg[e], C.lane) + rb[e];
                        int ea = 0; float va = lg[0];
#pragma unroll
                        for (int e = 1; e < 8; ++e) if (lg[e] > va) { va = lg[e]; ea = e; }
                        int eb = (ea + 1) & 7; float vb = -3.0e38f;
#pragma unroll
                        for (int e = 0; e < 8; ++e) if (e != ea && lg[e] > vb) { vb = lg[e]; eb = e; }
                        const float wa = 1.0f / (1.0f + expf(vb - va));
                        if (C.lane == 0) { route_e[row] = ea | (eb << 8); route_w[2 * row] = wa; route_w[2 * row + 1] = 1.0f - wa; }
                    }
                    __syncthreads();
                    VM_WAIT(); __syncthreads();
                    if (C.tid < 8) { int c = 0; for (int i = 0; i < 64; ++i) { const int e2 = __hip_atomic_load(route_e + blk * 64 + i, __ATOMIC_RELAXED, __HIP_MEMORY_SCOPE_AGENT); c += ((e2 & 255) == C.tid) + ((e2 >> 8) == C.tid); }
                        blkcnt[blk * 8 + C.tid] = c; }
                    __syncthreads();
                }
                constexpr int IE1 = 16 * 88, IE2 = 44 * 32, IE = 2 * IE1 + IE2;
                for (int it = C.gw; it < NE * IE; it += C.ngw) {
                    const int e = it / IE; int r = it % IE;
                    if (r < 2 * IE1) { const int w3 = r >= IE1; if (w3) r -= IE1; const int kb = r / 88, nb = r % 88;
                        tr_item(prm.in[w3 ? I_MW3 : I_MW1] + (size_t)e * D * DFF, DFF, 64 * kb, 32 * nb, nullptr, (bf16_t*)(ws + WS_MW13) + (size_t)e * 5632 * 1024, 1024, 64 * kb, RowGU{w3 ? 16 : 0}, wscr, C.lane); }
                    else { r -= 2 * IE1; const int kb = r / 32, nb = r % 32;
                        tr_item(prm.in[I_MW2] + (size_t)e * DFF * D, 1024, 64 * kb, 32 * nb, nullptr, (bf16_t*)(ws + WS_MW2) + (size_t)e * 1024 * DFF, DFF, 64 * kb, RowId{}, wscr, C.lane); }
                }
            }
            GRID_BAR();
            DBGSCAN(h2m, (size_t)TL * 1024 * 2, false, 24); DBGSCAN(ws + WS_MW13, (size_t)NE * 5632 * 1024 * 2 + (size_t)NE * 1024 * DFF * 2, false, 25);
            if (PHON(19)) { PHASE_CTX
                __syncthreads();
                if (C.tid < 8) { int tot = 0; for (int b2 = 0; b2 < 256; ++b2) tot += blkcnt[b2 * 8 + C.tid]; sc_i[128 + C.tid] = tot; }
                __syncthreads();
                if (C.tid == 0) { int seg = 0, tl = 0; for (int e = 0; e < 8; ++e) { sc_i[136 + e] = seg; const int ntl = (sc_i[128 + e] + 255) >> 8; for (int q = 0; q < ntl; ++q) tile_e[tl++] = e; seg += ntl * 256; } tile_e[140] = tl; }
                __syncthreads();
                for (int blk = C.bid; blk < 256; blk += C.G) {
                    if (C.tid < 8) { int run = sc_i[136 + C.tid]; for (int b2 = 0; b2 < blk; ++b2) run += blkcnt[b2 * 8 + C.tid];
                        for (int i = 0; i < 64; ++i) { const int e2 = route_e[blk * 64 + i]; if ((e2 & 255) == C.tid) { sc_i[256 + 2 * i] = run; tokslot[2 * (blk * 64 + i)] = run; ++run; } if ((e2 >> 8) == C.tid) { sc_i[256 + 2 * i + 1] = run; tokslot[2 * (blk * 64 + i) + 1] = run; ++run; } } }
                    __syncthreads();
                    for (int rr = 0; rr < 8; ++rr) { const int lr = C.wave * 8 + rr, row = blk * 64 + lr;
                        const u32x4* sp = (const u32x4*)(h2m + (size_t)row * D) + C.lane; const u32x4 v0 = sp[0], v1 = sp[64];
                        u32x4* d0 = (u32x4*)(h2g + (size_t)sc_i[256 + 2 * lr] * D) + C.lane; u32x4* d1 = (u32x4*)(h2g + (size_t)sc_i[256 + 2 * lr + 1] * D) + C.lane;
                        d0[0] = v0; d0[64] = v1; d1[0] = v0; d1[64] = v1; }
                    __syncthreads();
                }
                if (C.bid < 8) { const int e = C.bid, cnt = sc_i[128 + e], s0 = sc_i[136 + e] + cnt, s1 = sc_i[136 + e] + (((cnt + 255) >> 8) << 8);
                    for (int i = C.tid; i < (s1 - s0) * 128; i += 512) *((u32x4*)(h2g + (size_t)s0 * D) + i) = (u32x4){0u, 0u, 0u, 0u}; }
            }
            GRID_BAR();
            const int ntiles = tile_e[140];
            DBGSCAN(h2g, (size_t)ntiles * 256 * 1024 * 2, false, 26);
            {
                if (PHON(20)) { PHASE_WS pg8::Gemm g{h2g, (const bf16_t*)(ws + WS_MW13), 1024, 1024, 1024, (size_t)5632 * 1024 * 2};
                  pg8::GridOrder S; S.init(ntiles, 22, C.G, C.bid); S.tile_e = tile_e;
                  pg8::EpiSwiglu E{uf, DFF};
                  pg8::gemm_phase<pg8::EpiSwiglu, pg8::GridOrder, true>(C.lds, g, S, E, C.wave); }
                GRID_BAR();
                if (PHON(21)) { PHASE_WS
                  { pg8::Gemm g{uf, (const bf16_t*)(ws + WS_MW2), DFF, DFF, DFF, (size_t)1024 * DFF * 2};
                    pg8::GridOrder S; S.init(ntiles < 128 ? ntiles : 128, 4, C.G, C.bid); S.tile_e = tile_e;
                    pg8::EpiMoeDown E{yexp, yx2};
                    pg8::gemm_phase<pg8::EpiMoeDown, pg8::GridOrder, true>(C.lds, g, S, E, C.wave); }
                  if (ntiles > 128) { pg8::Gemm g{uf, (const bf16_t*)(ws + WS_MW2), DFF, DFF, DFH, (size_t)1024 * DFF * 2, 0, (size_t)DFH * 2, (size_t)DFH * 2};
                    pg8::MoeOvOrder S{ntiles - 128, C.G, (C.bid + 128) % C.G, tile_e};
                    pg8::EpiMoeDown E{yexp, yx2};
                    pg8::gemm_phase<pg8::EpiMoeDown, pg8::MoeOvOrder, true>(C.lds, g, S, E, C.wave); }
                }
                GRID_BAR();
            }
            if (PHON(24)) { PHASE_CTX for (int row = C.gw; row < TL; row += C.ngw) {
                const int set = row >> 13; const float* gt = mods_l + set * 6144 + 5 * 1024;
                const float wa = route_w[2 * row], wb = route_w[2 * row + 1]; const int sa = tokslot[2 * row], sb = tokslot[2 * row + 1];
                f32x4 v[4]; float s = 0.f;
#pragma unroll
                for (int j = 0; j < 4; ++j) {
                    const f32x4 x = *((const f32x4*)(xw + (size_t)row * D) + C.lane + 64 * j), gg = *((const f32x4*)gt + C.lane + 64 * j);
                    const u32x2 ya = *((const u32x2*)(yexp + (size_t)sa * D) + C.lane + 64 * j), yb = *((const u32x2*)(yexp + (size_t)sb * D) + C.lane + 64 * j);
                    f32x4 fa = (f32x4){bflo(ya.x), bfhi(ya.x), bflo(ya.y), bfhi(ya.y)}, fb = (f32x4){bflo(yb.x), bfhi(yb.x), bflo(yb.y), bfhi(yb.y)};
                    if (sa >= 32768) { const u32x2 y2 = *((const u32x2*)(yx2 + (size_t)(sa - 32768) * D) + C.lane + 64 * j); fa += (f32x4){bflo(y2.x), bfhi(y2.x), bflo(y2.y), bfhi(y2.y)}; }
                    if (sb >= 32768) { const u32x2 y2 = *((const u32x2*)(yx2 + (size_t)(sb - 32768) * D) + C.lane + 64 * j); fb += (f32x4){bflo(y2.x), bfhi(y2.x), bflo(y2.y), bfhi(y2.y)}; }
                    v[j] = x + gg * (fa * wa + fb * wb);
                    s += (v[j][0] * v[j][0] + v[j][1] * v[j][1]) + (v[j][2] * v[j][2] + v[j][3] * v[j][3]);
                }
                const float rstd = __builtin_amdgcn_rsqf(wave_sum(s, C.lane) * (1.0f / D) + EPS);
#pragma unroll
                for (int j = 0; j < 4; ++j) { const f32x4 gf = *((const f32x4*)prm.in[I_GFINAL] + C.lane + 64 * j); f32x4 o = v[j] * rstd * gf;
#if DBG
                    { const unsigned fl = *((volatile unsigned*)(ws + WS_CTL) + CW_DBG); if (fl) { const float big = exp2f(2.0f * (float)(100 - (int)fl)); o = (f32x4){big, big, big, big}; }
                      else {
#pragma unroll
                          for (int i = 0; i < 4; ++i) if (!(fabsf(o[i]) < 1e30f)) o[i] = 0.f; } }
#endif
                    *((f32x4*)(prm.out + (size_t)row * D) + C.lane + 64 * j) = o; }
            } }
        }

}
__global__ void __launch_bounds__(512, 2) mega_fwd(Params prm) {
    extern __shared__ __attribute__((aligned(16))) unsigned char lds_raw[];
    Ctx C;
    C.lds = (LAS unsigned char*)lds_raw;
    C.tid = threadIdx.x; C.lane = C.tid & 63; C.wave = __builtin_amdgcn_readfirstlane(C.tid >> 6);
    C.G = gridDim.x; C.bid = blockIdx.x; C.gw = C.bid * 8 + C.wave; C.ngw = C.G * 8;
    unsigned char* ws0 = prm.ws;
    for (int u = C.tid; u < (LDS_BYTES - LDSCTL_OFF) / 4; u += 512) ((LAS unsigned*)(C.lds + LDSCTL_OFF))[u] = 0u;
    __syncthreads();
    XcdBarrier bar = xcd_barrier_post((unsigned*)(ws0 + WS_CTL) + CW_BAR, (volatile LAS unsigned*)(C.lds + MISC_OFF) + 8);
    if (PHON(0)) { PHASE_CTX
        const int gtid = C.bid * 512 + C.tid, gthreads = C.G * 512;
        LAS float* wscr = (LAS float*)(C.lds + C.wave * 8448);
        for (int item = C.bid; item < 192; item += C.G) {
            const int layer = item / 96, c0 = (item % 96) * 64;
            const float* wm = prm.in[I_WMOD] + (size_t)layer * D * 6144 + c0 + C.lane;
            float a0 = 0.f, a1 = 0.f, a2 = 0.f;
#pragma unroll 1
            for (int kh = 0; kh < 2; ++kh) {
                const int k0 = C.wave * 128 + kh * 64;
                float s0 = prm.in[I_C][k0 + C.lane], s1 = prm.in[I_C][D + k0 + C.lane], s2 = prm.in[I_CCTX][k0 + C.lane];
                s0 = s0 * sigmoidf_fast(s0); s1 = s1 * sigmoidf_fast(s1); s2 = s2 * sigmoidf_fast(s2);
                float wv[64];
#pragma unroll
                for (int j = 0; j < 64; ++j) wv[j] = wm[(size_t)(k0 + j) * 6144];
#pragma unroll
                for (int j = 0; j < 64; ++j) {
                    a0 += __int_as_float(__builtin_amdgcn_readlane(__float_as_int(s0), j)) * wv[j];
                    a1 += __int_as_float(__builtin_amdgcn_readlane(__float_as_int(s1), j)) * wv[j];
                    a2 += __int_as_float(__builtin_amdgcn_readlane(__float_as_int(s2), j)) * wv[j];
                }
            }
            LAS float* red = (LAS float*)(C.lds + 80000);
            __syncthreads();
            red[(C.wave * 3 + 0) * 64 + C.lane] = a0; red[(C.wave * 3 + 1) * 64 + C.lane] = a1; red[(C.wave * 3 + 2) * 64 + C.lane] = a2;
            __syncthreads();
            if (C.tid < 192) { const int set = C.tid >> 6, l = C.tid & 63; float s = 0.f;
#pragma unroll
                for (int w = 0; w < 8; ++w) s += red[(w * 3 + set) * 64 + l];
                mods[(size_t)(layer * 3 + set) * 6144 + c0 + l] = s + prm.in[I_BMOD][layer * 6144 + c0 + l]; }
            __syncthreads();
        }
        for (int i = gtid; i < 128 * 8; i += gthreads) { const int pos = i >> 3, f = i & 7; const float inv = exp2f(-(float)f * (13.287712379549449f / 8.0f)); const float a = (float)pos * inv;
            ropet[2 * i] = cosf(a); ropet[2 * i + 1] = sinf(a); }
        for (int i = gtid; i < 128 * 64; i += gthreads) { const int k1 = i >> 6, l2 = i & 63; const float x = (float)((k1 * l2) & 8191) * (2.0f / 8192.0f); twt[2 * i] = cospif(x); twt[2 * i + 1] = sinpif(x); }
        for (int i = gtid; i < 256 * 128; i += gthreads) { const int n = i >> 7, l1 = i & 127, k1 = n >> 1; const float x = (float)((k1 * l1) & 127) * (2.0f / 128.0f); dft128[i] = f2bf((n & 1) ? -sinpif(x) : cospif(x)); }
        for (int i = gtid; i < 128 * 128; i += gthreads) { const int n = i >> 7, kk = i & 127, k2 = n >> 1, ro = n & 1, l2 = kk >> 1, ri = kk & 1; const float x = (float)((k2 * l2) & 63) * (2.0f / 64.0f);
            const float c = cospif(x), s = sinpif(x); m64[i] = f2bf(ro == ri ? c : (ro == 0 ? s : -s)); }
        for (int i = gtid; i < 512 * 256; i += gthreads) { const int n = i >> 8, l = i & 255, k = n >> 1; const float x = (float)((k * l) & 255) * (2.0f / 256.0f); dft256[i] = f2bf((n & 1) ? -sinpif(x) : cospif(x)); }
        {
            constexpr int IL_IN = 16 * 149, IL_UQ = 6 * 24, IL_UKV = 4 * 32, IL_OA = 8 * 32, IL_OUT = 16 * 32, IL = IL_IN + IL_UQ + IL_UKV + IL_OA + IL_OUT;
            constexpr int IF1 = 16 * 88, IF2 = 44 * 32, NIT = 2 * IL + 2 * IF1 + IF2;
            for (int it = C.gw; it < NIT; it += C.ngw) {
                int r = it;
                if (r < 2 * IL) {
                    const int layer = r / IL; r -= layer * IL;
                    bf16_t* lwp = (bf16_t*)(ws + WS_PERM + (size_t)layer * LW_SIZE);
                    if (r < IL_IN) { tr_item(prm.in[I_WIN] + (size_t)layer * D * IN_COLS, IN_COLS, 64 * (r / 149), 32 * (r % 149), nullptr, (bf16_t*)((char*)lwp + LW_IN), 1024, 64 * (r / 149), RowWin{}, wscr, C.lane); continue; } r -= IL_IN;
                    if (r < IL_UQ) { tr_item(prm.in[I_WUQ] + (size_t)layer * QL * 768, 768, 64 * (r / 24), 32 * (r % 24), prm.in[I_GQ] + layer * QL, (bf16_t*)((char*)lwp + LW_UQ), QL, 64 * (r / 24), RowQ{}, wscr, C.lane); continue; } r -= IL_UQ;
                    if (r < IL_UKV) { tr_item(prm.in[I_WUKV] + (size_t)layer * KVL * 1024, 1024, 64 * (r / 32), 32 * (r % 32), prm.in[I_GKV] + layer * KVL, (bf16_t*)((char*)lwp + LW_UKV), KVL, 64 * (r / 32), RowId{}, wscr, C.lane); continue; } r -= IL_UKV;
                    if (r < IL_OA) { tr_item(prm.in[I_WOA] + (size_t)layer * 512 * 1024, 1024, 64 * (r / 32), 32 * (r % 32), nullptr, (bf16_t*)((char*)lwp + LW_OA), 512, 64 * (r / 32), RowId{}, wscr, C.lane); continue; } r -= IL_OA;
                    tr_item(prm.in[I_WOUT] + (size_t)layer * D * D, 1024, 64 * (r / 32), 32 * (r % 32), nullptr, (bf16_t*)((char*)lwp + LW_OUT), 1024, 64 * (r / 32), RowId{}, wscr, C.lane); continue;
                }
                r -= 2 * IL;
                if (r < IF1) { tr_item(prm.in[I_FW1], DFF, 64 * (r / 88), 32 * (r % 88), nullptr, (bf16_t*)(ws + WS_FFN13), 1024, 64 * (r / 88), RowGU{0}, wscr, C.lane); continue; } r -= IF1;
                if (r < IF1) { tr_item(prm.in[I_FW3], DFF, 64 * (r / 88), 32 * (r % 88), nullptr, (bf16_t*)(ws + WS_FFN13), 1024, 64 * (r / 88), RowGU{16}, wscr, C.lane); continue; } r -= IF1;
                tr_item(prm.in[I_FW2], 1024, 64 * (r / 32), 32 * (r % 32), nullptr, (bf16_t*)(ws + WS_FFN2), DFF, 64 * (r / 32), RowId{}, wscr, C.lane);
            }
            for (int i = gtid; i < 2 * 96 * 128; i += gthreads) { const int layer = i / (96 * 128), r = i % (96 * 128);
                *(u32x4*)(ws + WS_PERM + (size_t)layer * LW_SIZE + LW_IN + (size_t)OFF_GATE * 2048 + (size_t)r * 16) = (u32x4){0u, 0u, 0u, 0u}; }
        }
        {
            LAS float* ctab = (LAS float*)(C.lds + 90000);
            __syncthreads();
            if (C.tid < 128) ctab[C.tid] = cospif((float)C.tid * (2.0f / 128.0f));
            __syncthreads();
            for (int un = C.bid; un < 64 + 128; un += C.G) {
                if (un < 64) {
                    const int layer = un >> 5, g = (un >> 3) & 3, dch = un & 7;
                    const float* wo = prm.in[I_WOB] + ((size_t)layer * 512 + g * 128) * 1024 + dch * 128;
                    const float* wp = prm.in[I_WPOOL] + (size_t)(layer * 4 + g) * 128 * 128; const float* sp = prm.in[I_SPOOL] + layer * 512 + g * 128;
                    bf16_t* dst = (bf16_t*)(ws + WS_PERM + (size_t)layer * LW_SIZE + LW_PB) + (size_t)dch * 128 * 512 + g * 128;
                    flex_tile(C, 128,
                        [&](int m, int k) { u32x4 o; float f[8];
#pragma unroll
                            for (int t = 0; t < 8; ++t) f[t] = wo[(size_t)(k + t) * 1024 + m];
                            o.x = cvt_pk_bf16(f[0], f[1]); o.y = cvt_pk_bf16(f[2], f[3]); o.z = cvt_pk_bf16(f[4], f[5]); o.w = cvt_pk_bf16(f[6], f[7]); return __builtin_bit_cast(bf16x8, o); },
                        [&](int n, int k) { const f32x4 a0 = *(const f32x4*)(wp + (size_t)n * 128 + k), a1 = *(const f32x4*)(wp + (size_t)n * 128 + k + 4), s0 = *(const f32x4*)(sp + k), s1 = *(const f32x4*)(sp + k + 4);
                            u32x4 o; o.x = cvt_pk_bf16(a0[0] * s0[0], a0[1] * s0[1]); o.y = cvt_pk_bf16(a0[2] * s0[2], a0[3] * s0[3]); o.z = cvt_pk_bf16(a1[0] * s1[0], a1[1] * s1[1]); o.w = cvt_pk_bf16(a1[2] * s1[2], a1[3] * s1[3]);
                            return __builtin_bit_cast(bf16x8, o); },
                        [&](int m, int n, float v0, float v1) { *(unsigned*)(dst + (size_t)m * 512 + n) = cvt_pk_bf16(v0, v1); });
                } else {
                    const int u2 = un - 64, layer = u2 >> 6, g = (u2 >> 4) & 3, dch = (u2 >> 1) & 7, nch = u2 & 1, sh = nch ? 96 : 0;
                    const float* wo = prm.in[I_WOC] + ((size_t)layer * 512 + g * 128) * 1024 + dch * 128;
                    bf16_t* dst = (bf16_t*)(ws + WS_PERM + (size_t)layer * LW_SIZE + LW_FC) + (size_t)dch * 128 * 1024 + g * 256 + nch * 128;
                    flex_tile(C, 128,
                        [&](int m, int k) { u32x4 o; float f[8];
#pragma unroll
                            for (int t = 0; t < 8; ++t) f[t] = wo[(size_t)(k + t) * 1024 + m];
                            o.x = cvt_pk_bf16(f[0], f[1]); o.y = cvt_pk_bf16(f[2], f[3]); o.z = cvt_pk_bf16(f[4], f[5]); o.w = cvt_pk_bf16(f[6], f[7]); return __builtin_bit_cast(bf16x8, o); },
                        [&](int n, int k) { float f[8];
#pragma unroll
                            for (int t = 0; t < 8; ++t) f[t] = ctab[((k + t) * n + sh) & 127];
                            u32x4 o; o.x = cvt_pk_bf16(f[0], f[1]); o.y = cvt_pk_bf16(f[2], f[3]); o.z = cvt_pk_bf16(f[4], f[5]); o.w = cvt_pk_bf16(f[6], f[7]); return __builtin_bit_cast(bf16x8, o); },
                        [&](int m, int n, float v0, float v1) { *(unsigned*)(dst + (size_t)m * 1024 + n) = cvt_pk_bf16(v0 * (1.0f / 1024.0f), v1 * (1.0f / 1024.0f)); });
                }
            }
        }
    }
    GRID_BAR();
    DBGSCAN(ws0 + WS_DFT128, WS_ROUTE_E - WS_DFT128, false, 1); DBGSCAN(ws0 + WS_ROPE, WS_DFT128 - WS_ROPE, true, 1); DBGSCAN(ws0 + WS_PERM, WS_ARENA - WS_PERM, false, 1); DBGSCAN(ws0 + WS_MODS, (size_t)2 * 3 * 6144 * 4, true, 1); DBGSCAN(ws0 + WS_XW, (size_t)T * D * 4, true, 1);
    if (PHON(1)) { PHASE_CTX norm_phase(C, prm.in[I_X], prm.in[I_CTX], prm.in[I_GN1], mods, 0, A1, T); }
    GRID_BAR();
    DBGSCAN(ws0 + WS_A1, (size_t)T * D * 2, false, 2);

    layer_body<0>(C, prm, ws0, bar);
    layer_body<1>(C, prm, ws0, bar);
#undef GRID_BAR
}

extern "C" void kernel_launch(void* const* d_in, const int* in_sizes, int n_in, void* d_out, int out_size, void* d_ws, size_t ws_size, hipStream_t stream) {
    static int grid = 0;
    if (grid == 0) {
        if (n_in != 29 || out_size != TL * D || ws_size < WS_NEED) { fprintf(stderr, "kernel_launch: unexpected shapes (n_in %d out %d ws %zu need %zu)\n", n_in, out_size, ws_size, (size_t)WS_NEED); grid = -1; return; }
        int dev = 0, cus = 0, per_cu = 0;
        if (hipGetDevice(&dev) != hipSuccess || hipDeviceGetAttribute(&cus, hipDeviceAttributeMultiprocessorCount, dev) != hipSuccess) { grid = -1; return; }
        if (hipFuncSetAttribute((const void*)mega_fwd, hipFuncAttributeMaxDynamicSharedMemorySize, LDS_BYTES) != hipSuccess) { fprintf(stderr, "kernel_launch: hipFuncSetAttribute failed\n"); grid = -1; return; }
        if (hipOccupancyMaxActiveBlocksPerMultiprocessor(&per_cu, (const void*)mega_fwd, 512, LDS_BYTES) != hipSuccess || per_cu < 1) { fprintf(stderr, "kernel_launch: occupancy query reports %d\n", per_cu); }
        (void)hipGetLastError();
        grid = cus;
        if (grid != 256) { fprintf(stderr, "kernel_launch: built for a 256-CU device (got %d)\n", cus); if (grid > 256) grid = 256; }
    }
    if (grid < 0) return;
    if (hipMemsetAsync((char*)d_ws + WS_CTL, 0, CTL_ZERO_BYTES, stream) != hipSuccess) return;
    Params p{};
    for (int i = 0; i < 29; ++i) p.in[i] = (const float*)d_in[i];
    p.out = (float*)d_out; p.ws = (unsigned char*)d_ws;
    hipLaunchKernelGGL(mega_fwd, dim3(grid), dim3(512), LDS_BYTES, stream, p);
}
```
